# Optimizing an MI355X kernel written in HIP

```python
import jax, jax.numpy as jnp
from jax import lax
import numpy as np

D_MODEL = 1024
BATCH = 4
SEQ = 8192
DEPTH = 2

N_META = 16
CONV_WIDTH = 3
HEAD_DIM = 64
N_Q_HEADS = D_MODEL // HEAD_DIM
N_KV_HEADS = N_Q_HEADS // 4
GROUP = N_Q_HEADS // N_KV_HEADS
Q_DIM = N_Q_HEADS * HEAD_DIM
KV_DIM = N_KV_HEADS * HEAD_DIM
QKV_DIM = Q_DIM + 2 * KV_DIM
WINDOW = 128
BLOCK = 128
ROPE_THETA = 10000.0
D_FF = 7 * D_MODEL // 2
N_EXPERTS = 8
TOP_K = 2
EXPERT_FF = 7 * D_MODEL // 2
RMS_EPS = 1e-5
N_CONV_LAYERS = (DEPTH + 1) // 2
N_ATTN_LAYERS = DEPTH // 2

kernel_name = "hybrid_shortconv_swa_sink_moe_block"


def rmsnorm(x, g):
    xf = x.astype(jnp.float32)
    y = xf * lax.rsqrt(jnp.mean(xf * xf, axis=-1, keepdims=True) + RMS_EPS)
    return (y * g.astype(jnp.float32)).astype(x.dtype)


def swiglu(h, w_gate, w_up, w_down):
    return (jax.nn.silu(h @ w_gate) * (h @ w_up)) @ w_down


def short_conv_mixer(h, w_in, conv_w, w_out):
    b_gate, c_gate, u = jnp.split(h @ w_in, 3, axis=-1)
    v = c_gate * u
    L = v.shape[1]
    vp = jnp.pad(v, ((0, 0), (CONV_WIDTH - 1, 0), (0, 0)))
    conv = sum(conv_w[k] * vp[:, k:k + L] for k in range(CONV_WIDTH))
    return (b_gate * conv) @ w_out


def rope_tables(L):
    pos = jnp.arange(L, dtype=jnp.float32)
    inv = ROPE_THETA ** (-jnp.arange(0, HEAD_DIM, 2, dtype=jnp.float32) / HEAD_DIM)
    ang = pos[:, None] * inv[None, :]
    return jnp.cos(ang), jnp.sin(ang)


def apply_rope(x, cos, sin):
    x1, x2 = jnp.split(x.astype(jnp.float32), 2, axis=-1)
    c = cos[None, :, None, :]
    s = sin[None, :, None, :]
    return jnp.concatenate([x1 * c - x2 * s, x2 * c + x1 * s], axis=-1).astype(x.dtype)


def sliding_window_attention(h, w_qkv, b_qkv, sinks, w_o):
    Bsz, L, _ = h.shape
    qkv = h @ w_qkv + b_qkv
    q, k, v = jnp.split(qkv, [Q_DIM, Q_DIM + KV_DIM], axis=-1)
    q = q.reshape(Bsz, L, N_Q_HEADS, HEAD_DIM)
    k = k.reshape(Bsz, L, N_KV_HEADS, HEAD_DIM)
    v = v.reshape(Bsz, L, N_KV_HEADS, HEAD_DIM)
    cos, sin = rope_tables(L)
    q = apply_rope(q, cos, sin)
    k = apply_rope(k, cos, sin)
    pad = (-L) % BLOCK
    L_pad = L + pad
    nb = L_pad // BLOCK
    padf = lambda t: jnp.pad(t, ((0, 0), (pad, 0), (0, 0), (0, 0)))
    qb = padf(q).reshape(Bsz, nb, BLOCK, N_KV_HEADS, GROUP, HEAD_DIM)
    kb = padf(k).reshape(Bsz, nb, BLOCK, N_KV_HEADS, HEAD_DIM)
    vb = padf(v).reshape(Bsz, nb, BLOCK, N_KV_HEADS, HEAD_DIM)
    prev = lambda t: jnp.concatenate([jnp.zeros_like(t[:, :1]), t[:, :-1]], axis=1)
    kw = jnp.concatenate([prev(kb), kb], axis=2)
    vw = jnp.concatenate([prev(vb), vb], axis=2)
    scale = HEAD_DIM ** -0.5
    s = jnp.einsum('bnqhgd,bnshd->bnhgqs', qb, kw, preferred_element_type=jnp.float32) * scale
    r = jnp.arange(BLOCK)[:, None]
    j = jnp.arange(2 * BLOCK)[None, :]
    diff = BLOCK + r - j
    k_abs = jnp.arange(nb)[:, None, None] * BLOCK - BLOCK + j[None]
    mask = ((diff >= 0) & (diff < WINDOW))[None] & (k_abs >= pad)
    s = jnp.where(mask[None, :, None, None], s, -jnp.inf)
    sink = sinks.astype(jnp.float32).reshape(1, 1, N_KV_HEADS, GROUP, 1, 1)
    m = jnp.maximum(jnp.max(s, axis=-1, keepdims=True), sink)
    p = jnp.exp(s - m)
    denom = jnp.sum(p, axis=-1, keepdims=True) + jnp.exp(sink - m)
    p = (p / denom).astype(vw.dtype)
    o = jnp.einsum('bnhgqs,bnshd->bnqhgd', p, vw)
    o = o.reshape(Bsz, L_pad, Q_DIM)[:, pad:]
    return o @ w_o


def moe_swiglu(h, w_router, w_gate, w_up, w_down):
    logits = jnp.einsum('bld,de->ble', h, w_router).astype(jnp.float32)
    top_val, top_idx = lax.top_k(logits, TOP_K)
    gates = jax.nn.softmax(top_val, axis=-1)
    combine = jnp.sum(jax.nn.one_hot(top_idx, N_EXPERTS, dtype=jnp.float32) * gates[..., None], axis=-2)
    out = jnp.zeros_like(h)
    for e in range(N_EXPERTS):
        out = out + combine[..., e:e + 1].astype(h.dtype) * swiglu(h, w_gate[e], w_up[e], w_down[e])
    return out


def setup_inputs(seed: int = 0) -> dict:
    key = jax.random.key(seed)
    ks = iter(jax.random.split(key, 32))
    nrm = lambda shape, scale: jax.random.normal(next(ks), shape, jnp.float32) * scale
    gain = lambda shape: 1.0 + nrm(shape, 0.02)
    D, NA, NB = D_MODEL, N_CONV_LAYERS, N_ATTN_LAYERS
    return {
        "x": nrm((BATCH, SEQ, D), 1.0),
        "meta_tokens": nrm((N_META, D), 1.0),
        "conv_norm": gain((NA, D)),
        "conv_w_in": nrm((NA, D, 3 * D), D ** -0.5),
        "conv_w": nrm((NA, CONV_WIDTH, D), CONV_WIDTH ** -0.5),
        "conv_w_out": nrm((NA, D, D), D ** -0.5),
        "ffn_norm": gain((NA, D)),
        "ffn_w_gate": nrm((NA, D, D_FF), D ** -0.5),
        "ffn_w_up": nrm((NA, D, D_FF), D ** -0.5),
        "ffn_w_down": nrm((NA, D_FF, D), D_FF ** -0.5),
        "attn_norm": gain((NB, D)),
        "attn_w_qkv": nrm((NB, D, QKV_DIM), D ** -0.5),
        "attn_b_qkv": nrm((NB, QKV_DIM), 0.02),
        "attn_sinks": nrm((NB, N_Q_HEADS), 0.5),
        "attn_w_o": nrm((NB, Q_DIM, D), Q_DIM ** -0.5),
        "moe_norm": gain((NB, D)),
        "moe_w_router": nrm((NB, D, N_EXPERTS), D ** -0.5),
        "moe_w_gate": nrm((NB, N_EXPERTS, D, EXPERT_FF), D ** -0.5),
        "moe_w_up": nrm((NB, N_EXPERTS, D, EXPERT_FF), D ** -0.5),
        "moe_w_down": nrm((NB, N_EXPERTS, EXPERT_FF, D), EXPERT_FF ** -0.5),
        "final_norm": gain((D,)),
    }


def reference(x, meta_tokens, conv_norm, conv_w_in, conv_w, conv_w_out, ffn_norm, ffn_w_gate, ffn_w_up,
              ffn_w_down, attn_norm, attn_w_qkv, attn_b_qkv, attn_sinks, attn_w_o, moe_norm, moe_w_router,
              moe_w_gate, moe_w_up, moe_w_down, final_norm):
    Bsz = x.shape[0]
    meta = jnp.broadcast_to(meta_tokens[None].astype(x.dtype), (Bsz, N_META, D_MODEL))
    h = jnp.concatenate([meta, x], axis=1)
    for i in range(DEPTH):
        j = i // 2
        if i % 2 == 0:
            h = h + short_conv_mixer(rmsnorm(h, conv_norm[j]), conv_w_in[j], conv_w[j], conv_w_out[j])
            h = h + swiglu(rmsnorm(h, ffn_norm[j]), ffn_w_gate[j], ffn_w_up[j], ffn_w_down[j])
        else:
            h = h + sliding_window_attention(rmsnorm(h, attn_norm[j]), attn_w_qkv[j], attn_b_qkv[j],
                                             attn_sinks[j], attn_w_o[j])
            h = h + moe_swiglu(rmsnorm(h, moe_norm[j]), moe_w_router[j], moe_w_gate[j], moe_w_up[j],
                               moe_w_down[j])
    return rmsnorm(h, final_norm)[:, N_META:]
```

```cpp
#include <hip/hip_runtime.h>
#include <cstdio>
#include <cstdint>
#include <cmath>

#ifndef NAIVE_GEMM
#define NAIVE_GEMM 0
#endif
#ifndef PROBE_KL
#define PROBE_KL 1
#endif
#ifndef PROBE_DEPI
#define PROBE_DEPI 1
#endif
#ifndef PROBE_EPI
#define PROBE_EPI 1
#endif
#ifndef MULTI_LAUNCH
#define MULTI_LAUNCH 0
#endif

#define GAS __attribute__((address_space(1)))
#define LAS __attribute__((address_space(3)))
typedef unsigned short bf16;
typedef short bf16x8 __attribute__((ext_vector_type(8)));
typedef float f32x4 __attribute__((ext_vector_type(4)));
typedef float f32x2 __attribute__((ext_vector_type(2)));
typedef float f32x16 __attribute__((ext_vector_type(16)));
typedef unsigned u32x4 __attribute__((ext_vector_type(4)));
typedef unsigned u32x2 __attribute__((ext_vector_type(2)));
typedef int i32x8 __attribute__((ext_vector_type(8)));
typedef int i32x4 __attribute__((ext_vector_type(4)));

constexpr int D = 1024, BATCH = 4, SEQ = 8192, NMETA = 16, M = BATCH * SEQ;
constexpr int NCONV = 3 * D, DFF = 3584, NGU = 2 * DFF, NQKV = 1536, NE = 8;
constexpr int NQH = 16, NKVH = 4, HD = 64, KVD = NKVH * HD;
constexpr int LPOS = SEQ + NMETA;
constexpr float RMS_EPS = 1e-5f;
constexpr float LOG2E = 1.4426950408889634f;
constexpr float QSCALE = 0.125f * LOG2E;
constexpr int RING_BYTES_ = 131072;

__device__ __forceinline__ unsigned cvt_pk_bf16(float lo, float hi) { unsigned r; asm volatile("v_cvt_pk_bf16_f32 %0, %1, %2" : "=v"(r) : "v"(lo), "v"(hi)); return r; }
__device__ __forceinline__ float bf2f(unsigned short b) { return __uint_as_float(((unsigned)b) << 16); }
__device__ __forceinline__ float bflo(unsigned w) { return __uint_as_float(w << 16); }
__device__ __forceinline__ float bfhi(unsigned w) { return __uint_as_float(w & 0xffff0000u); }
__device__ __forceinline__ int hw_lane() { int l; asm volatile("v_mbcnt_lo_u32_b32 %0, -1, 0\n\tv_mbcnt_hi_u32_b32 %0, -1, %0" : "=v"(l)); return l; }
__device__ __forceinline__ float wave_sum(float v) {
#pragma unroll
    for (int o = 1; o < 64; o <<= 1) v += __shfl_xor(v, o);
    return v;
}

namespace pg8 {
constexpr int BM = 256, BK = 64, HALF = 128, HTB = HALF * BK * 2, STAGE_BYTES = 8 * HTB, NXCD = 8, WGM = 8;
__host__ __device__ __forceinline__ int lds_byte(int r, int c) { const int st = (r >> 4) * 2 + (c >> 5), rr = r & 15, cc = c & 31, ob = rr * 64 + cc * 2; return st * 1024 + (ob ^ (((ob >> 9) & 1) << 5)); }
__host__ __device__ __forceinline__ void stage_rc(int b, int& R, int& C) { const int st = b / 1024, sb = b % 1024, swz = sb ^ (((sb >> 9) & 1) << 5); R = (st >> 1) * 16 + swz / 64; C = (st & 1) * 32 + (swz % 64) / 2; }
__host__ __device__ __forceinline__ int perm32(int rho) { const int n = rho >> 4, i = rho & 15; return 8 * (i >> 2) + 4 * n + (i & 3); }

struct Unit { int pm, pn, e, lt; int ord = 0; };

__device__ __forceinline__ void order_unit(int L, int nM, int nN, int& pm, int& pn) {
    const int nwg = nM * nN; int wgid = L;
    { const int q = nwg / NXCD, r = nwg % NXCD, xcd = wgid % NXCD, off = wgid / NXCD; wgid = (xcd < r ? xcd * (q + 1) : r * (q + 1) + (xcd - r) * q) + off; }
    const int nig = WGM * nN, gid = wgid / nig, fm = gid * WGM, gsz = (nM - fm) < WGM ? (nM - fm) : WGM;
    pm = fm + ((wgid % nig) % gsz); pn = (wgid % nig) / gsz;
}

__device__ __forceinline__ const char* uptr(const char* p) { const unsigned long long v = (unsigned long long)p; const unsigned lo = __builtin_amdgcn_readfirstlane((unsigned)v), hi = __builtin_amdgcn_readfirstlane((unsigned)(v >> 32)); return (const char*)(((unsigned long long)hi << 32) | lo); }
__device__ __forceinline__ const char* sopaque(const char* p) { unsigned long long v = (unsigned long long)p; asm volatile("" : "+s"(v)); return (const char*)v; }
__device__ __forceinline__ void order_unit_b(int L, int nM, int nN, int& pm, int& pn) {
    const int nwg = nM * nN; int wgid = L;
    { const int q = nwg / NXCD, r = nwg % NXCD, xcd = wgid % NXCD, off = wgid / NXCD; wgid = (xcd < r ? xcd * (q + 1) : r * (q + 1) + (xcd - r) * q) + off; }
    const int gN = (nN % 4 == 0) ? 4 : ((nN % 3 == 0) ? 3 : nN);
    const int per_g = nM * gN, g = wgid / per_g, w = wgid % per_g;
    const int blk = WGM * gN, pmb = w / blk, wi = w % blk, fm = pmb * WGM, gsz = (nM - fm) < WGM ? (nM - fm) : WGM;
    pm = fm + wi % gsz; pn = g * gN + wi / gsz;
}
#ifndef FFN8
#define FFN8 1
#endif
#ifndef HD_NT
#define HD_NT 0
#endif
#ifndef YC_NT
#define YC_NT 1
#endif
#ifndef HM_PLAIN_FROM
#define HM_PLAIN_FROM 15
#endif
#ifndef BG_DEFER
#define BG_DEFER 0
#endif
#ifndef BG_CVT
#define BG_CVT 0
#endif
#ifndef BAL_LDS
#define BAL_LDS 0
#endif
#ifndef QKV_PIPE
#define QKV_PIPE 1
#endif
#ifndef CONV_BATCH
#define CONV_BATCH 1
#endif
#ifndef ORDER_B
#define ORDER_B 1
#endif
template <int NM, int NN, bool F8 = false>
struct DenseSched {
    static constexpr bool GATHER = false, FP8 = F8; static constexpr int REPK = 1, REPE = 1;
    const char* A; const char* Bt; int KB  , G, c;
    __device__ __forceinline__ bool next(int i, Unit& u) const { const int L = i * G + c; if (L >= NM * NN) return false; if (ORDER_B) order_unit_b(L, NM, NN, u.pm, u.pn); else order_unit(L, NM, NN, u.pm, u.pn); u.e = 0; u.lt = i; return true; }
    __device__ __forceinline__ const char* aptr(const Unit& u) const { return A + (size_t)u.pm * BM * KB; }
    __device__ __forceinline__ const char* bptr(const Unit& u) const { return Bt + (size_t)u.pn * BM * KB; }
    __device__ __forceinline__ unsigned arow(const Unit&, int r) const { return (unsigned)r * (unsigned)KB; }
    __device__ __forceinline__ int ktiles() const { return KB / (BK * 2); }
};

#define PG8_SA(b, h) (((b) * 2 + (h)) * HTB)
#define PG8_SB(b, h) ((4 + (b) * 2 + (h)) * HTB)
template <int OFF> __device__ __forceinline__ void glds16_s(const char* sbase, unsigned voff, unsigned lbase) { unsigned keep;
    asm volatile("s_mov_b32 %0, m0\n\ts_add_u32 m0, %3, %4\n\ts_nop 0\n\tglobal_load_lds_dwordx4 %1, %2\n\ts_mov_b32 m0, %0" : "=&s"(keep) : "v"(voff), "s"(sbase), "s"(lbase), "i"(OFF) : "memory", "scc"); }
#define PG8_STAGE(bufoff, gbase, voff) do { const char* _gb = (const char*)(gbase); glds16_s<(bufoff)>(_gb, (voff)[0], ldsb); glds16_s<(bufoff) + 8192>(_gb, (voff)[1], ldsb); } while (0)
#define PG8_STAGE_A1(bufoff, gbase) do { if constexpr (Sched::GATHER) PG8_STAGE(bufoff, gbase, aof1); else PG8_STAGE(bufoff, (const char*)(gbase) + hstepA, aof0); } while (0)
#define PG8_LDA(dst, b, h) do { _Pragma("unroll") for (int m = 0; m < 4; ++m) _Pragma("unroll") for (int k = 0; k < 2; ++k) dst[m][k] = *(const LAS bf16x8*)(lds + PG8_SA(b, h) + aoff + m * 2048 + k * 1024); } while (0)
#define PG8_LDB(dst, b, h) do { _Pragma("unroll") for (int n = 0; n < 2; ++n) _Pragma("unroll") for (int k = 0; k < 2; ++k) dst[n][k] = *(const LAS bf16x8*)(lds + PG8_SB(b, h) + boff + n * 2048 + k * 1024); } while (0)
#define PG8_MMA(ai, bj, At, Bt) do { __builtin_amdgcn_s_setprio(1); _Pragma("unroll") for (int m = 0; m < 4; ++m) _Pragma("unroll") for (int n = 0; n < 2; ++n) _Pragma("unroll") for (int k = 0; k < 2; ++k) \
        acc[ai][bj][m][n] = __builtin_amdgcn_mfma_f32_16x16x32_bf16(Bt[n][k], At[m][k], acc[ai][bj][m][n], 0, 0, 0); __builtin_amdgcn_s_setprio(0); } while (0)
#define PG8_CAT(x) __builtin_shufflevector(__builtin_bit_cast(i32x4, x[0]), __builtin_bit_cast(i32x4, x[1]), 0, 1, 2, 3, 4, 5, 6, 7)
#define PG8_MMA8(ai, bj, At, Bt) do { __builtin_amdgcn_s_setprio(1); _Pragma("unroll") for (int m = 0; m < 4; ++m) _Pragma("unroll") for (int n = 0; n < 2; ++n) \
        acc[ai][bj][m][n] = __builtin_amdgcn_mfma_scale_f32_16x16x128_f8f6f4(PG8_CAT(Bt[n]), PG8_CAT(At[m]), acc[ai][bj][m][n], 0, 0, 0, 0, 0, 0); __builtin_amdgcn_s_setprio(0); } while (0)
#define PG8_MM(ai, bj, At, Bt) do { if constexpr (Sched::FP8) PG8_MMA8(ai, bj, At, Bt); else PG8_MMA(ai, bj, At, Bt); } while (0)
#define PG8_WAIT_V(n) asm volatile("s_waitcnt vmcnt(" #n ")" ::: "memory")
#define PG8_WAIT_L(n) asm volatile("s_waitcnt lgkmcnt(" #n ")" ::: "memory")
#define PG8_BAR __builtin_amdgcn_s_barrier()
#define PG8_SCHED __builtin_amdgcn_sched_barrier(0)

#if !NAIVE_GEMM
struct NoPre { __device__ __forceinline__ void operator()() const {} };
struct NoBg { __device__ __forceinline__ void issue(int) {} __device__ __forceinline__ void finish() {} };
template <class Epi, class Sched, bool ALIGN_EPI, class Pre = NoPre, class Bg = NoBg>
__device__ __forceinline__ void gemm_phase(LAS unsigned char* lds, const Sched& S, const Epi& E, const int wid, const Pre& pre = Pre(), Bg bg = Bg()) {
    const int lane = hw_lane(), tid = wid * 64 + lane, wr = wid >> 2, wc = wid & 3, fr = lane & 15, fq = lane >> 4;
    const int KB = S.KB, nt = S.ktiles();
    int R_[2], C_[2]; unsigned voffB[2]; unsigned aof0[2], aof1[2];
#pragma unroll
    for (int i = 0; i < 2; ++i) { int R, C; stage_rc(tid * 16 + i * 8192, R, C); R_[i] = R; C_[i] = C; const int Rb = Epi::PERM ? ((R & ~31) + perm32(R & 31)) : R;
        voffB[i] = (unsigned)(Rb * KB + C * 2); }
    const size_t kstep = (size_t)(BK * 2);
    const size_t hstep = (size_t)HALF * KB;
    const size_t hstepA = (size_t)S.arow(Unit{0, 0, 0, 0}, HALF);
    const unsigned ldsb = (unsigned)(size_t)lds + (unsigned)wid * 1024u;
    const int aoff = lds_byte(wr * 64 + fr, fq * 8), boff = lds_byte(wc * 32 + fr, fq * 8);
    Unit cur, nxt; int ui = 0;
    if (!S.next(0, cur)) { pre(); return; }
    f32x4 acc[2][2][4][2];
#pragma unroll
    for (int a = 0; a < 2; ++a)
#pragma unroll
        for (int b = 0; b < 2; ++b)
#pragma unroll
            for (int m = 0; m < 4; ++m)
#pragma unroll
                for (int n = 0; n < 2; ++n) acc[a][b][m][n] = (f32x4){0.f, 0.f, 0.f, 0.f};
    bf16x8 At[4][2], B0[2][2], B1[2][2];
    const char* cA = uptr(S.aptr(cur)); const char* cB = uptr(S.bptr(cur));
#pragma unroll
    for (int i = 0; i < 2; ++i) { aof0[i] = S.arow(cur, R_[i]) + (unsigned)C_[i] * 2u; aof1[i] = Sched::GATHER ? S.arow(cur, HALF + R_[i]) + (unsigned)C_[i] * 2u : 0u; }
#if BAL_LDS == 1
    PG8_STAGE(PG8_SB(0, 0), cB, voffB); PG8_STAGE(PG8_SB(0, 1), cB + hstep, voffB); PG8_STAGE(PG8_SA(0, 0), cA, aof0); PG8_STAGE_A1(PG8_SA(0, 1), cA);
    PG8_STAGE(PG8_SB(1, 0), cB + kstep, voffB); PG8_STAGE(PG8_SA(1, 0), cA + kstep, aof0);
    pre();
    PG8_WAIT_V(4);
    if (wr == 1) PG8_BAR;
    PG8_BAR;
#else
    PG8_STAGE(PG8_SB(0, 0), cB, voffB); PG8_STAGE(PG8_SB(0, 1), cB + hstep, voffB); PG8_STAGE(PG8_SA(0, 0), cA, aof0); PG8_STAGE_A1(PG8_SA(0, 1), cA);
    pre();
    if (wr == 1) PG8_BAR;
    PG8_WAIT_V(2); PG8_BAR;
    PG8_STAGE(PG8_SB(1, 0), cB + kstep, voffB); PG8_STAGE(PG8_SA(1, 0), cA + kstep, aof0); PG8_STAGE(PG8_SB(1, 1), cB + hstep + kstep, voffB);
    PG8_WAIT_V(6); PG8_BAR;
#endif
    for (;;) {
        const bool has_next = S.next((ui + 1) / Sched::REPK, nxt);
        const char* nA = uptr(has_next ? S.aptr(nxt) : cA); const char* nB = uptr(has_next ? S.bptr(nxt) : cB);
        int ntok0[2], ntok1[2];
        if constexpr (Sched::GATHER) {
#pragma unroll
            for (int i = 0; i < 2; ++i) { int R, C; stage_rc((wid * 64 + hw_lane()) * 16 + i * 8192, R, C); ntok0[i] = S.arow_raw(has_next ? nxt : cur, R); ntok1[i] = S.arow_raw(has_next ? nxt : cur, HALF + R); }
        }
#if BAL_LDS
        PG8_SCHED; PG8_LDB(B0, 0, 0);
#endif
        for (int t = 0; t < nt; t += 2) {
            const bool last = (t == nt - 2);
            const char* a1 = cA + (size_t)(t + 1) * kstep;
            const char* a2 = last ? nA : cA + (size_t)(t + 2) * kstep; const char* b2 = last ? nB : cB + (size_t)(t + 2) * kstep;
            const char* a3 = a2 + kstep; const char* b3 = b2 + kstep;
#if BAL_LDS == 1
            const char* b1 = cB + (size_t)(t + 1) * kstep;
            PG8_LDA(At, 0, 0); PG8_STAGE_A1(PG8_SA(1, 1), a1); PG8_STAGE(PG8_SB(1, 1), b1 + hstep, voffB);
            PG8_WAIT_V(8); PG8_WAIT_L(0); PG8_BAR;
            PG8_LDB(B1, 0, 1); PG8_SCHED; PG8_MM(0, 0, At, B0); PG8_MM(0, 1, At, B1); PG8_BAR; PG8_SCHED;
            if constexpr (Sched::GATHER) { if (last) {
#pragma unroll
                for (int i = 0; i < 2; ++i) { int R, C; stage_rc((wid * 64 + hw_lane()) * 16 + i * 8192, R, C); aof0[i] = S.arow_fin(ntok0[i]) + (unsigned)C * 2u; aof1[i] = S.arow_fin(ntok1[i]) + (unsigned)C * 2u; } } }
            PG8_LDA(At, 0, 1); PG8_STAGE(PG8_SB(0, 0), b2, voffB); PG8_STAGE(PG8_SA(0, 0), a2, aof0);
            PG8_WAIT_V(8); PG8_WAIT_L(0); PG8_BAR;
            PG8_MM(1, 0, At, B0); PG8_SCHED; PG8_LDB(B0, 1, 0); PG8_SCHED; PG8_MM(1, 1, At, B1); PG8_BAR; PG8_SCHED;
            PG8_LDA(At, 1, 0); PG8_STAGE_A1(PG8_SA(0, 1), a2); PG8_STAGE(PG8_SB(0, 1), b2 + hstep, voffB);
            PG8_WAIT_V(8); PG8_WAIT_L(0); PG8_BAR;
            PG8_LDB(B1, 1, 1); PG8_SCHED; PG8_MM(0, 0, At, B0); PG8_MM(0, 1, At, B1); PG8_BAR; PG8_SCHED;
            PG8_LDA(At, 1, 1); PG8_STAGE(PG8_SB(1, 0), b3, voffB); PG8_STAGE(PG8_SA(1, 0), a3, aof0);
            PG8_WAIT_V(8); PG8_WAIT_L(0); PG8_BAR;
            PG8_MM(1, 0, At, B0); PG8_SCHED; if (!last) PG8_LDB(B0, 0, 0); PG8_SCHED; PG8_MM(1, 1, At, B1); PG8_BAR; PG8_SCHED;
#else
            if (BAL_LDS != 2) PG8_LDB(B0, 0, 0); PG8_LDB(B1, 0, 1); PG8_SCHED; PG8_LDA(At, 0, 0); PG8_STAGE_A1(PG8_SA(1, 1), a1);
            PG8_WAIT_V(8); PG8_WAIT_L(0); PG8_BAR; PG8_MM(0, 0, At, B0); PG8_MM(0, 1, At, B1); PG8_BAR; PG8_SCHED;
            if constexpr (Sched::GATHER) { if (last) {
#pragma unroll
                for (int i = 0; i < 2; ++i) { int R, C; stage_rc((wid * 64 + hw_lane()) * 16 + i * 8192, R, C); aof0[i] = S.arow_fin(ntok0[i]) + (unsigned)C * 2u; aof1[i] = S.arow_fin(ntok1[i]) + (unsigned)C * 2u; } } }
            PG8_LDA(At, 0, 1); PG8_STAGE(PG8_SB(0, 0), b2, voffB); PG8_STAGE(PG8_SB(0, 1), b2 + hstep, voffB); PG8_STAGE(PG8_SA(0, 0), a2, aof0);
            PG8_WAIT_V(8); PG8_WAIT_L(0); PG8_BAR; PG8_MM(1, 0, At, B0); if (BAL_LDS == 2) { PG8_SCHED; PG8_LDB(B0, 1, 0); PG8_SCHED; } PG8_MM(1, 1, At, B1); PG8_BAR; PG8_SCHED;
            if (BAL_LDS != 2) PG8_LDB(B0, 1, 0); PG8_LDB(B1, 1, 1); PG8_SCHED; PG8_LDA(At, 1, 0); PG8_STAGE_A1(PG8_SA(0, 1), a2);
            PG8_WAIT_V(8); PG8_WAIT_L(0); PG8_BAR; PG8_MM(0, 0, At, B0); PG8_MM(0, 1, At, B1); PG8_BAR; PG8_SCHED;
            PG8_LDA(At, 1, 1); PG8_STAGE(PG8_SB(1, 0), b3, voffB); PG8_STAGE(PG8_SB(1, 1), b3 + hstep, voffB); PG8_STAGE(PG8_SA(1, 0), a3, aof0);
            PG8_WAIT_V(8); PG8_WAIT_L(0); PG8_BAR; PG8_MM(1, 0, At, B0); if (BAL_LDS == 2) { PG8_SCHED; if (!last) PG8_LDB(B0, 0, 0); PG8_SCHED; } PG8_MM(1, 1, At, B1); PG8_BAR; PG8_SCHED;
#endif
        }
        if constexpr (ALIGN_EPI) { if (wr == 0) PG8_BAR; }
#if BG_DEFER
        PG8_SCHED; bg.finish(); bg.issue(ui); PG8_SCHED;
#else
        bg.issue(ui);
#endif
        if (Sched::REPK == 1 || (ui % Sched::REPK) == Sched::REPK - 1) { for (int re = 0; re < Sched::REPE * Epi::REPE; ++re) E(acc, cur, wr, wc, fr, fq); }
#if !BG_DEFER
        PG8_SCHED; bg.finish(); PG8_SCHED;
#endif
        if (!has_next) break;
#pragma unroll
        for (int a = 0; a < 2; ++a)
#pragma unroll
            for (int b = 0; b < 2; ++b)
#pragma unroll
                for (int m = 0; m < 4; ++m)
#pragma unroll
                    for (int n = 0; n < 2; ++n) acc[a][b][m][n] = (f32x4){0.f, 0.f, 0.f, 0.f};
        cur = nxt; cA = nA; cB = nB; ++ui;
        if constexpr (!Sched::GATHER) {   }
        if constexpr (ALIGN_EPI) { if (wr == 1) PG8_BAR; }
    }
#if BG_DEFER
    bg.finish();
#endif
    PG8_WAIT_V(0);
    if constexpr (!ALIGN_EPI) { if (wr == 0) PG8_BAR; }
    PG8_BAR;
}
#else
struct NoPre { __device__ __forceinline__ void operator()() const {} };
struct NoBg { __device__ __forceinline__ void issue(int) {} __device__ __forceinline__ void finish() {} };
template <class Epi, class Sched, bool ALIGN_EPI, class Pre = NoPre, class Bg = NoBg>
__device__ __forceinline__ void gemm_phase(LAS unsigned char* lds, const Sched& S, const Epi& E, const int wid, const Pre& pre = Pre(), Bg bg = Bg()) {
    const int lane = hw_lane(), tid = wid * 64 + lane, wr = wid >> 2, wc = wid & 3, fr = lane & 15, fq = lane >> 4;
    const int K = S.KB / 2; static_assert(!Sched::FP8, "naive body is bf16 only");
    Unit cur;
    for (int ui = 0; S.next(ui, cur); ++ui) {
        f32x4 acc[2][2][4][2];
        const char* cA = S.aptr(cur); const char* cB = S.bptr(cur);
#pragma unroll
        for (int ai = 0; ai < 2; ++ai)
#pragma unroll
            for (int m = 0; m < 4; ++m) {
                const char* arow = cA + S.arow(cur, ai * HALF + wr * 64 + m * 16 + fr);
#pragma unroll
                for (int bj = 0; bj < 2; ++bj)
#pragma unroll
                    for (int n = 0; n < 2; ++n) {
                        float s[4] = {0.f, 0.f, 0.f, 0.f};
                        const int c0 = bj * HALF + wc * 32 + (Epi::PERM ? (8 * fq + 4 * n) : (16 * n + 4 * fq));
                        for (int k = 0; k < K; k += 8) {
                            const u32x4 av = *(const u32x4*)(arow + (size_t)k * 2);
#pragma unroll
                            for (int i = 0; i < 4; ++i) {
                                const u32x4 bv = *(const u32x4*)(cB + ((size_t)(c0 + i) * K + k) * 2);
                                s[i] += bflo(av.x) * bflo(bv.x) + bfhi(av.x) * bfhi(bv.x) + bflo(av.y) * bflo(bv.y) + bfhi(av.y) * bfhi(bv.y)
                                      + bflo(av.z) * bflo(bv.z) + bfhi(av.z) * bfhi(bv.z) + bflo(av.w) * bflo(bv.w) + bfhi(av.w) * bfhi(bv.w);
                            }
                        }
                        acc[ai][bj][m][n] = (f32x4){s[0], s[1], s[2], s[3]};
                    }
            }
        bg.issue(ui); E(acc, cur, wr, wc, fr, fq); bg.finish();
    }
    (void)lds;
}
#endif
}

constexpr size_t MiB = 1u << 20;
constexpr size_t WS_CTL = 0, CTL_ZERO_BYTES = 1 * MiB;
constexpr size_t WS_MISC = 1 * MiB;
constexpr size_t WS_ROPE = 2 * MiB;
constexpr size_t WS_SSQ = 5 * MiB;
constexpr size_t WS_TOKEP = 7 * MiB;
constexpr size_t WS_TOKG = 7 * MiB + 512 * 1024;
constexpr size_t WS_LRSTD = 8 * MiB;
constexpr size_t WS_LIST = 9 * MiB;
constexpr size_t WS_WIN = 10 * MiB, WS_WOUT = 16 * MiB, WS_WGU = 18 * MiB, WS_WD = 32 * MiB, WS_WQKV = 39 * MiB, WS_WO = 42 * MiB;
constexpr size_t WS_EWGU = 44 * MiB, WS_EWD = 100 * MiB;
constexpr size_t WS_XQ = 128 * MiB;
constexpr size_t WS_HB = 160 * MiB;
constexpr size_t WS_ACT = 224 * MiB;
constexpr size_t WS_BC = WS_ACT, WS_VC = WS_ACT + 64 * MiB, WS_YC = WS_ACT + 128 * MiB, WS_HD = WS_ACT;
constexpr size_t WS_Q = WS_ACT, WS_KB = WS_ACT + 64 * MiB, WS_VB = WS_ACT + 80 * MiB, WS_O = WS_ACT + 128 * MiB;
constexpr size_t WS_Y = WS_ACT, WS_HM = WS_ACT + 132 * MiB;
constexpr size_t WS_YP = 480 * MiB;
constexpr size_t WS_END = 508 * MiB;
constexpr size_t WS_WGU8 = 508 * MiB, WS_WD8 = 516 * MiB, WS_END2 = 520 * MiB;
constexpr int DOWN_MAIN_TILES = 256, DOWN_KS = 7;
constexpr size_t HM_TILE_BYTES = (size_t)256 * DFF;
constexpr int HM_OUT_TILES = 146, HM_WS_TILES = 118, MAX_TILES = 264;
static_assert(HM_OUT_TILES * HM_TILE_BYTES <= (size_t)M * D * 4 && WS_HM + HM_WS_TILES * HM_TILE_BYTES <= WS_END && WS_Y + (size_t)MAX_TILES * 256 * D * 2 <= WS_HM, "MoE map");
static_assert(HM_OUT_TILES + HM_WS_TILES >= MAX_TILES && WS_HD + (size_t)M * DFF * 2 <= WS_END, "capacity");
constexpr float H1Q_SCALE = 16.f, WGU8_SCALE = 256.f, HDQ_SCALE = 8.f, WD8_SCALE = 512.f;
constexpr float XQ_SCALE = 32.f, WGU_SCALE = 256.f, HQ_SCALE = 8.f, WD_SCALE = 16.f;
constexpr size_t MS_MB = 0, MS_BM = 64 * 1024, MS_VM = 128 * 1024, MS_YCM = 192 * 1024, MS_HM = 256 * 1024, MS_HMB = 320 * 1024, MS_HDM = 384 * 1024,
                 MS_SSQ0 = 512 * 1024, MS_SSQ1 = 513 * 1024, MS_SSQ2 = 516 * 1024, MS_KM = 528 * 1024, MS_VMETA = 536 * 1024;
constexpr int CW_TMO = 0, CW_CODE = 1, CW_BAR = 4096, CW_CNT = 16384;
constexpr int RING_BYTES = 131072, LDSCTL_OFF = RING_BYTES, MISC_OFF = LDSCTL_OFF + 320, LDS_BYTES = 147456;
constexpr int NWAVES = 8;

#define RLX_AGENT __ATOMIC_RELAXED, __HIP_MEMORY_SCOPE_AGENT
#define LDS_WAIT() asm volatile("s_waitcnt lgkmcnt(0)" ::: "memory")
#define VM_WAIT() asm volatile("s_waitcnt vmcnt(0)" ::: "memory")
__device__ __forceinline__ unsigned f2bf(float f) { unsigned u = __builtin_bit_cast(unsigned, f); return (u + 0x7fffu + ((u >> 16) & 1u)) >> 16; }
__device__ __forceinline__ unsigned pk2(float lo, float hi) { return f2bf(lo) | (f2bf(hi) << 16); }
__device__ __forceinline__ float clamp8(float v) { return __builtin_amdgcn_fmed3f(v, -448.f, 448.f); }
__device__ __forceinline__ unsigned pk4_fp8(float a, float b, float c, float d) { unsigned w = 0u; w = (unsigned)__builtin_amdgcn_cvt_pk_fp8_f32(clamp8(a), clamp8(b), (int)w, false); w = (unsigned)__builtin_amdgcn_cvt_pk_fp8_f32(clamp8(c), clamp8(d), (int)w, true); return w; }

namespace pg8 {
__device__ __forceinline__ float rstd_from_ssq(const float* ssq, int row) {
    const f32x4* p = (const f32x4*)((const char*)ssq + (unsigned)row * 64u);
    const f32x4 a = p[0], b = p[1], c = p[2], d = p[3];
    const float s = (((a.x + a.y) + (a.z + a.w)) + ((b.x + b.y) + (b.z + b.w))) + (((c.x + c.y) + (c.z + c.w)) + ((d.x + d.y) + (d.z + d.w)));
    return __builtin_amdgcn_rsqf(s * (1.0f / (float)D) + RMS_EPS);
}
__device__ __forceinline__ u32x4 pack8(const f32x4 v0, const f32x4 v1) { u32x4 w; w.x = cvt_pk_bf16(v0[0], v0[1]); w.y = cvt_pk_bf16(v0[2], v0[3]); w.z = cvt_pk_bf16(v1[0], v1[1]); w.w = cvt_pk_bf16(v1[2], v1[3]); return w; }
__device__ __forceinline__ float silu_mul(float g, float u) { return g * u * __builtin_amdgcn_rcpf(1.0f + __builtin_amdgcn_exp2f(-g * LOG2E)); }

constexpr int RSTD_TAB_OFF = RING_BYTES_ + 1024, RSTD_TAB_MAX_UNITS = 14;
template <class Sched>
__device__ __forceinline__ void rstd_table_fill(const Sched& S, const float* ssq, LAS float* tab, int tid) {
    LAS int* pml = (LAS int*)(tab + RSTD_TAB_MAX_UNITS * BM);
    Unit u; int n = 0;
    for (int i = 0; S.next(i, u); ++i) if (i < RSTD_TAB_MAX_UNITS) { if (tid == 0) pml[i] = u.pm; n = i + 1; }
    __syncthreads();
#pragma unroll 4
    for (int idx = tid; idx < n * BM; idx += NWAVES * 64) tab[idx] = rstd_from_ssq(ssq, pml[idx >> 8] * BM + (idx & (BM - 1)));
}
static_assert(RSTD_TAB_OFF + RSTD_TAB_MAX_UNITS * BM * 4 + RSTD_TAB_MAX_UNITS * 4 <= LDS_BYTES, "rstd table");
struct EpiConvIn {
    static constexpr bool PERM = true; static constexpr int REPE = PROBE_DEPI;
    bf16* Bc; bf16* Vc; const LAS float* rtab;
    __device__ __forceinline__ void operator()(const f32x4 (&acc)[2][2][4][2], const Unit& u, int wr, int wc, int fr, int fq) const {
        int row0 = u.pm * BM + wr * 64 + fr; asm volatile("" : "+v"(row0));
#pragma unroll
        for (int ai = 0; ai < 2; ++ai)
#pragma unroll
            for (int m = 0; m < 4; ++m) {
                const int row = row0 + ai * HALF + m * 16; const float r = rtab[u.lt * BM + ai * HALF + wr * 64 + m * 16 + fr];
                if (u.pn < 4) {
#pragma unroll
                    for (int bj = 0; bj < 2; ++bj) __builtin_nontemporal_store(pack8(acc[ai][bj][m][0] * r, acc[ai][bj][m][1] * r), (u32x4*)((char*)Bc + (unsigned)(row * D + u.pn * BM + bj * HALF + wc * 32 + 8 * fq) * 2u));
                } else {
                    const float r2 = r * r;
                    __builtin_nontemporal_store(pack8(acc[ai][0][m][0] * acc[ai][1][m][0] * r2, acc[ai][0][m][1] * acc[ai][1][m][1] * r2), (u32x4*)((char*)Vc + (unsigned)(row * D + (u.pn - 4) * HALF + wc * 32 + 8 * fq) * 2u));
                }
            }
    }
};
template <bool Q8 = false, bool HALFB = false>
struct EpiResidT {
    static constexpr bool PERM = true; static constexpr int REPE = 1;
    bf16* hb; float* ssq; float sc  ; unsigned char* q8  ;
    __device__ __forceinline__ void operator()(const f32x4 (&acc)[2][2][4][2], const Unit& u, int wr, int wc, int fr, int fq) const {
        int row0 = u.pm * BM + wr * 64 + fr; asm volatile("" : "+v"(row0));
        unsigned off0 = (unsigned)(row0 * D + u.pn * BM + wc * 32 + 8 * fq) * 2u; asm volatile("" : "+v"(off0));
        char* hp = (char*)sopaque((const char*)hb);
        u32x4 b[2][4][2];
#pragma unroll
        for (int ai = 0; ai < (HALFB ? 1 : 2); ++ai)
#pragma unroll
            for (int m = 0; m < 4; ++m)
#pragma unroll
                for (int bj = 0; bj < 2; ++bj) b[ai][m][bj] = *(const GAS u32x4*)(hp + (off0 + (unsigned)(((ai * HALF + m * 16) * D + bj * HALF) * 2)));
#pragma unroll
        for (int ai = 0; ai < 2; ++ai) {
            if (HALFB && ai == 1) {
#pragma unroll
                for (int m = 0; m < 4; ++m)
#pragma unroll
                    for (int bj = 0; bj < 2; ++bj) b[1][m][bj] = *(const GAS u32x4*)(hp + (off0 + (unsigned)(((HALF + m * 16) * D + bj * HALF) * 2)));
            }
#pragma unroll
            for (int m = 0; m < 4; ++m) {
                const int row = row0 + ai * HALF + m * 16; float q = 0.f;
#pragma unroll
                for (int bj = 0; bj < 2; ++bj) {
                    const u32x4 bb = b[ai][m][bj];
                    const f32x4 v0 = acc[ai][bj][m][0] * sc + (f32x4){bflo(bb.x), bfhi(bb.x), bflo(bb.y), bfhi(bb.y)}, v1 = acc[ai][bj][m][1] * sc + (f32x4){bflo(bb.z), bfhi(bb.z), bflo(bb.w), bfhi(bb.w)};
                    const u32x4 pk = pack8(v0, v1);
                    *(GAS u32x4*)(hp + (off0 + (unsigned)(((ai * HALF + m * 16) * D + bj * HALF) * 2))) = pk;
                    if constexpr (Q8) {
                        const f32x4 w0 = v0 * H1Q_SCALE, w1 = v1 * H1Q_SCALE;
                        *(GAS u32x2*)((char*)sopaque((const char*)q8) + ((off0 >> 1) + (unsigned)((ai * HALF + m * 16) * D + bj * HALF))) = (u32x2){pk4_fp8(w0[0], w0[1], w0[2], w0[3]), pk4_fp8(w1[0], w1[1], w1[2], w1[3])};
                    }
                    q += ((v0[0] * v0[0] + v0[1] * v0[1]) + (v0[2] * v0[2] + v0[3] * v0[3])) + ((v1[0] * v1[0] + v1[1] * v1[1]) + (v1[2] * v1[2] + v1[3] * v1[3]));
                }
                q += __shfl_xor(q, 16); q += __shfl_xor(q, 32);
                if (fq == 0) *(float*)((char*)ssq + (unsigned)(row * 16 + u.pn * 4 + wc) * 4u) = q;
            }
        }
    }
};
typedef EpiResidT<false, false> EpiResid;
template <bool OUT8 = true>
struct EpiSwiGLU8T {
    static constexpr bool PERM = true; static constexpr int REPE = PROBE_DEPI;
    unsigned char* H; const LAS float* rtab;
    __device__ __forceinline__ void operator()(const f32x4 (&acc)[2][2][4][2], const Unit& u, int wr, int wc, int fr, int fq) const {
        int row0 = u.pm * BM + wr * 64 + fr; asm volatile("" : "+v"(row0));
        constexpr float s = 1.0f / (H1Q_SCALE * WGU8_SCALE);
#pragma unroll
        for (int ai = 0; ai < 2; ++ai)
#pragma unroll
            for (int m = 0; m < 4; ++m) {
                const int row = row0 + ai * HALF + m * 16; const float r = rtab[u.lt * BM + ai * HALF + wr * 64 + m * 16 + fr] * s; const float c1 = -r * LOG2E, c3 = __builtin_amdgcn_rcpf(r * r * (OUT8 ? HDQ_SCALE : 1.0f));
                f32x4 h[2];
#pragma unroll
                for (int n = 0; n < 2; ++n) {
                    const f32x4 g = acc[ai][0][m][n], uu = acc[ai][1][m][n]; const f32x4 t = g * c1; f32x4 e;
#pragma unroll
                    for (int i = 0; i < 4; ++i) e[i] = __builtin_amdgcn_exp2f(t[i]);
                    const f32x4 d = e * c3 + c3; f32x4 rr;
#pragma unroll
                    for (int i = 0; i < 4; ++i) rr[i] = __builtin_amdgcn_rcpf(d[i]);
                    h[n] = (g * uu) * rr;
                }
                if constexpr (OUT8) { if (HD_NT) __builtin_nontemporal_store((u32x2){pk4_fp8(h[0][0], h[0][1], h[0][2], h[0][3]), pk4_fp8(h[1][0], h[1][1], h[1][2], h[1][3])}, (u32x2*)((char*)H + (unsigned)(row * DFF + u.pn * HALF + wc * 32 + 8 * fq)));
                    else *(u32x2*)((char*)H + (unsigned)(row * DFF + u.pn * HALF + wc * 32 + 8 * fq)) = (u32x2){pk4_fp8(h[0][0], h[0][1], h[0][2], h[0][3]), pk4_fp8(h[1][0], h[1][1], h[1][2], h[1][3])}; }
                else __builtin_nontemporal_store(pack8(h[0], h[1]), (u32x4*)((char*)H + (unsigned)(row * DFF + u.pn * HALF + wc * 32 + 8 * fq) * 2u));
            }
    }
};
struct EpiSwiGLU {
    static constexpr bool PERM = true; static constexpr int REPE = PROBE_DEPI;
    bf16* H; const LAS float* rtab;
    __device__ __forceinline__ void operator()(const f32x4 (&acc)[2][2][4][2], const Unit& u, int wr, int wc, int fr, int fq) const {
        int row0 = u.pm * BM + wr * 64 + fr; asm volatile("" : "+v"(row0));
#pragma unroll
        for (int ai = 0; ai < 2; ++ai)
#pragma unroll
            for (int m = 0; m < 4; ++m) {
                const int row = row0 + ai * HALF + m * 16; const float r = rtab[u.lt * BM + ai * HALF + wr * 64 + m * 16 + fr]; const float c1 = -r * LOG2E, c3 = __builtin_amdgcn_rcpf(r * r);
                f32x4 h[2];
#pragma unroll
                for (int n = 0; n < 2; ++n) {
                    const f32x4 g = acc[ai][0][m][n], uu = acc[ai][1][m][n]; const f32x4 t = g * c1; f32x4 e;
#pragma unroll
                    for (int i = 0; i < 4; ++i) e[i] = __builtin_amdgcn_exp2f(t[i]);
                    const f32x4 d = e * c3 + c3; f32x4 rr;
#pragma unroll
                    for (int i = 0; i < 4; ++i) rr[i] = __builtin_amdgcn_rcpf(d[i]);
                    h[n] = (g * uu) * rr;
                }
                __builtin_nontemporal_store(pack8(h[0], h[1]), (u32x4*)((char*)H + (unsigned)(row * DFF + u.pn * HALF + wc * 32 + 8 * fq) * 2u));
            }
    }
};
struct EpiQKV {
    static constexpr bool PERM = true; static constexpr int REPE = PROBE_DEPI;
    bf16* Q; bf16* Kb; bf16* Vb; const LAS float* rtab; const float* bias; const f32x2* rope;
    __device__ __forceinline__ void operator()(const f32x4 (&acc)[2][2][4][2], const Unit& u, int wr, int wc, int fr, int fq) const {
        int row0 = u.pm * BM + wr * 64 + fr; asm volatile("" : "+v"(row0));
        if (u.pn < 5) {
            const int cb = (u.pn < 4 ? u.pn * BM : D) + wc * 64 + 8 * fq;
            const f32x4 b00 = *(const f32x4*)(bias + cb), b01 = *(const f32x4*)(bias + cb + 4), b10 = *(const f32x4*)(bias + cb + 32), b11 = *(const f32x4*)(bias + cb + 36);
            const float sc = u.pn < 4 ? QSCALE : 1.0f;
#if QKV_PIPE
            const char* rbase = sopaque((const char*)rope);
            unsigned roff = (unsigned)((NMETA + (row0 & (SEQ - 1))) * 32 + 8 * fq) * 8u; asm volatile("" : "+v"(roff));
            f32x4 rq[8][4];
#pragma unroll
            for (int it = 0; it < 4; ++it)
#pragma unroll
                for (int j = 0; j < 4; ++j) rq[it][j] = *(const GAS f32x4*)(rbase + (roff + (unsigned)((((it >> 2) * HALF + (it & 3) * 16) * 32) * 8 + j * 16)));
#pragma unroll
            for (int it = 0; it < 8; ++it) {
                    const int ai = it >> 2, m = it & 3;
                    const int row = row0 + ai * HALF + m * 16; const float r = rtab[u.lt * BM + ai * HALF + wr * 64 + m * 16 + fr];
                    f32x4 lo0 = acc[ai][0][m][0] * r + b00, lo1 = acc[ai][0][m][1] * r + b01, hi0 = acc[ai][1][m][0] * r + b10, hi1 = acc[ai][1][m][1] * r + b11;
                    f32x4 ol0, ol1, oh0, oh1;
#pragma unroll
                    for (int i = 0; i < 4; ++i) {
                        const f32x2 c0 = {rq[it][i >> 1][2 * (i & 1)], rq[it][i >> 1][2 * (i & 1) + 1]}, c1 = {rq[it][2 + (i >> 1)][2 * (i & 1)], rq[it][2 + (i >> 1)][2 * (i & 1) + 1]};
                        ol0[i] = (lo0[i] * c0.x - hi0[i] * c0.y) * sc; oh0[i] = (hi0[i] * c0.x + lo0[i] * c0.y) * sc;
                        ol1[i] = (lo1[i] * c1.x - hi1[i] * c1.y) * sc; oh1[i] = (hi1[i] * c1.x + lo1[i] * c1.y) * sc;
                    }
                    if (u.pn < 4) { char* p = (char*)Q + (unsigned)(row * D + u.pn * BM + wc * 64 + 8 * fq) * 2u; *(u32x4*)p = pack8(ol0, ol1); *(u32x4*)(p + 64) = pack8(oh0, oh1); }
                    else          { char* p = (char*)Kb + (unsigned)(row * KVD + wc * 64 + 8 * fq) * 2u;          *(u32x4*)p = pack8(ol0, ol1); *(u32x4*)(p + 64) = pack8(oh0, oh1); }
                    if (it + 4 < 8) {
#pragma unroll
                        for (int j = 0; j < 4; ++j) rq[it + 4][j] = *(const GAS f32x4*)(rbase + (roff + (unsigned)(((((it + 4) >> 2) * HALF + ((it + 4) & 3) * 16) * 32) * 8 + j * 16)));
                    }
            }
#else
#pragma unroll
            for (int ai = 0; ai < 2; ++ai)
#pragma unroll
                for (int m = 0; m < 4; ++m) {
                    const int row = row0 + ai * HALF + m * 16; const float r = rtab[u.lt * BM + ai * HALF + wr * 64 + m * 16 + fr];
                    const f32x2* rp = (const f32x2*)((const char*)rope + (unsigned)((NMETA + (row & (SEQ - 1))) * 32 + 8 * fq) * 8u);
                    f32x4 lo0 = acc[ai][0][m][0] * r + b00, lo1 = acc[ai][0][m][1] * r + b01, hi0 = acc[ai][1][m][0] * r + b10, hi1 = acc[ai][1][m][1] * r + b11;
                    f32x4 ol0, ol1, oh0, oh1;
#pragma unroll
                    for (int i = 0; i < 4; ++i) {
                        const f32x2 c0 = rp[i], c1 = rp[4 + i];
                        ol0[i] = (lo0[i] * c0.x - hi0[i] * c0.y) * sc; oh0[i] = (hi0[i] * c0.x + lo0[i] * c0.y) * sc;
                        ol1[i] = (lo1[i] * c1.x - hi1[i] * c1.y) * sc; oh1[i] = (hi1[i] * c1.x + lo1[i] * c1.y) * sc;
                    }
                    if (u.pn < 4) { char* p = (char*)Q + (unsigned)(row * D + u.pn * BM + wc * 64 + 8 * fq) * 2u; *(u32x4*)p = pack8(ol0, ol1); *(u32x4*)(p + 64) = pack8(oh0, oh1); }
                    else          { char* p = (char*)Kb + (unsigned)(row * KVD + wc * 64 + 8 * fq) * 2u;          *(u32x4*)p = pack8(ol0, ol1); *(u32x4*)(p + 64) = pack8(oh0, oh1); }
                }
#endif
        } else {
#pragma unroll
            for (int bj = 0; bj < 2; ++bj) {
                const int c = bj * HALF + wc * 32 + 8 * fq;
                const f32x4 b0 = *(const f32x4*)(bias + D + KVD + c), b1 = *(const f32x4*)(bias + D + KVD + c + 4);
#pragma unroll
                for (int ai = 0; ai < 2; ++ai)
#pragma unroll
                    for (int m = 0; m < 4; ++m) {
                        const int row = row0 + ai * HALF + m * 16; const float r = rtab[u.lt * BM + ai * HALF + wr * 64 + m * 16 + fr];
                        *(u32x4*)((char*)Vb + (unsigned)(row * KVD + c) * 2u) = pack8(acc[ai][bj][m][0] * r + b0, acc[ai][bj][m][1] * r + b1);
                    }
            }
        }
    }
};
}
#define XB_TMO      128
#define XB_XCNT(j)  (256  + 64 * (j))
#define XB_XSUB(j)  (1280 + 64 * (j))
#define XB_XGEN(j)  (2304 + 64 * (j))
#define XB_TOP      3328
#define XB_TOPGEN   3392
#define XCD_BAR_WORDS 3456
#define XB_SPIN_CAP (1u << 18)

__device__ __forceinline__ unsigned xb_ld(unsigned* p)              { return __hip_atomic_load(p, __ATOMIC_RELAXED, __HIP_MEMORY_SCOPE_AGENT); }
__device__ __forceinline__ unsigned xb_add(unsigned* p, unsigned v) { return __hip_atomic_fetch_add(p, v, __ATOMIC_RELAXED, __HIP_MEMORY_SCOPE_AGENT); }
__device__ __forceinline__ unsigned xb_xcc_id() { return (unsigned)__builtin_amdgcn_s_getreg((3 << 11) | 20) & 0xFu; }
#define XB_SPIN(cond, bar) do { unsigned _sp = 0; while (cond) { __builtin_amdgcn_s_sleep(1); \
    if ((++_sp & 255u) == 0u) { if (xb_ld(&(bar)[XB_TMO])) break; if (_sp > XB_SPIN_CAP) { atomicAdd(&(bar)[XB_TMO], 1u); break; } } } } while (0)

struct XcdBarrier {
    unsigned* bar; unsigned x;
    volatile LAS unsigned* st;
};

__device__ __forceinline__ XcdBarrier xcd_barrier_post(unsigned* bar, volatile LAS unsigned* st, int wave) {
    XcdBarrier b; b.bar = bar; b.x = xb_xcc_id(); b.st = st;
    if (wave == 0 && hw_lane() == 0) (void)xb_add(&bar[XB_XCNT(b.x)], 1u);
    return b;
}
__device__ __forceinline__ void xcd_barrier_complete(unsigned* bar, unsigned x, unsigned& nloc, unsigned& nx) {
    const unsigned G = gridDim.x * gridDim.y * gridDim.z;
    unsigned sum, cnt, mine, sp = 0u;
    for (;;) {
        sum = 0u; cnt = 0u; mine = 0u;
#pragma unroll
        for (unsigned j = 0; j < 16; ++j) { const unsigned c = xb_ld(&bar[XB_XCNT(j)]); sum += c; cnt += (c > 0u) ? 1u : 0u; mine = (j == x) ? c : mine; }
        if (sum == G) break;
        __builtin_amdgcn_s_sleep(1);
        if ((++sp & 255u) == 0u) { if (xb_ld(&bar[XB_TMO])) break; if (sp > XB_SPIN_CAP) { atomicAdd(&bar[XB_TMO], 1u); break; } }
    }
    nloc = mine > 0u ? mine : 1u; nx = cnt > 0u ? cnt : 1u;
}

__device__ __forceinline__ void xcd_barrier(const XcdBarrier& b, int wave) {
    asm volatile("s_waitcnt vmcnt(0)" ::: "memory");
    __syncthreads();
    if (wave == 0 && hw_lane() == 0) {
        unsigned* bar = b.bar;
        __builtin_amdgcn_s_waitcnt(0);
        unsigned nloc = b.st[0], nx = b.st[1];
        if (nloc == 0u) { xcd_barrier_complete(bar, b.x, nloc, nx); b.st[0] = nloc; b.st[1] = nx; }
        const unsigned old = xb_add(&bar[XB_XSUB(b.x)], 1u);
        const unsigned gen = old / nloc;
        if (old + 1u == (gen + 1u) * nloc) {
            __builtin_amdgcn_fence(__ATOMIC_RELEASE, "agent");
            asm volatile("s_waitcnt vmcnt(0)" ::: "memory");
            const unsigned og = xb_add(&bar[XB_TOP], 1u);
            const unsigned tg = og / nx;
            if (og + 1u == (tg + 1u) * nx) xb_add(&bar[XB_TOPGEN], 1u);
            else XB_SPIN(xb_ld(&bar[XB_TOPGEN]) == tg, bar);
            __builtin_amdgcn_fence(__ATOMIC_ACQUIRE, "agent");
            xb_add(&bar[XB_XGEN(b.x)], 1u);
            asm volatile("s_waitcnt vmcnt(0)" ::: "memory");
        } else {
            XB_SPIN(xb_ld(&bar[XB_XGEN(b.x)]) == gen, bar);
            __builtin_amdgcn_fence(__ATOMIC_ACQUIRE, "agent");
            asm volatile("s_waitcnt vmcnt(0)" ::: "memory");
        }
    }
    __syncthreads();
}

struct MoeInfo { int ts[9]; int cnt[8]; };
__device__ __forceinline__ void moe_info_load(const unsigned* ctl, MoeInfo& mi) {
    int t = 0;
#pragma unroll
    for (int e = 0; e < 8; ++e) { const int c = (int)__builtin_amdgcn_readfirstlane(__hip_atomic_load(ctl + CW_CNT + 64 * e, RLX_AGENT)); mi.cnt[e] = c; mi.ts[e] = t; t += (c + 255) >> 8; }
    mi.ts[8] = t;
}
__device__ __forceinline__ void moe_info_to_lds(const unsigned* ctl, LAS int* ml, int wave) {
    MoeInfo mi; moe_info_load(ctl, mi);
    if (wave == 0 && hw_lane() == 0) {
#pragma unroll
        for (int e = 0; e < 9; ++e) ml[e] = mi.ts[e];
#pragma unroll
        for (int e = 0; e < 8; ++e) ml[16 + e] = mi.cnt[e];
    }
    __syncthreads();
}
__device__ __forceinline__ void moe_find(const LAS int* ml, int T, int& e, int& ts, int& ne) {
    int ee = 0;
#pragma unroll
    for (int j = 1; j < 8; ++j) ee += (T >= ml[j]) ? 1 : 0;
    e = __builtin_amdgcn_readfirstlane(ee); ts = __builtin_amdgcn_readfirstlane(ml[e]); ne = __builtin_amdgcn_readfirstlane(ml[16 + e]);
}
__device__ __forceinline__ char* hm_tile_ptr(unsigned char* dout, unsigned char* ws, int ltc  ) {
    return (char*)(ltc < HM_OUT_TILES ? dout + (size_t)ltc * HM_TILE_BYTES : ws + WS_HM + (size_t)(ltc - HM_OUT_TILES) * HM_TILE_BYTES);
}
namespace pg8 {
struct MoeUpSched {
    static constexpr bool GATHER = true, FP8 = true; static constexpr int REPK = PROBE_KL, REPE = PROBE_EPI;
    const char* A; const char* Bt; const int* list; const LAS int* ml; int KB, nM, G, c, tbase; static constexpr int nN = NGU / 256;
    __device__ __forceinline__ bool next(int i, Unit& u) const {
        const int L = i * G + c; if (L >= nM * nN) return false;
        int pmc; order_unit(L, nM, nN, pmc, u.pn); const int T = tbase + pmc; int e, ts, ne; moe_find(ml, T, e, ts, ne);
        u.pm = T; u.e = e | (ne << 4); u.lt = T - ts; u.ord = i; return true; }
    __device__ __forceinline__ const char* aptr(const Unit&) const { return A; }
    __device__ __forceinline__ const char* bptr(const Unit& u) const { return Bt + ((size_t)(u.e & 15) * NGU + (size_t)u.pn * BM) * D; }
    __device__ __forceinline__ unsigned arow(const Unit& u, int r) const { const int idx = u.lt * BM + r; const int tok = idx < (u.e >> 4) ? list[(size_t)(u.e & 15) * M + idx] : 0; return (unsigned)tok * (unsigned)D; }
    __device__ __forceinline__ int arow_raw(const Unit& u, int r) const { const int ne = u.e >> 4; int idx = u.lt * BM + r; idx = idx < ne ? idx : ne - 1; return list[(size_t)(u.e & 15) * M + idx]; }
    __device__ __forceinline__ unsigned arow_fin(int tok) const { return (unsigned)tok * (unsigned)D; }    __device__ __forceinline__ int ktiles() const { return KB / (BK * 2); }
};
struct MoeDownSched {
    static constexpr bool GATHER = false, FP8 = true; static constexpr int REPK = 1, REPE = 1;
    unsigned char* dout; unsigned char* ws; const char* Bt; const LAS int* ml; int KB, nM, G, c, tbase; static constexpr int nN = D / 256;
    __device__ __forceinline__ bool next(int i, Unit& u) const {
        int L = i * G + c; if (L >= nM * nN) return false;
        if ((nM * nN) % G == 0) L = (nM * nN / G - 1 - i) * G + c;
        int pmc; order_unit(L, nM, nN, pmc, u.pn); const int T = tbase + pmc;
        int e, ts, ne; moe_find(ml, T, e, ts, ne);
        u.pm = T; u.e = e; u.lt = 0; return true; }
    __device__ __forceinline__ const char* aptr(const Unit& u) const { return hm_tile_ptr(dout, ws, u.pm - tbase); }
    __device__ __forceinline__ const char* bptr(const Unit& u) const { return Bt + ((size_t)(u.e & 15) * D + (size_t)u.pn * BM) * DFF; }
    __device__ __forceinline__ unsigned arow(const Unit&, int r) const { return (unsigned)r * (unsigned)DFF; }    __device__ __forceinline__ int ktiles() const { return KB / (BK * 2); }
};
struct MoeDownTailSched {
    static constexpr bool GATHER = false, FP8 = true; static constexpr int REPK = 1, REPE = 1;
    unsigned char* dout; unsigned char* ws; const char* Bt; const LAS int* ml; int KB, nsub, G, c;
    __device__ __forceinline__ bool next(int i, Unit& u) const {
        const int q = i * G + c; if (q >= nsub) return false;
        const int tr = q / (4 * DOWN_KS), rem = q % (4 * DOWN_KS); u.pn = rem / DOWN_KS; u.lt = rem % DOWN_KS; u.pm = DOWN_MAIN_TILES + tr;
        int e, ts, ne; moe_find(ml, u.pm, e, ts, ne); u.e = e; return true; }
    __device__ __forceinline__ const char* aptr(const Unit& u) const { return hm_tile_ptr(dout, ws, u.pm) + u.lt * 512; }
    __device__ __forceinline__ const char* bptr(const Unit& u) const { return Bt + ((size_t)(u.e & 15) * D + (size_t)u.pn * BM) * DFF + u.lt * 512; }
    __device__ __forceinline__ unsigned arow(const Unit&, int r) const { return (unsigned)r * (unsigned)DFF; }
    __device__ __forceinline__ int ktiles() const { int n = 4; asm volatile("" : "+s"(n)); return n; }
};

struct EpiMoeUp {
    static constexpr bool PERM = true; static constexpr int REPE = 1;
    unsigned char* dout; unsigned char* ws; int tbase;
    __device__ __forceinline__ void operator()(const f32x4 (&acc)[2][2][4][2], const Unit& u, int wr, int wc, int fr, int fq) const {
        constexpr float s = 1.0f / (XQ_SCALE * WGU_SCALE), c1 = -s * LOG2E, c3 = 1.0f / (s * s * HQ_SCALE);
        unsigned off0 = (unsigned)((wr * 64 + fr) * DFF + u.pn * HALF + wc * 32 + 8 * fq); asm volatile("" : "+v"(off0));
        char* H = (char*)pg8::sopaque(hm_tile_ptr(dout, ws, u.pm - tbase)) + off0;
#pragma unroll
        for (int ai = 0; ai < 2; ++ai)
#pragma unroll
            for (int m = 0; m < 4; ++m) {
                f32x4 h[2];
#pragma unroll
                for (int n = 0; n < 2; ++n) {
                    const f32x4 g = acc[ai][0][m][n], uu = acc[ai][1][m][n]; const f32x4 t = g * c1; f32x4 e;
#pragma unroll
                    for (int i = 0; i < 4; ++i) e[i] = __builtin_amdgcn_exp2f(t[i]);
                    const f32x4 d = e * c3 + c3; f32x4 r;
#pragma unroll
                    for (int i = 0; i < 4; ++i) r[i] = __builtin_amdgcn_rcpf(d[i]);
                    h[n] = (g * uu) * r;
                }
                const u32x2 hw = (u32x2){pk4_fp8(h[0][0], h[0][1], h[0][2], h[0][3]), pk4_fp8(h[1][0], h[1][1], h[1][2], h[1][3])};
                if (u.ord >= HM_PLAIN_FROM) *(u32x2*)(H + (ai * HALF + m * 16) * DFF) = hw; else __builtin_nontemporal_store(hw, (u32x2*)(H + (ai * HALF + m * 16) * DFF));
            }
    }
};
struct EpiMoeDown {
    static constexpr bool PERM = true; static constexpr int REPE = 1;
    unsigned char* Y;
    __device__ __forceinline__ void operator()(const f32x4 (&acc)[2][2][4][2], const Unit& u, int wr, int wc, int fr, int fq) const {
        unsigned off0 = (unsigned)((u.pm * BM + wr * 64 + fr) * D + u.pn * BM + wc * 32 + 8 * fq); asm volatile("" : "+v"(off0));
        char* Yp = (char*)pg8::sopaque((const char*)Y) + off0;
#pragma unroll
        for (int ai = 0; ai < 2; ++ai)
#pragma unroll
            for (int m = 0; m < 4; ++m)
#pragma unroll
                for (int bj = 0; bj < 2; ++bj) { const f32x4 v0 = acc[ai][bj][m][0], v1 = acc[ai][bj][m][1];
                    *(u32x2*)(Yp + (ai * HALF + m * 16) * D + bj * HALF) = (u32x2){pk4_fp8(v0[0], v0[1], v0[2], v0[3]), pk4_fp8(v1[0], v1[1], v1[2], v1[3])}; }
    }
};
struct EpiMoeDownPart {
    static constexpr bool PERM = true; static constexpr int REPE = 1;
    bf16* P;
    __device__ __forceinline__ void operator()(const f32x4 (&acc)[2][2][4][2], const Unit& u, int wr, int wc, int fr, int fq) const {
        unsigned off0 = (unsigned)((((u.pm - DOWN_MAIN_TILES) * 4 + u.pn) * DOWN_KS + u.lt) * 65536 + (wr * 64 + fr) * 256 + wc * 32 + 8 * fq) * 2u; asm volatile("" : "+v"(off0));
        char* Pp = (char*)pg8::sopaque((const char*)P) + off0;
#pragma unroll
        for (int ai = 0; ai < 2; ++ai)
#pragma unroll
            for (int m = 0; m < 4; ++m)
#pragma unroll
                for (int bj = 0; bj < 2; ++bj) *(u32x4*)(Pp + ((ai * HALF + m * 16) * 256 + bj * HALF) * 2) = pack8(acc[ai][bj][m][0], acc[ai][bj][m][1]);
    }
};
}

constexpr int META_LDS_OFF = RING_BYTES + 1024;
static_assert(META_LDS_OFF + 7 * 64 * 8 * 4 <= LDS_BYTES, "meta scratch");
template <class F>
__device__ __forceinline__ void meta_dual(LAS unsigned char* lds, const bf16* A, int K, const bf16* Bt, int n0, int n1, int lane, int wave, const F& epi) {
    const int r16 = lane & 15, kq = lane >> 4; const int kw = K / 8, kb = wave * kw;
    const bf16* ap = A + (size_t)r16 * K + kb + 8 * kq; const bf16* b0p = Bt + (size_t)(n0 + r16) * K + kb + 8 * kq; const bf16* b1p = Bt + (size_t)(n1 + r16) * K + kb + 8 * kq;
    f32x4 acc0 = (f32x4){0.f, 0.f, 0.f, 0.f}, acc1 = (f32x4){0.f, 0.f, 0.f, 0.f};
#pragma unroll 2
    for (int k = 0; k < kw; k += 64) {
        const bf16x8 a = *(const bf16x8*)(ap + k), b0 = *(const bf16x8*)(b0p + k), b1 = *(const bf16x8*)(b1p + k);
        const bf16x8 a2 = *(const bf16x8*)(ap + k + 32), b02 = *(const bf16x8*)(b0p + k + 32), b12 = *(const bf16x8*)(b1p + k + 32);
        acc0 = __builtin_amdgcn_mfma_f32_16x16x32_bf16(a, b0, acc0, 0, 0, 0); acc1 = __builtin_amdgcn_mfma_f32_16x16x32_bf16(a, b1, acc1, 0, 0, 0);
        acc0 = __builtin_amdgcn_mfma_f32_16x16x32_bf16(a2, b02, acc0, 0, 0, 0); acc1 = __builtin_amdgcn_mfma_f32_16x16x32_bf16(a2, b12, acc1, 0, 0, 0);
    }
    LAS f32x4* sc = (LAS f32x4*)(lds + META_LDS_OFF);
    if (wave > 0) { sc[((wave - 1) * 64 + lane) * 2] = acc0; sc[((wave - 1) * 64 + lane) * 2 + 1] = acc1; }
    __syncthreads();
    if (wave == 0) {
#pragma unroll
        for (int w = 0; w < 7; ++w) { acc0 += sc[(w * 64 + lane) * 2]; acc1 += sc[(w * 64 + lane) * 2 + 1]; }
        epi(acc0, acc1, r16, kq);
    }
}
__device__ __forceinline__ f32x4 meta_rstd_parts(const float* parts, int lane) {
    float s = 0.f;
    for (int j = 0; j < 32; ++j) s += parts[j * 16 + (lane & 15)];
    const float r = 1.0f / sqrtf(s * (1.0f / (float)D) + RMS_EPS); const int kq = lane >> 4; f32x4 o;
#pragma unroll
    for (int g = 0; g < 4; ++g) o[g] = __shfl(r, 4 * kq + g);
    return o;
}

__device__ __forceinline__ void p0_item(const float* W, int ldw, int K, int k0, int n0, bf16* dst, const float* gain, LAS float* scr, int lane) {
    { float t[32]; const float* wp = W + (size_t)(k0 + (lane >> 5)) * ldw + n0 + (lane & 31);
#pragma unroll
      for (int i = 0; i < 32; ++i) t[i] = wp[(size_t)(2 * i) * ldw];
#pragma unroll
      for (int i = 0; i < 32; ++i) scr[(2 * i + (lane >> 5)) * 33 + (lane & 31)] = t[i]; }
    LDS_WAIT(); asm volatile("" ::: "memory");
    const int c = lane & 7;
    float g[8];
#pragma unroll
    for (int e = 0; e < 8; ++e) g[e] = gain ? gain[k0 + 8 * c + e] : 1.0f;
#pragma unroll
    for (int j = 0; j < 4; ++j) { const int n = (lane >> 3) + 8 * j; const LAS float* s = scr + (8 * c) * 33 + n;
        u32x4 o; o.x = pk2(s[0 * 33] * g[0], s[1 * 33] * g[1]); o.y = pk2(s[2 * 33] * g[2], s[3 * 33] * g[3]); o.z = pk2(s[4 * 33] * g[4], s[5 * 33] * g[5]); o.w = pk2(s[6 * 33] * g[6], s[7 * 33] * g[7]);
        *(GAS u32x4*)(dst + (size_t)n * K + k0 + 8 * c) = o; }
    LDS_WAIT(); asm volatile("" ::: "memory");
}
__device__ __forceinline__ void p0_item_dual(const float* W, int ldw, int K, int k0, int n0, bf16* dst, unsigned char* dst8, const float* gain, float sc, LAS float* scr, int lane) {
    { float t[32]; const float* wp = W + (size_t)(k0 + (lane >> 5)) * ldw + n0 + (lane & 31);
#pragma unroll
      for (int i = 0; i < 32; ++i) t[i] = wp[(size_t)(2 * i) * ldw];
#pragma unroll
      for (int i = 0; i < 32; ++i) scr[(2 * i + (lane >> 5)) * 33 + (lane & 31)] = t[i]; }
    LDS_WAIT(); asm volatile("" ::: "memory");
    const int c = lane & 7;
    float g[8];
#pragma unroll
    for (int e = 0; e < 8; ++e) g[e] = gain ? gain[k0 + 8 * c + e] : 1.0f;
#pragma unroll
    for (int j = 0; j < 4; ++j) { const int n = (lane >> 3) + 8 * j; const LAS float* s = scr + (8 * c) * 33 + n;
        float v[8];
#pragma unroll
        for (int e = 0; e < 8; ++e) v[e] = s[e * 33] * g[e];
        u32x4 o; o.x = pk2(v[0], v[1]); o.y = pk2(v[2], v[3]); o.z = pk2(v[4], v[5]); o.w = pk2(v[6], v[7]);
        *(GAS u32x4*)(dst + (size_t)n * K + k0 + 8 * c) = o;
        u32x2 o8; o8.x = pk4_fp8(v[0] * sc, v[1] * sc, v[2] * sc, v[3] * sc); o8.y = pk4_fp8(v[4] * sc, v[5] * sc, v[6] * sc, v[7] * sc);
        *(GAS u32x2*)(dst8 + (size_t)n * K + k0 + 8 * c) = o8; }
    LDS_WAIT(); asm volatile("" ::: "memory");
}
__device__ __forceinline__ void p0_item8(const float* W, int ldw, int K, int k0, int n0, unsigned char* dst, const float* gain, float sc, LAS float* scr, int lane) {
    { float t[32]; const float* wp = W + (size_t)(k0 + (lane >> 5)) * ldw + n0 + (lane & 31);
#pragma unroll
      for (int i = 0; i < 32; ++i) t[i] = wp[(size_t)(2 * i) * ldw];
#pragma unroll
      for (int i = 0; i < 32; ++i) scr[(2 * i + (lane >> 5)) * 33 + (lane & 31)] = t[i]; }
    LDS_WAIT(); asm volatile("" ::: "memory");
    const int c = lane & 7;
    float g[8];
#pragma unroll
    for (int e = 0; e < 8; ++e) g[e] = (gain ? gain[k0 + 8 * c + e] : 1.0f) * sc;
#pragma unroll
    for (int j = 0; j < 4; ++j) { const int n = (lane >> 3) + 8 * j; const LAS float* s = scr + (8 * c) * 33 + n;
        u32x2 o; o.x = pk4_fp8(s[0 * 33] * g[0], s[1 * 33] * g[1], s[2 * 33] * g[2], s[3 * 33] * g[3]); o.y = pk4_fp8(s[4 * 33] * g[4], s[5 * 33] * g[5], s[6 * 33] * g[6], s[7 * 33] * g[7]);
        *(GAS u32x2*)(dst + (size_t)n * K + k0 + 8 * c) = o; }
    LDS_WAIT(); asm volatile("" ::: "memory");
}
__device__ __forceinline__ int ileave(int ch, int kind) { return 256 * (ch >> 7) + 128 * kind + (ch & 127); }

struct Args { const float* in[21]; float* out; unsigned char* ws; float inv[32]; int ph_lo, ph_hi; };

constexpr int EXP_ITEMS = 24 * 16 * 112, BG_ORDS = 20, BG_P1 = 6, BG_P4 = 14;
__device__ __forceinline__ int bg_cover(int G) { if (!BG_CVT) return 0; const int c = BG_ORDS * G * NWAVES; return c < EXP_ITEMS ? c : EXP_ITEMS; }
struct ExpertCvtBg {
    const float* gate; const float* up; const float* down; const float* gain; unsigned char* ws; int first, base_ord, nmax, gw, NGW;
    f32x4 t[8]; f32x4 gA, gB; unsigned char* dbase; unsigned doff; int K; float sc; bool active;
    __device__ __forceinline__ void issue(int ui) {
        const int r = first + (base_ord + ui) * NGW + gw;
        active = ui < nmax && r < EXP_ITEMS;
        if (!active) return;
        const int mat = r / (16 * 112), q = r - mat * (16 * 112), kind = mat >> 3, e = mat & 7;
        const int ln = hw_lane(), kq = ln >> 3, nq = ln & 7;
        const float* W; int ldw, k0, n0;
        if (kind < 2) { const int kb = q / 112, nb = q - kb * 112; k0 = kb * 64; n0 = nb * 32; W = (kind ? up : gate) + (size_t)e * D * DFF; ldw = DFF; K = D; sc = WGU_SCALE;
            dbase = ws + WS_EWGU + ((size_t)e * NGU + ileave(n0, kind)) * D; }
        else { const int kb = q >> 5, nb = q & 31; k0 = kb * 64; n0 = nb * 32; W = down + (size_t)e * DFF * D; ldw = D; K = DFF; sc = WD_SCALE; dbase = ws + WS_EWD + ((size_t)e * D + n0) * DFF; }
        const GAS float* wp = (const GAS float*)W + (size_t)(k0 + 8 * kq) * ldw + n0 + 4 * nq;
#pragma unroll
        for (int j = 0; j < 8; ++j) t[j] = *(const GAS f32x4*)(wp + (size_t)j * ldw);
        if (kind < 2) { gA = *(const GAS f32x4*)(gain + k0 + 8 * kq); gB = *(const GAS f32x4*)(gain + k0 + 8 * kq + 4); } else { gA = (f32x4){1.f, 1.f, 1.f, 1.f}; gB = gA; }
        doff = (unsigned)((4 * nq) * K + k0 + 8 * kq);
    }
    __device__ __forceinline__ void finish() {
        if (!active) return;
        active = false;
        const float g[8] = {gA.x * sc, gA.y * sc, gA.z * sc, gA.w * sc, gB.x * sc, gB.y * sc, gB.z * sc, gB.w * sc};
#pragma unroll
        for (int i = 0; i < 4; ++i) {
            u32x2 o; o.x = pk4_fp8(t[0][i] * g[0], t[1][i] * g[1], t[2][i] * g[2], t[3][i] * g[3]); o.y = pk4_fp8(t[4][i] * g[4], t[5][i] * g[5], t[6][i] * g[6], t[7][i] * g[7]);
            *(GAS u32x2*)(dbase + (doff + (unsigned)(i * K))) = o;
        }
    }
};

__device__ __forceinline__ void p0_prologue(const Args& a, LAS unsigned char* lds, int vcu, int G, int wave, int lane) {
    unsigned char* ws = a.ws;
    LAS float* scr = (LAS float*)(lds + wave * 16384);
    const int gw = vcu * NWAVES + wave, NGW = G * NWAVES;
    constexpr int I_WIN = 16 * 96, I_WOUT = 16 * 32, I_G = 16 * 112, I_DN = 56 * 32, I_QKV = 16 * 48, I_WO = 16 * 32;
    constexpr int NITEMS = I_WIN + I_WOUT + 2 * I_G + I_DN + I_QKV + I_WO + 24 * I_G;
    static_assert(I_DN == I_G, "item counts");
    const int nitems = NITEMS - bg_cover(G);
    for (int it = gw; it < nitems; it += NGW) {
        int r = it;
        if (r < I_WIN) { const int kb = r / 96, nb = r % 96, n0 = nb * 32; int d0;
            if (n0 < D) d0 = n0; else if (n0 < 2 * D) d0 = D + ileave(n0 - D, 0); else d0 = D + ileave(n0 - 2 * D, 1);
            p0_item(a.in[3], NCONV, D, kb * 64, n0, (bf16*)(ws + WS_WIN) + (size_t)d0 * D, a.in[2], scr, lane); continue; } r -= I_WIN;
        if (r < I_WOUT) { const int kb = r / 32, nb = r % 32; p0_item(a.in[5], D, D, kb * 64, nb * 32, (bf16*)(ws + WS_WOUT) + (size_t)(nb * 32) * D, nullptr, scr, lane); continue; } r -= I_WOUT;
        if (r < I_G) { const int kb = r / 112, nb = r % 112;
            if (FFN8) p0_item_dual(a.in[7], DFF, D, kb * 64, nb * 32, (bf16*)(ws + WS_WGU) + (size_t)ileave(nb * 32, 0) * D, ws + WS_WGU8 + (size_t)ileave(nb * 32, 0) * D, a.in[6], WGU8_SCALE, scr, lane);
            else p0_item(a.in[7], DFF, D, kb * 64, nb * 32, (bf16*)(ws + WS_WGU) + (size_t)ileave(nb * 32, 0) * D, a.in[6], scr, lane); continue; } r -= I_G;
        if (r < I_G) { const int kb = r / 112, nb = r % 112;
            if (FFN8) p0_item_dual(a.in[8], DFF, D, kb * 64, nb * 32, (bf16*)(ws + WS_WGU) + (size_t)ileave(nb * 32, 1) * D, ws + WS_WGU8 + (size_t)ileave(nb * 32, 1) * D, a.in[6], WGU8_SCALE, scr, lane);
            else p0_item(a.in[8], DFF, D, kb * 64, nb * 32, (bf16*)(ws + WS_WGU) + (size_t)ileave(nb * 32, 1) * D, a.in[6], scr, lane); continue; } r -= I_G;
        if (r < I_DN) { const int kb = r / 32, nb = r % 32;
            if (FFN8) p0_item_dual(a.in[9], D, DFF, kb * 64, nb * 32, (bf16*)(ws + WS_WD) + (size_t)(nb * 32) * DFF, ws + WS_WD8 + (size_t)(nb * 32) * DFF, nullptr, WD8_SCALE, scr, lane);
            else p0_item(a.in[9], D, DFF, kb * 64, nb * 32, (bf16*)(ws + WS_WD) + (size_t)(nb * 32) * DFF, nullptr, scr, lane); continue; } r -= I_DN;
        if (r < I_QKV) { const int kb = r / 48, nb = r % 48, n0 = nb * 32; int d0;
            if (n0 < D + KVD) { const int c = n0 & 255; d0 = (n0 & ~255) + 128 * ((c >> 5) & 1) + 32 * (c >> 6); } else d0 = n0;
            p0_item(a.in[11], NQKV, D, kb * 64, n0, (bf16*)(ws + WS_WQKV) + (size_t)d0 * D, a.in[10], scr, lane); continue; } r -= I_QKV;
        if (r < I_WO) { const int kb = r / 32, nb = r % 32; p0_item(a.in[14], D, D, kb * 64, nb * 32, (bf16*)(ws + WS_WO) + (size_t)(nb * 32) * D, nullptr, scr, lane); continue; } r -= I_WO;
        { const int mat = r / I_G, q = r % I_G, kind = mat >> 3, e = mat & 7;
          if (kind < 2) { const int kb = q / 112, nb = q % 112;
              p0_item8(a.in[17 + kind] + (size_t)e * D * DFF, DFF, D, kb * 64, nb * 32, ws + WS_EWGU + ((size_t)e * NGU + ileave(nb * 32, kind)) * D, a.in[15], WGU_SCALE, scr, lane); }
          else { const int kb = q / 32, nb = q % 32;
              p0_item8(a.in[19] + (size_t)e * DFF * D, D, DFF, kb * 64, nb * 32, ws + WS_EWD + ((size_t)e * D + nb * 32) * DFF, nullptr, WD_SCALE, scr, lane); } }
    }
    {
        bf16* hb = (bf16*)(ws + WS_HB); float* ssq = (float*)(ws + WS_SSQ);
        constexpr int RB = 4;
        for (int m0 = gw; m0 < M + NMETA; m0 += RB * NGW) {
            f32x4 v[RB][4];
#pragma unroll
            for (int q = 0; q < RB; ++q) { const int m = m0 + q * NGW < M + NMETA ? m0 + q * NGW : m0; const bool meta = m >= M;
                const GAS f32x4* xr = (const GAS f32x4*)(meta ? a.in[1] + (size_t)(m - M) * D : a.in[0] + (size_t)m * D) + lane;
#pragma unroll
                for (int j = 0; j < 4; ++j) v[q][j] = xr[64 * j]; }
#pragma unroll
            for (int q = 0; q < RB; ++q) { const int m = m0 + q * NGW; if (m >= M + NMETA) break; const bool meta = m >= M;
                float s = 0.f;
#pragma unroll
                for (int j = 0; j < 4; ++j) s += (v[q][j].x * v[q][j].x + v[q][j].y * v[q][j].y) + (v[q][j].z * v[q][j].z + v[q][j].w * v[q][j].w);
                s = wave_sum(s);
                bf16* orow = meta ? (bf16*)(ws + WS_MISC + MS_MB) + (size_t)(m - M) * D : hb + (size_t)m * D;
                GAS unsigned long long* o8 = (GAS unsigned long long*)orow + lane;
#pragma unroll
                for (int j = 0; j < 4; ++j) o8[64 * j] = (unsigned long long)pk2(v[q][j].x, v[q][j].y) | ((unsigned long long)pk2(v[q][j].z, v[q][j].w) << 32);
                if (meta) { if (lane == 0) ((float*)(ws + WS_MISC + MS_SSQ0))[m - M] = s; }
                else if (lane < 16) ssq[(size_t)m * 16 + lane] = lane == 0 ? s : 0.f; }
        }
    }
    {
        f32x2* rope = (f32x2*)(ws + WS_ROPE);
        const int gt = gw * 64 + lane, NGT = NGW * 64;
        for (int idx = gt; idx < LPOS * 32; idx += NGT) {
            const int p = idx >> 5, f = idx & 31; const float ang = (float)p * a.inv[f];
            const double rev = (double)ang * 0.15915494309189535; const float fr = (float)(rev - rint(rev));
            rope[idx] = (f32x2){__builtin_amdgcn_cosf(fr), __builtin_amdgcn_sinf(fr)};
        }
    }
}

__device__ __forceinline__ void unpack8(const u32x4 w, float (&f)[8]) { f[0] = bflo(w.x); f[1] = bfhi(w.x); f[2] = bflo(w.y); f[3] = bfhi(w.y); f[4] = bflo(w.z); f[5] = bfhi(w.z); f[6] = bflo(w.w); f[7] = bfhi(w.w); }
__device__ __forceinline__ void conv_phase(const Args& a, int G, int tid) {
    unsigned char* ws = a.ws;
    const bf16* Bc = (const bf16*)(ws + WS_BC); const bf16* Vc = (const bf16*)(ws + WS_VC); bf16* Yc = (bf16*)(ws + WS_YC);
    const float* vm = (const float*)(ws + WS_MISC + MS_VM); const float* cw = a.in[4];
    const int cg = tid & 127, strip = tid >> 7, ch0 = cg * 8;
    float w0[8], w1[8], w2[8];
#pragma unroll
    for (int e = 0; e < 8; ++e) { w0[e] = cw[ch0 + e]; w1[e] = cw[D + ch0 + e]; w2[e] = cw[2 * D + ch0 + e]; }
    for (int blk = blockIdx.x; blk < M / 128; blk += G) {
        const int r0 = blk * 128 + strip * 32;
        float p2[8], p1[8];
        if ((r0 & (SEQ - 1)) == 0) {
#pragma unroll
            for (int e = 0; e < 8; ++e) { p2[e] = vm[14 * D + ch0 + e]; p1[e] = vm[15 * D + ch0 + e]; }
        } else { unpack8(*(const u32x4*)(Vc + (size_t)(r0 - 2) * D + ch0), p2); unpack8(*(const u32x4*)(Vc + (size_t)(r0 - 1) * D + ch0), p1); }
#if CONV_BATCH
        const GAS char* vp = (const GAS char*)Vc + ((size_t)r0 * D + ch0) * 2; const GAS char* bp = (const GAS char*)Bc + ((size_t)r0 * D + ch0) * 2; GAS char* yp = (GAS char*)Yc + ((size_t)r0 * D + ch0) * 2;
        u32x4 vq[2][8], bq[2][8];
#pragma unroll
        for (int i = 0; i < 8; ++i) { vq[0][i] = *(const GAS u32x4*)(vp + i * (D * 2)); bq[0][i] = *(const GAS u32x4*)(bp + i * (D * 2)); }
#pragma unroll
        for (int bt = 0; bt < 4; ++bt) {
            if (bt + 1 < 4) {
#pragma unroll
                for (int i = 0; i < 8; ++i) { vq[(bt + 1) & 1][i] = *(const GAS u32x4*)(vp + ((bt + 1) * 8 + i) * (D * 2)); bq[(bt + 1) & 1][i] = *(const GAS u32x4*)(bp + ((bt + 1) * 8 + i) * (D * 2)); }
            }
#pragma unroll
            for (int i = 0; i < 8; ++i) {
                float v[8], b[8]; unpack8(vq[bt & 1][i], v); unpack8(bq[bt & 1][i], b);
                float y[8];
#pragma unroll
                for (int e = 0; e < 8; ++e) { y[e] = b[e] * (w0[e] * p2[e] + w1[e] * p1[e] + w2[e] * v[e]); p2[e] = p1[e]; p1[e] = v[e]; }
                u32x4 o; o.x = cvt_pk_bf16(y[0], y[1]); o.y = cvt_pk_bf16(y[2], y[3]); o.z = cvt_pk_bf16(y[4], y[5]); o.w = cvt_pk_bf16(y[6], y[7]);
                if (YC_NT) __builtin_nontemporal_store(o, (GAS u32x4*)(yp + (bt * 8 + i) * (D * 2))); else *(GAS u32x4*)(yp + (bt * 8 + i) * (D * 2)) = o;
            }
        }
    }
#else
#pragma unroll 4
        for (int rr = 0; rr < 32; ++rr) {
            const size_t off = (size_t)(r0 + rr) * D + ch0;
            float v[8], b[8]; unpack8(*(const u32x4*)(Vc + off), v); unpack8(*(const u32x4*)(Bc + off), b);
            float y[8];
#pragma unroll
            for (int e = 0; e < 8; ++e) { y[e] = b[e] * (w0[e] * p2[e] + w1[e] * p1[e] + w2[e] * v[e]); p2[e] = p1[e]; p1[e] = v[e]; }
            u32x4 o; o.x = cvt_pk_bf16(y[0], y[1]); o.y = cvt_pk_bf16(y[2], y[3]); o.z = cvt_pk_bf16(y[4], y[5]); o.w = cvt_pk_bf16(y[6], y[7]);
            __builtin_nontemporal_store(o, (u32x4*)(Yc + off));
        }
    }
#endif
    if (blockIdx.x == (unsigned)(G - 1)) {
        const float* bm = (const float*)(ws + WS_MISC + MS_BM); bf16* ycm = (bf16*)(ws + WS_MISC + MS_YCM);
        for (int idx = tid; idx < NMETA * D; idx += NWAVES * 64) {
            const int i = idx >> 10, ch = idx & (D - 1);
            const float v0 = i >= 2 ? vm[(i - 2) * D + ch] : 0.f, v1 = i >= 1 ? vm[(i - 1) * D + ch] : 0.f, v2 = vm[i * D + ch];
            ycm[idx] = (bf16)f2bf(bm[idx] * (cw[ch] * v0 + cw[D + ch] * v1 + cw[2 * D + ch] * v2));
        }
    }
}

constexpr int KIMG_ROW = 144, AT_NSLOT = 3, KIMG_BYTES = AT_NSLOT * 128 * KIMG_ROW, VT_ROW = AT_NSLOT * 128 * 2 + 8, VT_BYTES = 64 * VT_ROW;
static_assert(KIMG_BYTES + VT_BYTES <= RING_BYTES, "attention LDS");
constexpr int QPRE_N = 2;
template <int QI, bool FIRST>
__device__ __forceinline__ void attn_qgroup(const LAS unsigned char* kimg, const LAS unsigned char* vimg, int pbase, int cbase, const bf16x8 (&qf)[4], bf16x8 (&qpre)[4], const bf16* qn, bf16* Og, float sk, int lane) {
    const int q = lane & 31, h = lane >> 5;
    f32x16 S[5];
#pragma unroll
    for (int bi = 0; bi < 5; ++bi) S[bi] = (f32x16){};
#pragma unroll
    for (int s = 0; s < 4; ++s)
#pragma unroll
        for (int bi = 0; bi < 5; ++bi) {
            const int rowbase = (bi < 4 - QI) ? pbase + 32 * (QI + bi) : cbase + 32 * (bi - (4 - QI));
            const bf16x8 kf = *(const LAS bf16x8*)(kimg + (rowbase + q) * KIMG_ROW + (16 * s + 8 * h) * 2);
            S[bi] = __builtin_amdgcn_mfma_f32_32x32x16_bf16(kf, qf[s], S[bi], 0, 0, 0);
        }
    if (QI & 1) {
#pragma unroll
        for (int s = 0; s < QPRE_N; ++s) qpre[s] = *(const GAS bf16x8*)(qn + 16 * s);
    }
    int tq = q - 4 * h; asm volatile("" : "+v"(tq));
    float mx = sk;
#pragma unroll
    for (int bi = 0; bi < 5; ++bi) {
        const bool prev = bi < 4 - QI; const int kb = prev ? QI + bi : bi - (4 - QI);
#pragma unroll
        for (int r = 0; r < 16; ++r) {
            const int cr = (r & 3) + 8 * (r >> 2);
            float sv = S[bi][r];
            if (prev) {
                if (FIRST) { if (kb < 3) sv = -INFINITY; else { if (!(cr + 4 * h >= 16)) sv = -INFINITY; if (kb == QI && !(cr > tq)) sv = -INFINITY; } }
                else if (kb == QI) { if (!(cr > tq)) sv = -INFINITY; }
            } else if (kb == QI) { if (!(cr <= tq)) sv = -INFINITY; }
            S[bi][r] = sv; mx = fmaxf(mx, sv);
        }
    }
    mx = fmaxf(mx, __shfl_xor(mx, 32));
    float l = 0.f;
#pragma unroll
    for (int bi = 0; bi < 5; ++bi)
#pragma unroll
        for (int r = 0; r < 16; ++r) { const float p = __builtin_amdgcn_exp2f(S[bi][r] - mx); S[bi][r] = p; l += p; }
    l += __shfl_xor(l, 32); l += __builtin_amdgcn_exp2f(sk - mx);
    f32x16 O[2][2];
#pragma unroll
    for (int c = 0; c < 2; ++c) { O[c][0] = (f32x16){}; O[c][1] = (f32x16){}; }
#pragma unroll
    for (int bi = 0; bi < 5; ++bi) {
        const int rowbase = (bi < 4 - QI) ? pbase + 32 * (QI + bi) : cbase + 32 * (bi - (4 - QI));
#pragma unroll
        for (int s2 = 0; s2 < 2; ++s2) {
            u32x4 pw; pw.x = cvt_pk_bf16(S[bi][8 * s2 + 0], S[bi][8 * s2 + 1]); pw.y = cvt_pk_bf16(S[bi][8 * s2 + 2], S[bi][8 * s2 + 3]);
            pw.z = cvt_pk_bf16(S[bi][8 * s2 + 4], S[bi][8 * s2 + 5]); pw.w = cvt_pk_bf16(S[bi][8 * s2 + 6], S[bi][8 * s2 + 7]);
            const bf16x8 pf = __builtin_bit_cast(bf16x8, pw);
#pragma unroll
            for (int c = 0; c < 2; ++c) {
                const LAS unsigned char* vp = vimg + (32 * c + q) * VT_ROW + (rowbase + 16 * s2 + 4 * h) * 2;
                const u32x2 lo = *(const LAS u32x2*)vp, hi = *(const LAS u32x2*)(vp + 16);
                const u32x4 vw = (u32x4){lo.x, lo.y, hi.x, hi.y};
                O[c][s2] = __builtin_amdgcn_mfma_f32_32x32x16_bf16(__builtin_bit_cast(bf16x8, vw), pf, O[c][s2], 0, 0, 0);
            }
        }
    }
    const float inv = __builtin_amdgcn_rcpf(l);
    bf16* orow = Og + (size_t)(32 * QI + q) * D;
#pragma unroll
    for (int c = 0; c < 2; ++c)
#pragma unroll
        for (int u4 = 0; u4 < 4; ++u4) {
            u32x2 w; w.x = cvt_pk_bf16((O[c][0][4 * u4 + 0] + O[c][1][4 * u4 + 0]) * inv, (O[c][0][4 * u4 + 1] + O[c][1][4 * u4 + 1]) * inv);
            w.y = cvt_pk_bf16((O[c][0][4 * u4 + 2] + O[c][1][4 * u4 + 2]) * inv, (O[c][0][4 * u4 + 3] + O[c][1][4 * u4 + 3]) * inv);
            *(u32x2*)(orow + 32 * c + 8 * u4 + 4 * h) = w;
        }
}
__device__ __forceinline__ void attn_load_block(const bf16* Kb, const bf16* Vb, const bf16* Km, const bf16* Vm, int b, int kvh, int jb, int tid, u32x4 (&kv)[2], u32x4 (&vv)[2]) {
#pragma unroll
    for (int ii = 0; ii < 2; ++ii) {
        const int c = tid + 512 * ii, row = c >> 3, ch = c & 7;
        kv[ii] = (u32x4){0u, 0u, 0u, 0u}; vv[ii] = (u32x4){0u, 0u, 0u, 0u};
        if (jb >= 0) { const size_t off = (size_t)(b * SEQ + 128 * jb + row) * KVD + kvh * HD + ch * 8; kv[ii] = *(const u32x4*)(Kb + off); vv[ii] = *(const u32x4*)(Vb + off); }
        else if (row >= 112) { const size_t off = (size_t)(row - 112) * KVD + kvh * HD + ch * 8; kv[ii] = *(const u32x4*)(Km + off); vv[ii] = *(const u32x4*)(Vm + off); }
    }
}
__device__ __forceinline__ void attn_store_block(LAS unsigned char* kimg, LAS unsigned char* vimg, int slot, int tid, const u32x4 (&kv)[2], const u32x4 (&vv)[2]) {
#pragma unroll
    for (int ii = 0; ii < 2; ++ii) {
        const int c = tid + 512 * ii, row = slot * 128 + (c >> 3), ch = c & 7;
        *(LAS u32x4*)(kimg + row * KIMG_ROW + ch * 16) = kv[ii];
        LAS unsigned short* vt = (LAS unsigned short*)(vimg + (ch * 8) * VT_ROW + row * 2);
        vt[0 * (VT_ROW / 2)] = (unsigned short)(vv[ii].x & 0xffffu); vt[1 * (VT_ROW / 2)] = (unsigned short)(vv[ii].x >> 16);
        vt[2 * (VT_ROW / 2)] = (unsigned short)(vv[ii].y & 0xffffu); vt[3 * (VT_ROW / 2)] = (unsigned short)(vv[ii].y >> 16);
        vt[4 * (VT_ROW / 2)] = (unsigned short)(vv[ii].z & 0xffffu); vt[5 * (VT_ROW / 2)] = (unsigned short)(vv[ii].z >> 16);
        vt[6 * (VT_ROW / 2)] = (unsigned short)(vv[ii].w & 0xffffu); vt[7 * (VT_ROW / 2)] = (unsigned short)(vv[ii].w >> 16);
    }
}
__device__ __forceinline__ void attn_phase(const Args& a, LAS unsigned char* lds, int vcu, int G, int tid, int wave, int lane) {
    unsigned char* ws = a.ws;
    const bf16* Q = (const bf16*)(ws + WS_Q); const bf16* Kb = (const bf16*)(ws + WS_KB); const bf16* Vb = (const bf16*)(ws + WS_VB);
    const bf16* Km = (const bf16*)(ws + WS_MISC + MS_KM); const bf16* Vm = (const bf16*)(ws + WS_MISC + MS_VMETA);
    LAS unsigned char* kimg = lds; LAS unsigned char* vimg = lds + KIMG_BYTES;
    constexpr int NUNITS = BATCH * NKVH * (SEQ / 128);
    const int per = (NUNITS + G - 1) / G;
    const int g = wave >> 1, half = wave & 1, q = lane & 31, h = lane >> 5;
    bf16x8 qf[2][4];
    for (int i = 0; i < per; ++i) {
        const int uid = vcu * per + i; if (uid >= NUNITS) break;
        const int b = uid >> 8, kvh = (uid >> 6) & 3, j = uid & 63; const int Rb = b * SEQ + 128 * j;
        const int hq = kvh * 4 + g;
#pragma unroll
        for (int qg = 0; qg < 2; ++qg) {
#pragma unroll
            for (int s = 0; s < 4; ++s) if (!(qg == 0 && i != 0 && s < QPRE_N)) qf[qg][s] = *(const GAS bf16x8*)(Q + (size_t)(Rb + 64 * half + 32 * qg + q) * D + hq * HD + 16 * s + 8 * h); }
        const bf16* qn;
        { const int un = (i + 1 < per && uid + 1 < NUNITS) ? uid + 1 : uid; const int bn = un >> 8, kvhn = (un >> 6) & 3, jn = un & 63;
          qn = Q + (size_t)(bn * SEQ + 128 * jn + 64 * half + q) * D + (kvhn * 4 + g) * HD + 8 * h; }
        const bool fresh = (i == 0) || (j == 0);
        if (fresh) {
            __syncthreads();
            u32x4 kv[2], vv[2], kv2[2], vv2[2];
            attn_load_block(Kb, Vb, Km, Vm, b, kvh, j - 1, tid, kv, vv); attn_load_block(Kb, Vb, Km, Vm, b, kvh, j, tid, kv2, vv2);
            attn_store_block(kimg, vimg, (j + 2) % 3, tid, kv, vv);      attn_store_block(kimg, vimg, j % 3, tid, kv2, vv2);
        }
        __syncthreads();
        const bool pre = (i + 1 < per) && (uid + 1 < NUNITS) && (j + 1 < 64);
        u32x4 nk[2], nv[2];
        if (pre) attn_load_block(Kb, Vb, Km, Vm, b, kvh, j + 1, tid, nk, nv);
        const float sk = a.in[13][hq] * LOG2E;
        bf16* Og = (bf16*)(ws + WS_O) + (size_t)Rb * D + hq * HD;
        const int pbase = ((j + 2) % 3) * 128, cbase = (j % 3) * 128;
        if (j != 0) {
            if (half == 0) { attn_qgroup<0, false>(kimg, vimg, pbase, cbase, qf[0], qf[0], qn, Og, sk, lane); attn_qgroup<1, false>(kimg, vimg, pbase, cbase, qf[1], qf[0], qn, Og, sk, lane); }
            else           { attn_qgroup<2, false>(kimg, vimg, pbase, cbase, qf[0], qf[0], qn, Og, sk, lane); attn_qgroup<3, false>(kimg, vimg, pbase, cbase, qf[1], qf[0], qn, Og, sk, lane); }
        } else {
            if (half == 0) { attn_qgroup<0, true>(kimg, vimg, pbase, cbase, qf[0], qf[0], qn, Og, sk, lane); attn_qgroup<1, true>(kimg, vimg, pbase, cbase, qf[1], qf[0], qn, Og, sk, lane); }
            else           { attn_qgroup<2, true>(kimg, vimg, pbase, cbase, qf[0], qf[0], qn, Og, sk, lane); attn_qgroup<3, true>(kimg, vimg, pbase, cbase, qf[1], qf[0], qn, Og, sk, lane); }
        }
        if (pre) attn_store_block(kimg, vimg, (j + 1) % 3, tid, nk, nv);
    }
    __syncthreads();
}

__device__ __forceinline__ void route_phase(const Args& a, LAS unsigned char* lds, unsigned* ctl, int G, int tid, int wave, int lane) {
    unsigned char* ws = a.ws;
    LAS float* wr_l = (LAS float*)lds;
    LAS int* cntL = (LAS int*)(lds + 32768); LAS int* baseL = (LAS int*)(lds + 32768 + 64);
    const float* Wr = a.in[16]; const float* gm = a.in[15];
    for (int idx = tid; idx < NE * D; idx += NWAVES * 64) { const int e = idx >> 10, k = idx & (D - 1); wr_l[idx] = Wr[k * NE + e] * gm[k]; }
    const bf16* hsrc = (const bf16*)(ws + WS_HB);
    unsigned char* xq = ws + WS_XQ;
    int* list = (int*)(ws + WS_LIST); u32x2* tokep = (u32x2*)(ws + WS_TOKEP); f32x2* tokg = (f32x2*)(ws + WS_TOKG);
    for (int blk = blockIdx.x; blk < M / 128; blk += G) {
        __syncthreads();
        if (tid < 8) cntL[tid] = 0;
        __syncthreads();
        int my_e1 = -1, my_e2 = -1; float my_g1 = 0.f, my_g2 = 0.f;
        const int rbase = blk * 128 + wave * 16;
        constexpr int RB = 2;
        u32x2 nx[RB][4];
#pragma unroll
        for (int q = 0; q < RB; ++q)
#pragma unroll
            for (int j = 0; j < 4; ++j) nx[q][j] = *(const GAS u32x2*)(hsrc + (size_t)(rbase + q) * D + 4 * lane + 256 * j);
        for (int jj0 = 0; jj0 < 16; jj0 += RB) {
            f32x4 hv[RB][4]; float s[RB], d[RB][8];
#pragma unroll
            for (int q = 0; q < RB; ++q) { s[q] = 0.f;
#pragma unroll
                for (int j = 0; j < 4; ++j) { const u32x2 w = nx[q][j]; hv[q][j] = (f32x4){bflo(w.x), bfhi(w.x), bflo(w.y), bfhi(w.y)};
                    s[q] += (hv[q][j].x * hv[q][j].x + hv[q][j].y * hv[q][j].y) + (hv[q][j].z * hv[q][j].z + hv[q][j].w * hv[q][j].w); } }
            { const int jn = jj0 + RB < 16 ? jj0 + RB : jj0;
#pragma unroll
              for (int q = 0; q < RB; ++q)
#pragma unroll
                  for (int j = 0; j < 4; ++j) nx[q][j] = *(const GAS u32x2*)(hsrc + (size_t)(rbase + jn + q) * D + 4 * lane + 256 * j); }
#pragma unroll
            for (int e = 0; e < 8; ++e) {
#pragma unroll
                for (int q = 0; q < RB; ++q) d[q][e] = 0.f;
#pragma unroll
                for (int j = 0; j < 4; ++j) { const f32x4 w = *(const LAS f32x4*)(wr_l + e * D + 4 * lane + 256 * j);
#pragma unroll
                    for (int q = 0; q < RB; ++q) d[q][e] += (hv[q][j].x * w.x + hv[q][j].y * w.y) + (hv[q][j].z * w.z + hv[q][j].w * w.w); } }
#pragma unroll
            for (int o = 1; o < 64; o <<= 1) {
#pragma unroll
                for (int q = 0; q < RB; ++q) { s[q] += __shfl_xor(s[q], o);
#pragma unroll
                    for (int e = 0; e < 8; ++e) d[q][e] += __shfl_xor(d[q][e], o); } }
#pragma unroll
            for (int q = 0; q < RB; ++q) {
                const int jj = jj0 + q;
                const float rstd = 1.0f / sqrtf(s[q] * (1.0f / (float)D) + RMS_EPS);
                { const float sc = rstd * XQ_SCALE; unsigned char* xr = xq + (size_t)(rbase + jj) * D + 4 * lane;
#pragma unroll
                  for (int j = 0; j < 4; ++j) *(unsigned*)(xr + 256 * j) = pk4_fp8(hv[q][j].x * sc, hv[q][j].y * sc, hv[q][j].z * sc, hv[q][j].w * sc); }
                float lg[8];
#pragma unroll
                for (int e = 0; e < 8; ++e) lg[e] = d[q][e] * rstd;
                int e1 = 0; float v1 = lg[0];
#pragma unroll
                for (int e = 1; e < 8; ++e) if (lg[e] > v1) { v1 = lg[e]; e1 = e; }
                int e2 = -1; float v2 = -INFINITY;
#pragma unroll
                for (int e = 0; e < 8; ++e) if (e != e1 && lg[e] > v2) { v2 = lg[e]; e2 = e; }
                const float g1 = 1.0f / (1.0f + expf(v2 - v1));
                if (lane == jj) { my_e1 = e1; my_e2 = e2; my_g1 = g1; my_g2 = 1.0f - g1; }
            }
        }
        unsigned long long mk[8]; int wb = 0;
#pragma unroll
        for (int e = 0; e < 8; ++e) { mk[e] = __ballot(my_e1 == e || my_e2 == e); if (lane == e) wb = __popcll(mk[e]); }
        if (lane < 8) wb = atomicAdd((int*)(cntL + lane), wb);
        __syncthreads();
        if (tid < 8) baseL[tid] = (int)__hip_atomic_fetch_add(ctl + CW_CNT + 64 * tid, (unsigned)cntL[tid], RLX_AGENT);
        __syncthreads();
        {
            int pos1 = 0, pos2 = 0;
#pragma unroll
            for (int e = 0; e < 8; ++e) {
                const int wbe = __shfl(wb, e); const int p = baseL[e] + wbe + __popcll(mk[e] & ((1ull << lane) - 1ull));
                if (my_e1 == e) pos1 = p; if (my_e2 == e) pos2 = p;
            }
            if (lane < 16) {
                const int tok = rbase + lane;
                list[(size_t)my_e1 * M + pos1] = tok; list[(size_t)my_e2 * M + pos2] = tok;
                tokep[tok] = (u32x2){((unsigned)my_e1 << 28) | (unsigned)pos1, ((unsigned)my_e2 << 28) | (unsigned)pos2};
                tokg[tok] = (f32x2){my_g1, my_g2};
            }
        }
    }
    __syncthreads();
}

__device__ __forceinline__ void unpack8_fp8(const u32x2 w, float (&f)[8]) {
    const f32x2 a = __builtin_amdgcn_cvt_pk_f32_fp8((int)w.x, false), b = __builtin_amdgcn_cvt_pk_f32_fp8((int)w.x, true), c = __builtin_amdgcn_cvt_pk_f32_fp8((int)w.y, false), d = __builtin_amdgcn_cvt_pk_f32_fp8((int)w.y, true);
    f[0] = a.x; f[1] = a.y; f[2] = b.x; f[3] = b.y; f[4] = c.x; f[5] = c.y; f[6] = d.x; f[7] = d.y;
}
__device__ __forceinline__ void final_y_tail(const bf16* YP, size_t s, int k, float (&y)[8]) {
    const int T = (int)(s >> 8);
    const bf16* p = YP + ((size_t)((T - DOWN_MAIN_TILES) * 4 + (k >> 8)) * DOWN_KS) * 65536 + (size_t)(s & 255) * 256 + (k & 255);
#pragma unroll
    for (int e = 0; e < 8; ++e) y[e] = 0.f;
#pragma unroll
    for (int ks = 0; ks < DOWN_KS; ++ks) { float t[8]; unpack8(*(const u32x4*)(p + (size_t)ks * 65536), t);
#pragma unroll
        for (int e = 0; e < 8; ++e) y[e] += t[e]; }
}
__device__ __forceinline__ void final_phase(const Args& a, unsigned* ctl, int vcu, int G, int wave, int lane) {
    unsigned char* ws = a.ws;
    MoeInfo mi; moe_info_load(ctl, mi);
    const bf16* hb = (const bf16*)(ws + WS_HB); const unsigned char* Y = ws + WS_Y; const bf16* YP = (const bf16*)(ws + WS_YP);
    const u32x2* tokep = (const u32x2*)(ws + WS_TOKEP); const f32x2* tokg = (const f32x2*)(ws + WS_TOKG); const float* gf = a.in[20];
    const int gw = vcu * NWAVES + wave, NGW = G * NWAVES;
    float gfv[16];
#pragma unroll
    for (int j = 0; j < 2; ++j)
#pragma unroll
        for (int e = 0; e < 8; ++e) gfv[j * 8 + e] = gf[8 * lane + 512 * j + e];
    constexpr int RB = 4;
    u32x2 epn[RB]; f32x2 gn[RB];
#pragma unroll
    for (int q = 0; q < RB; ++q) { const int r = gw + q * NGW < M ? gw + q * NGW : gw; epn[q] = ((const GAS u32x2*)tokep)[r]; gn[q] = ((const GAS f32x2*)tokg)[r]; }
    for (int r0 = gw; r0 < M; r0 += RB * NGW) {
        u32x2 ep[RB]; f32x2 g[RB]; size_t s1[RB], s2[RB]; u32x4 wh[RB][2]; u32x2 w1[RB][2], w2[RB][2];
#pragma unroll
        for (int q = 0; q < RB; ++q) { ep[q] = epn[q]; g[q] = gn[q] * (1.0f / (HQ_SCALE * WD_SCALE)); }
#pragma unroll
        for (int q = 0; q < RB; ++q) {
            const int r = r0 + q * NGW < M ? r0 + q * NGW : r0;
            int ts1 = 0, ts2 = 0; const int e1 = (int)(ep[q].x >> 28), e2 = (int)(ep[q].y >> 28);
#pragma unroll
            for (int e = 0; e < 8; ++e) { if (e1 == e) ts1 = mi.ts[e]; if (e2 == e) ts2 = mi.ts[e]; }
            s1[q] = (size_t)ts1 * 256 + (ep[q].x & 0x0fffffffu); s2[q] = (size_t)ts2 * 256 + (ep[q].y & 0x0fffffffu);
#pragma unroll
            for (int j = 0; j < 2; ++j) { const int k = 8 * lane + 512 * j;
                wh[q][j] = *(const u32x4*)(hb + (size_t)r * D + k); w1[q][j] = *(const u32x2*)(Y + s1[q] * D + k); w2[q][j] = *(const u32x2*)(Y + s2[q] * D + k); }
        }
        { const int rn0 = r0 + RB * NGW;
#pragma unroll
          for (int q = 0; q < RB; ++q) { const int r = rn0 + q * NGW < M ? rn0 + q * NGW : gw; epn[q] = ((const GAS u32x2*)tokep)[r]; gn[q] = ((const GAS f32x2*)tokg)[r]; } }
#pragma unroll
        for (int q = 0; q < RB; ++q) {
            const int r = r0 + q * NGW; if (r >= M) break;
            const bool t1 = (s1[q] >> 8) >= (size_t)DOWN_MAIN_TILES, t2 = (s2[q] >> 8) >= (size_t)DOWN_MAIN_TILES;
            float v[16]; float s = 0.f;
#pragma unroll
            for (int j = 0; j < 2; ++j) {
                const int k = 8 * lane + 512 * j; float hf[8], y1[8], y2[8];
                unpack8(wh[q][j], hf); unpack8_fp8(w1[q][j], y1); unpack8_fp8(w2[q][j], y2);
                if (t1) final_y_tail(YP, s1[q], k, y1);
                if (t2) final_y_tail(YP, s2[q], k, y2);
#pragma unroll
                for (int e = 0; e < 8; ++e) { const float t = hf[e] + g[q].x * y1[e] + g[q].y * y2[e]; v[j * 8 + e] = t; s += t * t; }
            }
            s = wave_sum(s); const float rstd = 1.0f / sqrtf(s * (1.0f / (float)D) + RMS_EPS);
#pragma unroll
            for (int j = 0; j < 2; ++j) {
                float* o = a.out + (size_t)r * D + 8 * lane + 512 * j;
                *(f32x4*)o = (f32x4){v[j * 8 + 0] * rstd * gfv[j * 8 + 0], v[j * 8 + 1] * rstd * gfv[j * 8 + 1], v[j * 8 + 2] * rstd * gfv[j * 8 + 2], v[j * 8 + 3] * rstd * gfv[j * 8 + 3]};
                *(f32x4*)(o + 4) = (f32x4){v[j * 8 + 4] * rstd * gfv[j * 8 + 4], v[j * 8 + 5] * rstd * gfv[j * 8 + 5], v[j * 8 + 6] * rstd * gfv[j * 8 + 6], v[j * 8 + 7] * rstd * gfv[j * 8 + 7]};
            }
        }
    }
}

constexpr int N_PHASES = 13;
#ifndef REP_P0
#define REP_P0 1
#endif
#ifndef REP_P4
#define REP_P4 1
#endif
#ifndef REP_MOE
#define REP_MOE 1
#endif
#ifndef REP_EW
#define REP_EW 1
#endif
#ifndef REP_CONV
#define REP_CONV 1
#endif
#ifndef REP_QKV
#define REP_QKV 1
#endif
#ifndef REP_ATT
#define REP_ATT 1
#endif
__global__ void __launch_bounds__(NWAVES * 64, 2) fwd_kernel(Args args) {
    extern __shared__ __attribute__((aligned(16))) unsigned char lds_raw[];
    LAS unsigned char* lds = (LAS unsigned char*)lds_raw;
    volatile LAS unsigned* MISC = (volatile LAS unsigned*)(lds + MISC_OFF);
    const int wave = __builtin_amdgcn_readfirstlane((int)threadIdx.x >> 6);
#define lane hw_lane()
#define tid (wave * 64 + hw_lane())
    const int G = gridDim.x; const int bx = blockIdx.x; const int vcu = (G % 8 == 0) ? (bx % 8) * (G / 8) + bx / 8 : bx;
    unsigned char* ws = args.ws;
    unsigned* ctl = (unsigned*)(ws + WS_CTL);
    for (int u = (int)threadIdx.x; u < (LDS_BYTES - LDSCTL_OFF) / 4; u += NWAVES * 64) ((LAS unsigned*)(lds + LDSCTL_OFF))[u] = 0u;
    __syncthreads();
#if !MULTI_LAUNCH
    XcdBarrier bar = xcd_barrier_post(ctl + CW_BAR, MISC + 8, wave);
#define GRID_BAR() xcd_barrier(bar, wave)
#else
#define GRID_BAR() do { } while (0)
#endif
    const int lo = args.ph_lo, hi = args.ph_hi;
#define IN(k) (lo <= (k) && (k) < hi)
#define SEAM(k) do { if (IN(k) && IN((k) + 1)) GRID_BAR(); } while (0)
    unsigned char* misc = ws + WS_MISC;
    const float* ssq = (const float*)(ws + WS_SSQ);

    if (IN(0)) { for (int rep = 0; rep < REP_P0; ++rep) { p0_prologue(args, lds, vcu, G, wave, lane); SEAM(0); } }

    if (IN(1)) {
        typedef pg8::DenseSched<M / 256, NCONV / 256> DS; DS S{(const char*)(ws + WS_HB), (const char*)(ws + WS_WIN), 2 * D, G, bx};
        LAS float* rtab = (LAS float*)(lds + pg8::RSTD_TAB_OFF);
        auto pre = [&]() {
            if (bx < 96) {
                const float* ms0 = (const float*)(misc + MS_SSQ0); float* bm = (float*)(misc + MS_BM); float* vm = (float*)(misc + MS_VM);
                int n0, n1, vch = -1; if (bx < 32) { n0 = 32 * bx; n1 = n0 + 16; } else { const int j2 = bx - 32; n0 = D + 256 * (j2 >> 3) + 16 * (j2 & 7); n1 = n0 + 128; vch = 128 * (j2 >> 3) + 16 * (j2 & 7); }
                meta_dual(lds, (const bf16*)(misc + MS_MB), D, (const bf16*)(ws + WS_WIN), n0, n1, lane, wave, [&](const f32x4& a0, const f32x4& a1, int r16, int kq) {
    #pragma unroll
                    for (int g = 0; g < 4; ++g) { const int i = 4 * kq + g; const float r = 1.0f / sqrtf(ms0[i] * (1.0f / (float)D) + RMS_EPS);
                        if (vch < 0) { bm[i * D + n0 + r16] = a0[g] * r; bm[i * D + n1 + r16] = a1[g] * r; } else vm[i * D + vch + r16] = (a0[g] * r) * (a1[g] * r); } });
            }
            __syncthreads(); pg8::rstd_table_fill(S, ssq, rtab, tid); __syncthreads();
        };
        pg8::EpiConvIn E{(bf16*)(ws + WS_BC), (bf16*)(ws + WS_VC), rtab};
        ExpertCvtBg bg{args.in[17], args.in[18], args.in[19], args.in[15], ws, EXP_ITEMS - bg_cover(G), 0, BG_P1, bx * NWAVES + wave, G * NWAVES, {}, {}, {}, nullptr, 0u, 0, 0.f, false};
#if BG_CVT
        pg8::gemm_phase<pg8::EpiConvIn, DS, true>(lds, S, E, wave, pre, bg);
#else
        (void)bg; pg8::gemm_phase<pg8::EpiConvIn, DS, true>(lds, S, E, wave, pre);
#endif
        SEAM(1);
    }
    if (IN(2)) { for (int rep = 0; rep < REP_CONV; ++rep) { conv_phase(args, G, tid); SEAM(2); } }

    if (IN(3)) {
        typedef pg8::DenseSched<M / 256, D / 256> DS; DS S{(const char*)(ws + WS_YC), (const char*)(ws + WS_WOUT), 2 * D, G, bx};
        auto pre = [&]() {
            if (bx < 32) {
                const float* meta = args.in[1]; float* hm = (float*)(misc + MS_HM); bf16* hmb = (bf16*)(misc + MS_HMB); float* p1 = (float*)(misc + MS_SSQ1);
                const int n0 = 32 * bx, n1 = n0 + 16;
                meta_dual(lds, (const bf16*)(misc + MS_YCM), D, (const bf16*)(ws + WS_WOUT), n0, n1, lane, wave, [&](const f32x4& a0, const f32x4& a1, int r16, int kq) {
    #pragma unroll
                    for (int g = 0; g < 4; ++g) { const int i = 4 * kq + g; const float v0 = meta[i * D + n0 + r16] + a0[g], v1 = meta[i * D + n1 + r16] + a1[g];
                        hm[i * D + n0 + r16] = v0; hm[i * D + n1 + r16] = v1; hmb[i * D + n0 + r16] = (bf16)f2bf(v0); hmb[i * D + n1 + r16] = (bf16)f2bf(v1);
                        float q = v0 * v0 + v1 * v1; q += __shfl_xor(q, 1); q += __shfl_xor(q, 2); q += __shfl_xor(q, 4); q += __shfl_xor(q, 8);
                        if (r16 == 0) p1[bx * 16 + i] = q; } });
            }
        };
        pg8::EpiResidT<FFN8 != 0> E{(bf16*)(ws + WS_HB), (float*)(ws + WS_SSQ), 1.0f, ws + WS_XQ};
        pg8::gemm_phase<pg8::EpiResidT<FFN8 != 0>, DS, true>(lds, S, E, wave, pre);
        SEAM(3);
    }
    if (IN(4)) for (int rep = 0; rep < REP_P4; ++rep) {
#if FFN8
        typedef pg8::DenseSched<M / 256, NGU / 256, true> DS; DS S{(const char*)(ws + WS_XQ), (const char*)(ws + WS_WGU8), D, G, bx};
#else
        typedef pg8::DenseSched<M / 256, NGU / 256> DS; DS S{(const char*)(ws + WS_HB), (const char*)(ws + WS_WGU), 2 * D, G, bx};
#endif
        LAS float* rtab = (LAS float*)(lds + pg8::RSTD_TAB_OFF);
        auto pre = [&]() {
            if (bx < 224) {
                const f32x4 rs = meta_rstd_parts((const float*)(misc + MS_SSQ1), lane); bf16* hdm = (bf16*)(misc + MS_HDM);
                const int n0 = 256 * (bx >> 3) + 16 * (bx & 7), n1 = n0 + 128, hch = 128 * (bx >> 3) + 16 * (bx & 7);
                meta_dual(lds, (const bf16*)(misc + MS_HMB), D, (const bf16*)(ws + WS_WGU), n0, n1, lane, wave, [&](const f32x4& a0, const f32x4& a1, int r16, int kq) {
    #pragma unroll
                    for (int g = 0; g < 4; ++g) { const int i = 4 * kq + g; hdm[i * DFF + hch + r16] = (bf16)f2bf(pg8::silu_mul(a0[g] * rs[g], a1[g] * rs[g])); } });
            }
            __syncthreads(); pg8::rstd_table_fill(S, ssq, rtab, tid); __syncthreads();
        };
#if FFN8
        typedef pg8::EpiSwiGLU8T<FFN8 == 1> EPI4; EPI4 E{ws + WS_HD, rtab};
#else
        typedef pg8::EpiSwiGLU EPI4; EPI4 E{(bf16*)(ws + WS_HD), rtab};
#endif
        ExpertCvtBg bg{args.in[17], args.in[18], args.in[19], args.in[15], ws, EXP_ITEMS - bg_cover(G), BG_P1, BG_P4, bx * NWAVES + wave, G * NWAVES, {}, {}, {}, nullptr, 0u, 0, 0.f, false};
#if BG_CVT
        pg8::gemm_phase<EPI4, DS, true>(lds, S, E, wave, pre, bg);
#else
        (void)bg; pg8::gemm_phase<EPI4, DS, true>(lds, S, E, wave, pre);
#endif
        SEAM(4);
    }
    if (IN(5)) {
#if FFN8 == 1
        typedef pg8::DenseSched<M / 256, D / 256, true> DS; DS S{(const char*)(ws + WS_HD), (const char*)(ws + WS_WD8), DFF, G, bx};
#else
        typedef pg8::DenseSched<M / 256, D / 256> DS; DS S{(const char*)(ws + WS_HD), (const char*)(ws + WS_WD), 2 * DFF, G, bx};
#endif
        auto pre = [&]() {
            if (bx < 32) {
                float* hm = (float*)(misc + MS_HM); bf16* hmb = (bf16*)(misc + MS_HMB); float* p2 = (float*)(misc + MS_SSQ2);
                const int n0 = 32 * bx, n1 = n0 + 16;
                meta_dual(lds, (const bf16*)(misc + MS_HDM), DFF, (const bf16*)(ws + WS_WD), n0, n1, lane, wave, [&](const f32x4& a0, const f32x4& a1, int r16, int kq) {
    #pragma unroll
                    for (int g = 0; g < 4; ++g) { const int i = 4 * kq + g; const float v0 = hm[i * D + n0 + r16] + a0[g], v1 = hm[i * D + n1 + r16] + a1[g];
                        hm[i * D + n0 + r16] = v0; hm[i * D + n1 + r16] = v1; hmb[i * D + n0 + r16] = (bf16)f2bf(v0); hmb[i * D + n1 + r16] = (bf16)f2bf(v1);
                        float q = v0 * v0 + v1 * v1; q += __shfl_xor(q, 1); q += __shfl_xor(q, 2); q += __shfl_xor(q, 4); q += __shfl_xor(q, 8);
                        if (r16 == 0) p2[bx * 16 + i] = q; } });
            }
        };
        typedef pg8::EpiResidT<false, FFN8 == 1> EPI5; EPI5 E{(bf16*)(ws + WS_HB), (float*)(ws + WS_SSQ), FFN8 == 1 ? 1.0f / (HDQ_SCALE * WD8_SCALE) : 1.0f, nullptr};
        pg8::gemm_phase<EPI5, DS, true>(lds, S, E, wave, pre);
        SEAM(5);
    }
    if (IN(6)) {
        typedef pg8::DenseSched<M / 256, NQKV / 256> DS; DS S{(const char*)(ws + WS_HB), (const char*)(ws + WS_WQKV), 2 * D, G, bx};
        LAS float* rtab = (LAS float*)(lds + pg8::RSTD_TAB_OFF);
        auto pre = [&]() {
            if (bx < 16) {
                const f32x4 rs = meta_rstd_parts((const float*)(misc + MS_SSQ2), lane); const float* bias = args.in[12]; const f32x2* rope = (const f32x2*)(ws + WS_ROPE);
                bf16* km = (bf16*)(misc + MS_KM); bf16* vmt = (bf16*)(misc + MS_VMETA);
                int n0, n1; if (bx < 8) { n0 = D + 32 * (bx >> 1) + 16 * (bx & 1); n1 = n0 + 128; } else { n0 = D + KVD + 32 * (bx - 8); n1 = n0 + 16; }
                meta_dual(lds, (const bf16*)(misc + MS_HMB), D, (const bf16*)(ws + WS_WQKV), n0, n1, lane, wave, [&](const f32x4& a0, const f32x4& a1, int r16, int kq) {
    #pragma unroll
                    for (int g = 0; g < 4; ++g) { const int i = 4 * kq + g;
                        if (bx < 8) { const int wc = bx >> 1, dlo = 16 * (bx & 1) + r16; const float lo_ = a0[g] * rs[g] + bias[D + 64 * wc + dlo], hi_ = a1[g] * rs[g] + bias[D + 64 * wc + dlo + 32];
                            const f32x2 cs = rope[i * 32 + dlo]; km[i * KVD + 64 * wc + dlo] = (bf16)f2bf(lo_ * cs.x - hi_ * cs.y); km[i * KVD + 64 * wc + dlo + 32] = (bf16)f2bf(hi_ * cs.x + lo_ * cs.y); }
                        else { const int c0 = n0 - (D + KVD) + r16; vmt[i * KVD + c0] = (bf16)f2bf(a0[g] * rs[g] + bias[n0 + r16]); vmt[i * KVD + c0 + 16] = (bf16)f2bf(a1[g] * rs[g] + bias[n1 + r16]); } } });
            }
            __syncthreads(); pg8::rstd_table_fill(S, ssq, rtab, tid); __syncthreads();
        };
        pg8::EpiQKV E{(bf16*)(ws + WS_Q), (bf16*)(ws + WS_KB), (bf16*)(ws + WS_VB), rtab, args.in[12], (const f32x2*)(ws + WS_ROPE)};
        for (int rep = 0; rep < REP_QKV; ++rep) { pg8::gemm_phase<pg8::EpiQKV, DS, true>(lds, S, E, wave, pre);
        SEAM(6); }
    }
    if (IN(7)) { for (int rep = 0; rep < REP_ATT; ++rep) { attn_phase(args, lds, vcu, G, tid, wave, lane); SEAM(7); } }

    if (IN(8)) {
        typedef pg8::DenseSched<M / 256, D / 256> DS; DS S{(const char*)(ws + WS_O), (const char*)(ws + WS_WO), 2 * D, G, bx};
        pg8::EpiResid E{(bf16*)(ws + WS_HB), (float*)(ws + WS_SSQ), 1.0f, nullptr};
        pg8::gemm_phase<pg8::EpiResid, DS, true>(lds, S, E, wave);
        SEAM(8);
    }
    if (IN(9)) { route_phase(args, lds, ctl, G, tid, wave, lane); SEAM(9); }

    for (int rep = 0; rep < REP_MOE; ++rep) {
        if (IN(10)) {
            LAS int* ml = (LAS int*)(lds + MISC_OFF + 64); moe_info_to_lds(ctl, ml, wave);
            const int ntile = __builtin_amdgcn_readfirstlane(ml[8]);
            pg8::MoeUpSched S{(const char*)(ws + WS_XQ), (const char*)(ws + WS_EWGU), (const int*)(ws + WS_LIST), ml, D, ntile, G, bx, 0};
            pg8::EpiMoeUp E{(unsigned char*)args.out, ws, 0};
            pg8::gemm_phase<pg8::EpiMoeUp, pg8::MoeUpSched, true>(lds, S, E, wave);
            SEAM(10);
        }
        if (IN(11)) {
            LAS int* ml = (LAS int*)(lds + MISC_OFF + 64); moe_info_to_lds(ctl, ml, wave);
            const int ntile = __builtin_amdgcn_readfirstlane(ml[8]);
            const int nmain = ntile < DOWN_MAIN_TILES ? ntile : DOWN_MAIN_TILES;
            pg8::MoeDownSched S{(unsigned char*)args.out, ws, (const char*)(ws + WS_EWD), ml, DFF, nmain, G, bx, 0};
            pg8::EpiMoeDown E{ws + WS_Y};
            pg8::gemm_phase<pg8::EpiMoeDown, pg8::MoeDownSched, true>(lds, S, E, wave);
            pg8::MoeDownTailSched S2{(unsigned char*)args.out, ws, (const char*)(ws + WS_EWD), ml, DFF, (ntile - nmain) * 4 * DOWN_KS, G, bx};
            pg8::EpiMoeDownPart E2{(bf16*)(ws + WS_YP)};
            pg8::gemm_phase<pg8::EpiMoeDownPart, pg8::MoeDownTailSched, true>(lds, S2, E2, wave);
            SEAM(11);
        }
    }
    if (IN(12)) { for (int rep = 0; rep < REP_EW; ++rep) { if (rep) GRID_BAR(); final_phase(args, ctl, vcu, G, wave, lane); } }
#undef IN
#undef SEAM
#undef lane
#undef tid
}

extern "C" void kernel_launch(void* const* d_in, const int* in_sizes, int n_in, void* d_out, int out_size, void* d_ws, size_t ws_size, hipStream_t stream) {
    static int grid = 0;
    if (grid == 0) {
        if (n_in != 21 || in_sizes[0] != M * D || out_size != M * D || ws_size < WS_END2) { fprintf(stderr, "kernel_launch: unexpected shapes (n_in %d, in0 %d, out %d, ws %zu); nothing launched\n", n_in, n_in > 0 ? in_sizes[0] : -1, out_size, ws_size); grid = -1; return; }
        int dev = 0, cus = 0, per_cu = 0;
        if (hipGetDevice(&dev) != hipSuccess || hipDeviceGetAttribute(&cus, hipDeviceAttributeMultiprocessorCount, dev) != hipSuccess) { grid = -1; return; }
        if (hipFuncSetAttribute((const void*)fwd_kernel, hipFuncAttributeMaxDynamicSharedMemorySize, LDS_BYTES) != hipSuccess) { fprintf(stderr, "kernel_launch: hipFuncSetAttribute failed\n"); grid = -1; return; }
        if (hipOccupancyMaxActiveBlocksPerMultiprocessor(&per_cu, (const void*)fwd_kernel, NWAVES * 64, LDS_BYTES) != hipSuccess || per_cu < 1) fprintf(stderr, "kernel_launch: occupancy query reports %d\n", per_cu);
        (void)hipGetLastError();
        grid = cus;
    }
    if (grid < 0) return;
    if (hipMemsetAsync((char*)d_ws + WS_CTL, 0, CTL_ZERO_BYTES, stream) != hipSuccess) return;
    Args a{};
    for (int i = 0; i < 21; ++i) a.in[i] = (const float*)d_in[i];
    a.out = (float*)d_out; a.ws = (unsigned char*)d_ws;
    for (int f = 0; f < 32; ++f) a.inv[f] = (float)std::pow(10000.0, -(double)f / 32.0);
#if MULTI_LAUNCH
    for (int p = 0; p < N_PHASES; ++p) { a.ph_lo = p; a.ph_hi = p + 1; hipLaunchKernelGGL(fwd_kernel, dim3(grid), dim3(NWAVES * 64), LDS_BYTES, stream, a); }
#else
    a.ph_lo = 0; a.ph_hi = N_PHASES;
    hipLaunchKernelGGL(fwd_kernel, dim3(grid), dim3(NWAVES * 64), LDS_BYTES, stream, a);
#endif
}
```

```cpp
#define CV_NT 0
#include <hip/hip_runtime.h>
#include <cstdio>
#include <cstdint>
#include <cmath>

#ifndef NAIVE_GEMM
#define NAIVE_GEMM 0
#endif
#ifndef PROBE_KL
#define PROBE_KL 1
#endif
#ifndef PROBE_DEPI
#define PROBE_DEPI 1
#endif
#ifndef PROBE_EPI
#define PROBE_EPI 1
#endif
#ifndef MULTI_LAUNCH
#define MULTI_LAUNCH 0
#endif

#define GAS __attribute__((address_space(1)))
#define LAS __attribute__((address_space(3)))
typedef unsigned short bf16;
typedef short bf16x8 __attribute__((ext_vector_type(8)));
typedef float f32x4 __attribute__((ext_vector_type(4)));
typedef float f32x2 __attribute__((ext_vector_type(2)));
typedef float f32x16 __attribute__((ext_vector_type(16)));
typedef unsigned u32x4 __attribute__((ext_vector_type(4)));
typedef unsigned u32x2 __attribute__((ext_vector_type(2)));
typedef int i32x8 __attribute__((ext_vector_type(8)));
typedef int i32x4 __attribute__((ext_vector_type(4)));

constexpr int D = 1024, BATCH = 4, SEQ = 8192, NMETA = 16, M = BATCH * SEQ;
constexpr int NCONV = 3 * D, DFF = 3584, NGU = 2 * DFF, NQKV = 1536, NE = 8;
constexpr int NQH = 16, NKVH = 4, HD = 64, KVD = NKVH * HD;
constexpr int LPOS = SEQ + NMETA;
constexpr float RMS_EPS = 1e-5f;
constexpr float LOG2E = 1.4426950408889634f;
constexpr float QSCALE = 0.125f * LOG2E;
constexpr int RING_BYTES_ = 131072;

__device__ __forceinline__ unsigned cvt_pk_bf16(float lo, float hi) { unsigned r; asm volatile("v_cvt_pk_bf16_f32 %0, %1, %2" : "=v"(r) : "v"(lo), "v"(hi)); return r; }
__device__ __forceinline__ float bf2f(unsigned short b) { return __uint_as_float(((unsigned)b) << 16); }
__device__ __forceinline__ float bflo(unsigned w) { return __uint_as_float(w << 16); }
__device__ __forceinline__ float bfhi(unsigned w) { return __uint_as_float(w & 0xffff0000u); }
__device__ __forceinline__ int hw_lane() { int l; asm volatile("v_mbcnt_lo_u32_b32 %0, -1, 0\n\tv_mbcnt_hi_u32_b32 %0, -1, %0" : "=v"(l)); return l; }
__device__ __forceinline__ float wave_sum(float v) {
#pragma unroll
    for (int o = 1; o < 64; o <<= 1) v += __shfl_xor(v, o);
    return v;
}

namespace pg8 {
constexpr int BM = 256, BK = 64, HALF = 128, HTB = HALF * BK * 2, STAGE_BYTES = 8 * HTB, NXCD = 8, WGM = 8;
__host__ __device__ __forceinline__ int lds_byte(int r, int c) { const int st = (r >> 4) * 2 + (c >> 5), rr = r & 15, cc = c & 31, ob = rr * 64 + cc * 2; return st * 1024 + (ob ^ (((ob >> 9) & 1) << 5)); }
__host__ __device__ __forceinline__ void stage_rc(int b, int& R, int& C) { const int st = b / 1024, sb = b % 1024, swz = sb ^ (((sb >> 9) & 1) << 5); R = (st >> 1) * 16 + swz / 64; C = (st & 1) * 32 + (swz % 64) / 2; }
__host__ __device__ __forceinline__ int perm32(int rho) { const int n = rho >> 4, i = rho & 15; return 8 * (i >> 2) + 4 * n + (i & 3); }

struct Unit { int pm, pn, e, lt; int ord = 0; };

__device__ __forceinline__ void order_unit(int L, int nM, int nN, int& pm, int& pn) {
    const int nwg = nM * nN; int wgid = L;
    { const int q = nwg / NXCD, r = nwg % NXCD, xcd = wgid % NXCD, off = wgid / NXCD; wgid = (xcd < r ? xcd * (q + 1) : r * (q + 1) + (xcd - r) * q) + off; }
    const int nig = WGM * nN, gid = wgid / nig, fm = gid * WGM, gsz = (nM - fm) < WGM ? (nM - fm) : WGM;
    pm = fm + ((wgid % nig) % gsz); pn = (wgid % nig) / gsz;
}

__device__ __forceinline__ const char* uptr(const char* p) { const unsigned long long v = (unsigned long long)p; const unsigned lo = __builtin_amdgcn_readfirstlane((unsigned)v), hi = __builtin_amdgcn_readfirstlane((unsigned)(v >> 32)); return (const char*)(((unsigned long long)hi << 32) | lo); }
__device__ __forceinline__ const char* sopaque(const char* p) { unsigned long long v = (unsigned long long)p; asm volatile("" : "+s"(v)); return (const char*)v; }
__device__ __forceinline__ void order_unit_b(int L, int nM, int nN, int& pm, int& pn) {
    const int nwg = nM * nN; int wgid = L;
    { const int q = nwg / NXCD, r = nwg % NXCD, xcd = wgid % NXCD, off = wgid / NXCD; wgid = (xcd < r ? xcd * (q + 1) : r * (q + 1) + (xcd - r) * q) + off; }
    const int gN = (nN % 4 == 0) ? 4 : ((nN % 3 == 0) ? 3 : nN);
    const int per_g = nM * gN, g = wgid / per_g, w = wgid % per_g;
    const int blk = WGM * gN, pmb = w / blk, wi = w % blk, fm = pmb * WGM, gsz = (nM - fm) < WGM ? (nM - fm) : WGM;
    pm = fm + wi % gsz; pn = g * gN + wi / gsz;
}
#ifndef FFN8
#define FFN8 1
#endif
#ifndef HD_NT
#define HD_NT 0
#endif
#ifndef YC_NT
#define YC_NT 1
#endif
#ifndef HM_PLAIN_FROM
#define HM_PLAIN_FROM 1000
#endif
#ifndef CV_NT
#define CV_NT 1
#endif
#ifndef BG_DEFER
#define BG_DEFER 0
#endif
#ifndef BG_CVT
#define BG_CVT 0
#endif
#ifndef BAL_LDS
#define BAL_LDS 0
#endif
#ifndef QKV_PIPE
#define QKV_PIPE 1
#endif
#ifndef CONV_BATCH
#define CONV_BATCH 1
#endif
#ifndef ORDER_B
#define ORDER_B 1
#endif
template <int NM, int NN, bool F8 = false>
struct DenseSched {
    static constexpr bool GATHER = false, FP8 = F8; static constexpr int REPK = 1, REPE = 1;
    const char* A; const char* Bt; int KB  , G, c;
    __device__ __forceinline__ bool next(int i, Unit& u) const { const int L = i * G + c; if (L >= NM * NN) return false; if (ORDER_B) order_unit_b(L, NM, NN, u.pm, u.pn); else order_unit(L, NM, NN, u.pm, u.pn); u.e = 0; u.lt = i; return true; }
    __device__ __forceinline__ const char* aptr(const Unit& u) const { return A + (size_t)u.pm * BM * KB; }
    __device__ __forceinline__ const char* bptr(const Unit& u) const { return Bt + (size_t)u.pn * BM * KB; }
    __device__ __forceinline__ unsigned arow(const Unit&, int r) const { return (unsigned)r * (unsigned)KB; }
    __device__ __forceinline__ int ktiles() const { return KB / (BK * 2); }
};

#define PG8_SA(b, h) (((b) * 2 + (h)) * HTB)
#define PG8_SB(b, h) ((4 + (b) * 2 + (h)) * HTB)
template <int OFF> __device__ __forceinline__ void glds16_s(const char* sbase, unsigned voff, unsigned lbase) { unsigned keep;
    asm volatile("s_mov_b32 %0, m0\n\ts_add_u32 m0, %3, %4\n\ts_nop 0\n\tglobal_load_lds_dwordx4 %1, %2\n\ts_mov_b32 m0, %0" : "=&s"(keep) : "v"(voff), "s"(sbase), "s"(lbase), "i"(OFF) : "memory", "scc"); }
#define PG8_STAGE(bufoff, gbase, voff) do { const char* _gb = (const char*)(gbase); glds16_s<(bufoff)>(_gb, (voff)[0], ldsb); glds16_s<(bufoff) + 8192>(_gb, (voff)[1], ldsb); } while (0)
#define PG8_STAGE_A1(bufoff, gbase) do { if constexpr (Sched::GATHER) PG8_STAGE(bufoff, gbase, aof1); else PG8_STAGE(bufoff, (const char*)(gbase) + hstepA, aof0); } while (0)
#define PG8_LDA(dst, b, h) do { _Pragma("unroll") for (int m = 0; m < 4; ++m) _Pragma("unroll") for (int k = 0; k < 2; ++k) dst[m][k] = *(const LAS bf16x8*)(lds + PG8_SA(b, h) + aoff + m * 2048 + k * 1024); } while (0)
#define PG8_LDB(dst, b, h) do { _Pragma("unroll") for (int n = 0; n < 2; ++n) _Pragma("unroll") for (int k = 0; k < 2; ++k) dst[n][k] = *(const LAS bf16x8*)(lds + PG8_SB(b, h) + boff + n * 2048 + k * 1024); } while (0)
#define PG8_MMA(ai, bj, At, Bt) do { __builtin_amdgcn_s_setprio(1); _Pragma("unroll") for (int m = 0; m < 4; ++m) _Pragma("unroll") for (int n = 0; n < 2; ++n) _Pragma("unroll") for (int k = 0; k < 2; ++k) \
        acc[ai][bj][m][n] = __builtin_amdgcn_mfma_f32_16x16x32_bf16(Bt[n][k], At[m][k], acc[ai][bj][m][n], 0, 0, 0); __builtin_amdgcn_s_setprio(0); } while (0)
#define PG8_CAT(x) __builtin_shufflevector(__builtin_bit_cast(i32x4, x[0]), __builtin_bit_cast(i32x4, x[1]), 0, 1, 2, 3, 4, 5, 6, 7)
#define PG8_MMA8(ai, bj, At, Bt) do { __builtin_amdgcn_s_setprio(1); _Pragma("unroll") for (int m = 0; m < 4; ++m) _Pragma("unroll") for (int n = 0; n < 2; ++n) \
        acc[ai][bj][m][n] = __builtin_amdgcn_mfma_scale_f32_16x16x128_f8f6f4(PG8_CAT(Bt[n]), PG8_CAT(At[m]), acc[ai][bj][m][n], 0, 0, 0, 0, 0, 0); __builtin_amdgcn_s_setprio(0); } while (0)
#define PG8_MM(ai, bj, At, Bt) do { if constexpr (Sched::FP8) PG8_MMA8(ai, bj, At, Bt); else PG8_MMA(ai, bj, At, Bt); } while (0)
#define PG8_WAIT_V(n) asm volatile("s_waitcnt vmcnt(" #n ")" ::: "memory")
#define PG8_WAIT_L(n) asm volatile("s_waitcnt lgkmcnt(" #n ")" ::: "memory")
#define PG8_BAR __builtin_amdgcn_s_barrier()
#define PG8_SCHED __builtin_amdgcn_sched_barrier(0)

#if !NAIVE_GEMM
struct NoPre { __device__ __forceinline__ void operator()() const {} };
struct NoBg { __device__ __forceinline__ void issue(int) {} __device__ __forceinline__ void finish() {} };
template <class Epi, class Sched, bool ALIGN_EPI, class Pre = NoPre, class Bg = NoBg>
__device__ __forceinline__ void gemm_phase(LAS unsigned char* lds, const Sched& S, const Epi& E, const int wid, const Pre& pre = Pre(), Bg bg = Bg()) {
    const int lane = hw_lane(), tid = wid * 64 + lane, wr = wid >> 2, wc = wid & 3, fr = lane & 15, fq = lane >> 4;
    const int KB = S.KB, nt = S.ktiles();
    int R_[2], C_[2]; unsigned voffB[2]; unsigned aof0[2], aof1[2];
#pragma unroll
    for (int i = 0; i < 2; ++i) { int R, C; stage_rc(tid * 16 + i * 8192, R, C); R_[i] = R; C_[i] = C; const int Rb = Epi::PERM ? ((R & ~31) + perm32(R & 31)) : R;
        voffB[i] = (unsigned)(Rb * KB + C * 2); }
    const size_t kstep = (size_t)(BK * 2);
    const size_t hstep = (size_t)HALF * KB;
    const size_t hstepA = (size_t)S.arow(Unit{0, 0, 0, 0}, HALF);
    const unsigned ldsb = (unsigned)(size_t)lds + (unsigned)wid * 1024u;
    const int aoff = lds_byte(wr * 64 + fr, fq * 8), boff = lds_byte(wc * 32 + fr, fq * 8);
    Unit cur, nxt; int ui = 0;
    if (!S.next(0, cur)) { pre(); return; }
    f32x4 acc[2][2][4][2];
#pragma unroll
    for (int a = 0; a < 2; ++a)
#pragma unroll
        for (int b = 0; b < 2; ++b)
#pragma unroll
            for (int m = 0; m < 4; ++m)
#pragma unroll
                for (int n = 0; n < 2; ++n) acc[a][b][m][n] = (f32x4){0.f, 0.f, 0.f, 0.f};
    bf16x8 At[4][2], B0[2][2], B1[2][2];
    const char* cA = uptr(S.aptr(cur)); const char* cB = uptr(S.bptr(cur));
#pragma unroll
    for (int i = 0; i < 2; ++i) { aof0[i] = S.arow(cur, R_[i]) + (unsigned)C_[i] * 2u; aof1[i] = Sched::GATHER ? S.arow(cur, HALF + R_[i]) + (unsigned)C_[i] * 2u : 0u; }
#if BAL_LDS == 1
    PG8_STAGE(PG8_SB(0, 0), cB, voffB); PG8_STAGE(PG8_SB(0, 1), cB + hstep, voffB); PG8_STAGE(PG8_SA(0, 0), cA, aof0); PG8_STAGE_A1(PG8_SA(0, 1), cA);
    PG8_STAGE(PG8_SB(1, 0), cB + kstep, voffB); PG8_STAGE(PG8_SA(1, 0), cA + kstep, aof0);
    pre();
    PG8_WAIT_V(4);
    if (wr == 1) PG8_BAR;
    PG8_BAR;
#else
    PG8_STAGE(PG8_SB(0, 0), cB, voffB); PG8_STAGE(PG8_SB(0, 1), cB + hstep, voffB); PG8_STAGE(PG8_SA(0, 0), cA, aof0); PG8_STAGE_A1(PG8_SA(0, 1), cA);
    pre();
    if (wr == 1) PG8_BAR;
    PG8_WAIT_V(2); PG8_BAR;
    PG8_STAGE(PG8_SB(1, 0), cB + kstep, voffB); PG8_STAGE(PG8_SA(1, 0), cA + kstep, aof0); PG8_STAGE(PG8_SB(1, 1), cB + hstep + kstep, voffB);
    PG8_WAIT_V(6); PG8_BAR;
#endif
    for (;;) {
        const bool has_next = S.next((ui + 1) / Sched::REPK, nxt);
        const char* nA = uptr(has_next ? S.aptr(nxt) : cA); const char* nB = uptr(has_next ? S.bptr(nxt) : cB);
        int ntok0[2], ntok1[2];
        if constexpr (Sched::GATHER) {
#pragma unroll
            for (int i = 0; i < 2; ++i) { int R, C; stage_rc((wid * 64 + hw_lane()) * 16 + i * 8192, R, C); ntok0[i] = S.arow_raw(has_next ? nxt : cur, R); ntok1[i] = S.arow_raw(has_next ? nxt : cur, HALF + R); }
        }
#if BAL_LDS
        PG8_SCHED; PG8_LDB(B0, 0, 0);
#endif
        for (int t = 0; t < nt; t += 2) {
            const bool last = (t == nt - 2);
            const char* a1 = cA + (size_t)(t + 1) * kstep;
            const char* a2 = last ? nA : cA + (size_t)(t + 2) * kstep; const char* b2 = last ? nB : cB + (size_t)(t + 2) * kstep;
            const char* a3 = a2 + kstep; const char* b3 = b2 + kstep;
#if BAL_LDS == 1
            const char* b1 = cB + (size_t)(t + 1) * kstep;
            PG8_LDA(At, 0, 0); PG8_STAGE_A1(PG8_SA(1, 1), a1); PG8_STAGE(PG8_SB(1, 1), b1 + hstep, voffB);
            PG8_WAIT_V(8); PG8_WAIT_L(0); PG8_BAR;
            PG8_LDB(B1, 0, 1); PG8_SCHED; PG8_MM(0, 0, At, B0); PG8_MM(0, 1, At, B1); PG8_BAR; PG8_SCHED;
            if constexpr (Sched::GATHER) { if (last) {
#pragma unroll
                for (int i = 0; i < 2; ++i) { int R, C; stage_rc((wid * 64 + hw_lane()) * 16 + i * 8192, R, C); aof0[i] = S.arow_fin(ntok0[i]) + (unsigned)C * 2u; aof1[i] = S.arow_fin(ntok1[i]) + (unsigned)C * 2u; } } }
            PG8_LDA(At, 0, 1); PG8_STAGE(PG8_SB(0, 0), b2, voffB); PG8_STAGE(PG8_SA(0, 0), a2, aof0);
            PG8_WAIT_V(8); PG8_WAIT_L(0); PG8_BAR;
            PG8_MM(1, 0, At, B0); PG8_SCHED; PG8_LDB(B0, 1, 0); PG8_SCHED; PG8_MM(1, 1, At, B1); PG8_BAR; PG8_SCHED;
            PG8_LDA(At, 1, 0); PG8_STAGE_A1(PG8_SA(0, 1), a2); PG8_STAGE(PG8_SB(0, 1), b2 + hstep, voffB);
            PG8_WAIT_V(8); PG8_WAIT_L(0); PG8_BAR;
            PG8_LDB(B1, 1, 1); PG8_SCHED; PG8_MM(0, 0, At, B0); PG8_MM(0, 1, At, B1); PG8_BAR; PG8_SCHED;
            PG8_LDA(At, 1, 1); PG8_STAGE(PG8_SB(1, 0), b3, voffB); PG8_STAGE(PG8_SA(1, 0), a3, aof0);
            PG8_WAIT_V(8); PG8_WAIT_L(0); PG8_BAR;
            PG8_MM(1, 0, At, B0); PG8_SCHED; if (!last) PG8_LDB(B0, 0, 0); PG8_SCHED; PG8_MM(1, 1, At, B1); PG8_BAR; PG8_SCHED;
#else
            if (BAL_LDS != 2) PG8_LDB(B0, 0, 0); PG8_LDB(B1, 0, 1); PG8_SCHED; PG8_LDA(At, 0, 0); PG8_STAGE_A1(PG8_SA(1, 1), a1);
            PG8_WAIT_V(8); PG8_WAIT_L(0); PG8_BAR; PG8_MM(0, 0, At, B0); PG8_MM(0, 1, At, B1); PG8_BAR; PG8_SCHED;
            if constexpr (Sched::GATHER) { if (last) {
#pragma unroll
                for (int i = 0; i < 2; ++i) { int R, C; stage_rc((wid * 64 + hw_lane()) * 16 + i * 8192, R, C); aof0[i] = S.arow_fin(ntok0[i]) + (unsigned)C * 2u; aof1[i] = S.arow_fin(ntok1[i]) + (unsigned)C * 2u; } } }
            PG8_LDA(At, 0, 1); PG8_STAGE(PG8_SB(0, 0), b2, voffB); PG8_STAGE(PG8_SB(0, 1), b2 + hstep, voffB); PG8_STAGE(PG8_SA(0, 0), a2, aof0);
            PG8_WAIT_V(8); PG8_WAIT_L(0); PG8_BAR; PG8_MM(1, 0, At, B0); if (BAL_LDS == 2) { PG8_SCHED; PG8_LDB(B0, 1, 0); PG8_SCHED; } PG8_MM(1, 1, At, B1); PG8_BAR; PG8_SCHED;
            if (BAL_LDS != 2) PG8_LDB(B0, 1, 0); PG8_LDB(B1, 1, 1); PG8_SCHED; PG8_LDA(At, 1, 0); PG8_STAGE_A1(PG8_SA(0, 1), a2);
            PG8_WAIT_V(8); PG8_WAIT_L(0); PG8_BAR; PG8_MM(0, 0, At, B0); PG8_MM(0, 1, At, B1); PG8_BAR; PG8_SCHED;
            PG8_LDA(At, 1, 1); PG8_STAGE(PG8_SB(1, 0), b3, voffB); PG8_STAGE(PG8_SB(1, 1), b3 + hstep, voffB); PG8_STAGE(PG8_SA(1, 0), a3, aof0);
            PG8_WAIT_V(8); PG8_WAIT_L(0); PG8_BAR; PG8_MM(1, 0, At, B0); if (BAL_LDS == 2) { PG8_SCHED; if (!last) PG8_LDB(B0, 0, 0); PG8_SCHED; } PG8_MM(1, 1, At, B1); PG8_BAR; PG8_SCHED;
#endif
        }
        if constexpr (ALIGN_EPI) { if (wr == 0) PG8_BAR; }
#if BG_DEFER
        PG8_SCHED; bg.finish(); bg.issue(ui); PG8_SCHED;
#else
        bg.issue(ui);
#endif
        if (Sched::REPK == 1 || (ui % Sched::REPK) == Sched::REPK - 1) { for (int re = 0; re < Sched::REPE * Epi::REPE; ++re) E(acc, cur, wr, wc, fr, fq); }
#if !BG_DEFER
        PG8_SCHED; bg.finish(); PG8_SCHED;
#endif
        if (!has_next) break;
#pragma unroll
        for (int a = 0; a < 2; ++a)
#pragma unroll
            for (int b = 0; b < 2; ++b)
#pragma unroll
                for (int m = 0; m < 4; ++m)
#pragma unroll
                    for (int n = 0; n < 2; ++n) acc[a][b][m][n] = (f32x4){0.f, 0.f, 0.f, 0.f};
        cur = nxt; cA = nA; cB = nB; ++ui;
        if constexpr (!Sched::GATHER) {   }
        if constexpr (ALIGN_EPI) { if (wr == 1) PG8_BAR; }
    }
#if BG_DEFER
    bg.finish();
#endif
    PG8_WAIT_V(0);
    if constexpr (!ALIGN_EPI) { if (wr == 0) PG8_BAR; }
    PG8_BAR;
}
#else
struct NoPre { __device__ __forceinline__ void operator()() const {} };
struct NoBg { __device__ __forceinline__ void issue(int) {} __device__ __forceinline__ void finish() {} };
template <class Epi, class Sched, bool ALIGN_EPI, class Pre = NoPre, class Bg = NoBg>
__device__ __forceinline__ void gemm_phase(LAS unsigned char* lds, const Sched& S, const Epi& E, const int wid, const Pre& pre = Pre(), Bg bg = Bg()) {
    const int lane = hw_lane(), tid = wid * 64 + lane, wr = wid >> 2, wc = wid & 3, fr = lane & 15, fq = lane >> 4;
    const int K = S.KB / 2; static_assert(!Sched::FP8, "naive body is bf16 only");
    Unit cur;
    for (int ui = 0; S.next(ui, cur); ++ui) {
        f32x4 acc[2][2][4][2];
        const char* cA = S.aptr(cur); const char* cB = S.bptr(cur);
#pragma unroll
        for (int ai = 0; ai < 2; ++ai)
#pragma unroll
            for (int m = 0; m < 4; ++m) {
                const char* arow = cA + S.arow(cur, ai * HALF + wr * 64 + m * 16 + fr);
#pragma unroll
                for (int bj = 0; bj < 2; ++bj)
#pragma unroll
                    for (int n = 0; n < 2; ++n) {
                        float s[4] = {0.f, 0.f, 0.f, 0.f};
                        const int c0 = bj * HALF + wc * 32 + (Epi::PERM ? (8 * fq + 4 * n) : (16 * n + 4 * fq));
                        for (int k = 0; k < K; k += 8) {
                            const u32x4 av = *(const u32x4*)(arow + (size_t)k * 2);
#pragma unroll
                            for (int i = 0; i < 4; ++i) {
                                const u32x4 bv = *(const u32x4*)(cB + ((size_t)(c0 + i) * K + k) * 2);
                                s[i] += bflo(av.x) * bflo(bv.x) + bfhi(av.x) * bfhi(bv.x) + bflo(av.y) * bflo(bv.y) + bfhi(av.y) * bfhi(bv.y)
                                      + bflo(av.z) * bflo(bv.z) + bfhi(av.z) * bfhi(bv.z) + bflo(av.w) * bflo(bv.w) + bfhi(av.w) * bfhi(bv.w);
                            }
                        }
                        acc[ai][bj][m][n] = (f32x4){s[0], s[1], s[2], s[3]};
                    }
            }
        bg.issue(ui); E(acc, cur, wr, wc, fr, fq); bg.finish();
    }
    (void)lds;
}
#endif
}

constexpr size_t MiB = 1u << 20;
constexpr size_t WS_CTL = 0, CTL_ZERO_BYTES = 1 * MiB;
constexpr size_t WS_MISC = 1 * MiB;
constexpr size_t WS_ROPE = 2 * MiB;
constexpr size_t WS_SSQ = 5 * MiB;
constexpr size_t WS_TOKEP = 7 * MiB;
constexpr size_t WS_TOKG = 7 * MiB + 512 * 1024;
constexpr size_t WS_LRSTD = 8 * MiB;
constexpr size_t WS_LIST = 9 * MiB;
constexpr size_t WS_WIN = 10 * MiB, WS_WOUT = 16 * MiB, WS_WGU = 18 * MiB, WS_WD = 32 * MiB, WS_WQKV = 39 * MiB, WS_WO = 42 * MiB;
constexpr size_t WS_EWGU = 44 * MiB, WS_EWD = 100 * MiB;
constexpr size_t WS_XQ = 128 * MiB;
constexpr size_t WS_HB = 160 * MiB;
constexpr size_t WS_ACT = 224 * MiB;
constexpr size_t WS_BC = WS_ACT, WS_VC = WS_ACT + 64 * MiB, WS_YC = WS_ACT + 128 * MiB, WS_HD = WS_ACT;
constexpr size_t WS_Q = WS_ACT, WS_KB = WS_ACT + 64 * MiB, WS_VB = WS_ACT + 80 * MiB, WS_O = WS_ACT + 128 * MiB;
constexpr size_t WS_Y = WS_ACT, WS_HM = WS_ACT + 132 * MiB;
constexpr size_t WS_YP = 480 * MiB;
constexpr size_t WS_END = 508 * MiB;
constexpr size_t WS_WGU8 = 508 * MiB, WS_WD8 = 516 * MiB, WS_END2 = 520 * MiB;
constexpr int DOWN_MAIN_TILES = 256, DOWN_KS = 7;
constexpr size_t HM_TILE_BYTES = (size_t)256 * DFF;
constexpr int HM_OUT_TILES = 146, HM_WS_TILES = 118, MAX_TILES = 264;
static_assert(HM_OUT_TILES * HM_TILE_BYTES <= (size_t)M * D * 4 && WS_HM + HM_WS_TILES * HM_TILE_BYTES <= WS_END && WS_Y + (size_t)MAX_TILES * 256 * D * 2 <= WS_HM, "MoE map");
static_assert(HM_OUT_TILES + HM_WS_TILES >= MAX_TILES && WS_HD + (size_t)M * DFF * 2 <= WS_END, "capacity");
constexpr float H1Q_SCALE = 16.f, WGU8_SCALE = 256.f, HDQ_SCALE = 8.f, WD8_SCALE = 512.f;
constexpr float XQ_SCALE = 32.f, WGU_SCALE = 256.f, HQ_SCALE = 8.f, WD_SCALE = 16.f;
constexpr size_t MS_MB = 0, MS_BM = 64 * 1024, MS_VM = 128 * 1024, MS_YCM = 192 * 1024, MS_HM = 256 * 1024, MS_HMB = 320 * 1024, MS_HDM = 384 * 1024,
                 MS_SSQ0 = 512 * 1024, MS_SSQ1 = 513 * 1024, MS_SSQ2 = 516 * 1024, MS_KM = 528 * 1024, MS_VMETA = 536 * 1024;
constexpr int CW_TMO = 0, CW_CODE = 1, CW_BAR = 4096, CW_CNT = 16384;
constexpr int RING_BYTES = 131072, LDSCTL_OFF = RING_BYTES, MISC_OFF = LDSCTL_OFF + 320, LDS_BYTES = 147456;
constexpr int NWAVES = 8;

#define RLX_AGENT __ATOMIC_RELAXED, __HIP_MEMORY_SCOPE_AGENT
#define LDS_WAIT() asm volatile("s_waitcnt lgkmcnt(0)" ::: "memory")
#define VM_WAIT() asm volatile("s_waitcnt vmcnt(0)" ::: "memory")
__device__ __forceinline__ unsigned f2bf(float f) { unsigned u = __builtin_bit_cast(unsigned, f); return (u + 0x7fffu + ((u >> 16) & 1u)) >> 16; }
__device__ __forceinline__ unsigned pk2(float lo, float hi) { return f2bf(lo) | (f2bf(hi) << 16); }
__device__ __forceinline__ float clamp8(float v) { return __builtin_amdgcn_fmed3f(v, -448.f, 448.f); }
__device__ __forceinline__ unsigned pk4_fp8(float a, float b, float c, float d) { unsigned w = 0u; w = (unsigned)__builtin_amdgcn_cvt_pk_fp8_f32(clamp8(a), clamp8(b), (int)w, false); w = (unsigned)__builtin_amdgcn_cvt_pk_fp8_f32(clamp8(c), clamp8(d), (int)w, true); return w; }

namespace pg8 {
__device__ __forceinline__ float rstd_from_ssq(const float* ssq, int row) {
    const f32x4* p = (const f32x4*)((const char*)ssq + (unsigned)row * 64u);
    const f32x4 a = p[0], b = p[1], c = p[2], d = p[3];
    const float s = (((a.x + a.y) + (a.z + a.w)) + ((b.x + b.y) + (b.z + b.w))) + (((c.x + c.y) + (c.z + c.w)) + ((d.x + d.y) + (d.z + d.w)));
    return __builtin_amdgcn_rsqf(s * (1.0f / (float)D) + RMS_EPS);
}
__device__ __forceinline__ u32x4 pack8(const f32x4 v0, const f32x4 v1) { u32x4 w; w.x = cvt_pk_bf16(v0[0], v0[1]); w.y = cvt_pk_bf16(v0[2], v0[3]); w.z = cvt_pk_bf16(v1[0], v1[1]); w.w = cvt_pk_bf16(v1[2], v1[3]); return w; }
__device__ __forceinline__ float silu_mul(float g, float u) { return g * u * __builtin_amdgcn_rcpf(1.0f + __builtin_amdgcn_exp2f(-g * LOG2E)); }

constexpr int RSTD_TAB_OFF = RING_BYTES_ + 1024, RSTD_TAB_MAX_UNITS = 14;
template <class Sched>
__device__ __forceinline__ void rstd_table_fill(const Sched& S, const float* ssq, LAS float* tab, int tid) {
    LAS int* pml = (LAS int*)(tab + RSTD_TAB_MAX_UNITS * BM);
    Unit u; int n = 0;
    for (int i = 0; S.next(i, u); ++i) if (i < RSTD_TAB_MAX_UNITS) { if (tid == 0) pml[i] = u.pm; n = i + 1; }
    __syncthreads();
#pragma unroll 4
    for (int idx = tid; idx < n * BM; idx += NWAVES * 64) tab[idx] = rstd_from_ssq(ssq, pml[idx >> 8] * BM + (idx & (BM - 1)));
}
static_assert(RSTD_TAB_OFF + RSTD_TAB_MAX_UNITS * BM * 4 + RSTD_TAB_MAX_UNITS * 4 <= LDS_BYTES, "rstd table");
struct EpiConvIn {
    static constexpr bool PERM = true; static constexpr int REPE = PROBE_DEPI;
    bf16* Bc; bf16* Vc; const LAS float* rtab;
    __device__ __forceinline__ void operator()(const f32x4 (&acc)[2][2][4][2], const Unit& u, int wr, int wc, int fr, int fq) const {
        int row0 = u.pm * BM + wr * 64 + fr; asm volatile("" : "+v"(row0));
#pragma unroll
        for (int ai = 0; ai < 2; ++ai)
#pragma unroll
            for (int m = 0; m < 4; ++m) {
                const int row = row0 + ai * HALF + m * 16; const float r = rtab[u.lt * BM + ai * HALF + wr * 64 + m * 16 + fr];
                if (u.pn < 4) {
#pragma unroll
                    for (int bj = 0; bj < 2; ++bj) { const u32x4 w = pack8(acc[ai][bj][m][0] * r, acc[ai][bj][m][1] * r); u32x4* p = (u32x4*)((char*)Bc + (unsigned)(row * D + u.pn * BM + bj * HALF + wc * 32 + 8 * fq) * 2u); if (CV_NT) __builtin_nontemporal_store(w, p); else *p = w; }
                } else {
                    const float r2 = r * r;
                    { const u32x4 w = pack8(acc[ai][0][m][0] * acc[ai][1][m][0] * r2, acc[ai][0][m][1] * acc[ai][1][m][1] * r2); u32x4* p = (u32x4*)((char*)Vc + (unsigned)(row * D + (u.pn - 4) * HALF + wc * 32 + 8 * fq) * 2u); if (CV_NT) __builtin_nontemporal_store(w, p); else *p = w; }
                }
            }
    }
};
template <bool Q8 = false, bool HALFB = false>
struct EpiResidT {
    static constexpr bool PERM = true; static constexpr int REPE = 1;
    bf16* hb; float* ssq; float sc  ; unsigned char* q8  ;
    __device__ __forceinline__ void operator()(const f32x4 (&acc)[2][2][4][2], const Unit& u, int wr, int wc, int fr, int fq) const {
        int row0 = u.pm * BM + wr * 64 + fr; asm volatile("" : "+v"(row0));
        unsigned off0 = (unsigned)(row0 * D + u.pn * BM + wc * 32 + 8 * fq) * 2u; asm volatile("" : "+v"(off0));
        char* hp = (char*)sopaque((const char*)hb);
        u32x4 b[2][4][2];
#pragma unroll
        for (int ai = 0; ai < (HALFB ? 1 : 2); ++ai)
#pragma unroll
            for (int m = 0; m < 4; ++m)
#pragma unroll
                for (int bj = 0; bj < 2; ++bj) b[ai][m][bj] = *(const GAS u32x4*)(hp + (off0 + (unsigned)(((ai * HALF + m * 16) * D + bj * HALF) * 2)));
#pragma unroll
        for (int ai = 0; ai < 2; ++ai) {
            if (HALFB && ai == 1) {
#pragma unroll
                for (int m = 0; m < 4; ++m)
#pragma unroll
                    for (int bj = 0; bj < 2; ++bj) b[1][m][bj] = *(const GAS u32x4*)(hp + (off0 + (unsigned)(((HALF + m * 16) * D + bj * HALF) * 2)));
            }
#pragma unroll
            for (int m = 0; m < 4; ++m) {
                const int row = row0 + ai * HALF + m * 16; float q = 0.f;
#pragma unroll
                for (int bj = 0; bj < 2; ++bj) {
                    const u32x4 bb = b[ai][m][bj];
                    const f32x4 v0 = acc[ai][bj][m][0] * sc + (f32x4){bflo(bb.x), bfhi(bb.x), bflo(bb.y), bfhi(bb.y)}, v1 = acc[ai][bj][m][1] * sc + (f32x4){bflo(bb.z), bfhi(bb.z), bflo(bb.w), bfhi(bb.w)};
                    const u32x4 pk = pack8(v0, v1);
                    *(GAS u32x4*)(hp + (off0 + (unsigned)(((ai * HALF + m * 16) * D + bj * HALF) * 2))) = pk;
                    if constexpr (Q8) {
                        const f32x4 w0 = v0 * H1Q_SCALE, w1 = v1 * H1Q_SCALE;
                        *(GAS u32x2*)((char*)sopaque((const char*)q8) + ((off0 >> 1) + (unsigned)((ai * HALF + m * 16) * D + bj * HALF))) = (u32x2){pk4_fp8(w0[0], w0[1], w0[2], w0[3]), pk4_fp8(w1[0], w1[1], w1[2], w1[3])};
                    }
                    q += ((v0[0] * v0[0] + v0[1] * v0[1]) + (v0[2] * v0[2] + v0[3] * v0[3])) + ((v1[0] * v1[0] + v1[1] * v1[1]) + (v1[2] * v1[2] + v1[3] * v1[3]));
                }
                q += __shfl_xor(q, 16); q += __shfl_xor(q, 32);
                if (fq == 0) *(float*)((char*)ssq + (unsigned)(row * 16 + u.pn * 4 + wc) * 4u) = q;
            }
        }
    }
};
typedef EpiResidT<false, false> EpiResid;
template <bool OUT8 = true>
struct EpiSwiGLU8T {
    static constexpr bool PERM = true; static constexpr int REPE = PROBE_DEPI;
    unsigned char* H; const LAS float* rtab;
    __device__ __forceinline__ void operator()(const f32x4 (&acc)[2][2][4][2], const Unit& u, int wr, int wc, int fr, int fq) const {
        int row0 = u.pm * BM + wr * 64 + fr; asm volatile("" : "+v"(row0));
        constexpr float s = 1.0f / (H1Q_SCALE * WGU8_SCALE);
#pragma unroll
        for (int ai = 0; ai < 2; ++ai)
#pragma unroll
            for (int m = 0; m < 4; ++m) {
                const int row = row0 + ai * HALF + m * 16; const float r = rtab[u.lt * BM + ai * HALF + wr * 64 + m * 16 + fr] * s; const float c1 = -r * LOG2E, c3 = __builtin_amdgcn_rcpf(r * r * (OUT8 ? HDQ_SCALE : 1.0f));
                f32x4 h[2];
#pragma unroll
                for (int n = 0; n < 2; ++n) {
                    const f32x4 g = acc[ai][0][m][n], uu = acc[ai][1][m][n]; const f32x4 t = g * c1; f32x4 e;
#pragma unroll
                    for (int i = 0; i < 4; ++i) e[i] = __builtin_amdgcn_exp2f(t[i]);
                    const f32x4 d = e * c3 + c3; f32x4 rr;
#pragma unroll
                    for (int i = 0; i < 4; ++i) rr[i] = __builtin_amdgcn_rcpf(d[i]);
                    h[n] = (g * uu) * rr;
                }
                if constexpr (OUT8) { if (HD_NT) __builtin_nontemporal_store((u32x2){pk4_fp8(h[0][0], h[0][1], h[0][2], h[0][3]), pk4_fp8(h[1][0], h[1][1], h[1][2], h[1][3])}, (u32x2*)((char*)H + (unsigned)(row * DFF + u.pn * HALF + wc * 32 + 8 * fq)));
                    else *(u32x2*)((char*)H + (unsigned)(row * DFF + u.pn * HALF + wc * 32 + 8 * fq)) = (u32x2){pk4_fp8(h[0][0], h[0][1], h[0][2], h[0][3]), pk4_fp8(h[1][0], h[1][1], h[1][2], h[1][3])}; }
                else __builtin_nontemporal_store(pack8(h[0], h[1]), (u32x4*)((char*)H + (unsigned)(row * DFF + u.pn * HALF + wc * 32 + 8 * fq) * 2u));
            }
    }
};
struct EpiSwiGLU {
    static constexpr bool PERM = true; static constexpr int REPE = PROBE_DEPI;
    bf16* H; const LAS float* rtab;
    __device__ __forceinline__ void operator()(const f32x4 (&acc)[2][2][4][2], const Unit& u, int wr, int wc, int fr, int fq) const {
        int row0 = u.pm * BM + wr * 64 + fr; asm volatile("" : "+v"(row0));
#pragma unroll
        for (int ai = 0; ai < 2; ++ai)
#pragma unroll
            for (int m = 0; m < 4; ++m) {
                const int row = row0 + ai * HALF + m * 16; const float r = rtab[u.lt * BM + ai * HALF + wr * 64 + m * 16 + fr]; const float c1 = -r * LOG2E, c3 = __builtin_amdgcn_rcpf(r * r);
                f32x4 h[2];
#pragma unroll
                for (int n = 0; n < 2; ++n) {
                    const f32x4 g = acc[ai][0][m][n], uu = acc[ai][1][m][n]; const f32x4 t = g * c1; f32x4 e;
#pragma unroll
                    for (int i = 0; i < 4; ++i) e[i] = __builtin_amdgcn_exp2f(t[i]);
                    const f32x4 d = e * c3 + c3; f32x4 rr;
#pragma unroll
                    for (int i = 0; i < 4; ++i) rr[i] = __builtin_amdgcn_rcpf(d[i]);
                    h[n] = (g * uu) * rr;
                }
                __builtin_nontemporal_store(pack8(h[0], h[1]), (u32x4*)((char*)H + (unsigned)(row * DFF + u.pn * HALF + wc * 32 + 8 * fq) * 2u));
            }
    }
};
struct EpiQKV {
    static constexpr bool PERM = true; static constexpr int REPE = PROBE_DEPI;
    bf16* Q; bf16* Kb; bf16* Vb; const LAS float* rtab; const float* bias; const f32x2* rope;
    __device__ __forceinline__ void operator()(const f32x4 (&acc)[2][2][4][2], const Unit& u, int wr, int wc, int fr, int fq) const {
        int row0 = u.pm * BM + wr * 64 + fr; asm volatile("" : "+v"(row0));
        if (u.pn < 5) {
            const int cb = (u.pn < 4 ? u.pn * BM : D) + wc * 64 + 8 * fq;
            const f32x4 b00 = *(const f32x4*)(bias + cb), b01 = *(const f32x4*)(bias + cb + 4), b10 = *(const f32x4*)(bias + cb + 32), b11 = *(const f32x4*)(bias + cb + 36);
            const float sc = u.pn < 4 ? QSCALE : 1.0f;
#if QKV_PIPE
            const char* rbase = sopaque((const char*)rope);
            unsigned roff = (unsigned)((NMETA + (row0 & (SEQ - 1))) * 32 + 8 * fq) * 8u; asm volatile("" : "+v"(roff));
            f32x4 rq[8][4];
#pragma unroll
            for (int it = 0; it < 4; ++it)
#pragma unroll
                for (int j = 0; j < 4; ++j) rq[it][j] = *(const GAS f32x4*)(rbase + (roff + (unsigned)((((it >> 2) * HALF + (it & 3) * 16) * 32) * 8 + j * 16)));
#pragma unroll
            for (int it = 0; it < 8; ++it) {
                    const int ai = it >> 2, m = it & 3;
                    const int row = row0 + ai * HALF + m * 16; const float r = rtab[u.lt * BM + ai * HALF + wr * 64 + m * 16 + fr];
                    f32x4 lo0 = acc[ai][0][m][0] * r + b00, lo1 = acc[ai][0][m][1] * r + b01, hi0 = acc[ai][1][m][0] * r + b10, hi1 = acc[ai][1][m][1] * r + b11;
                    f32x4 ol0, ol1, oh0, oh1;
#pragma unroll
                    for (int i = 0; i < 4; ++i) {
                        const f32x2 c0 = {rq[it][i >> 1][2 * (i & 1)], rq[it][i >> 1][2 * (i & 1) + 1]}, c1 = {rq[it][2 + (i >> 1)][2 * (i & 1)], rq[it][2 + (i >> 1)][2 * (i & 1) + 1]};
                        ol0[i] = (lo0[i] * c0.x - hi0[i] * c0.y) * sc; oh0[i] = (hi0[i] * c0.x + lo0[i] * c0.y) * sc;
                        ol1[i] = (lo1[i] * c1.x - hi1[i] * c1.y) * sc; oh1[i] = (hi1[i] * c1.x + lo1[i] * c1.y) * sc;
                    }
                    if (u.pn < 4) { char* p = (char*)Q + (unsigned)(row * D + u.pn * BM + wc * 64 + 8 * fq) * 2u; *(u32x4*)p = pack8(ol0, ol1); *(u32x4*)(p + 64) = pack8(oh0, oh1); }
                    else          { char* p = (char*)Kb + (unsigned)(row * KVD + wc * 64 + 8 * fq) * 2u;          *(u32x4*)p = pack8(ol0, ol1); *(u32x4*)(p + 64) = pack8(oh0, oh1); }
                    if (it + 4 < 8) {
#pragma unroll
                        for (int j = 0; j < 4; ++j) rq[it + 4][j] = *(const GAS f32x4*)(rbase + (roff + (unsigned)(((((it + 4) >> 2) * HALF + ((it + 4) & 3) * 16) * 32) * 8 + j * 16)));
                    }
            }
#else
#pragma unroll
            for (int ai = 0; ai < 2; ++ai)
#pragma unroll
                for (int m = 0; m < 4; ++m) {
                    const int row = row0 + ai * HALF + m * 16; const float r = rtab[u.lt * BM + ai * HALF + wr * 64 + m * 16 + fr];
                    const f32x2* rp = (const f32x2*)((const char*)rope + (unsigned)((NMETA + (row & (SEQ - 1))) * 32 + 8 * fq) * 8u);
                    f32x4 lo0 = acc[ai][0][m][0] * r + b00, lo1 = acc[ai][0][m][1] * r + b01, hi0 = acc[ai][1][m][0] * r + b10, hi1 = acc[ai][1][m][1] * r + b11;
                    f32x4 ol0, ol1, oh0, oh1;
#pragma unroll
                    for (int i = 0; i < 4; ++i) {
                        const f32x2 c0 = rp[i], c1 = rp[4 + i];
                        ol0[i] = (lo0[i] * c0.x - hi0[i] * c0.y) * sc; oh0[i] = (hi0[i] * c0.x + lo0[i] * c0.y) * sc;
                        ol1[i] = (lo1[i] * c1.x - hi1[i] * c1.y) * sc; oh1[i] = (hi1[i] * c1.x + lo1[i] * c1.y) * sc;
                    }
                    if (u.pn < 4) { char* p = (char*)Q + (unsigned)(row * D + u.pn * BM + wc * 64 + 8 * fq) * 2u; *(u32x4*)p = pack8(ol0, ol1); *(u32x4*)(p + 64) = pack8(oh0, oh1); }
                    else          { char* p = (char*)Kb + (unsigned)(row * KVD + wc * 64 + 8 * fq) * 2u;          *(u32x4*)p = pack8(ol0, ol1); *(u32x4*)(p + 64) = pack8(oh0, oh1); }
                }
#endif
        } else {
#pragma unroll
            for (int bj = 0; bj < 2; ++bj) {
                const int c = bj * HALF + wc * 32 + 8 * fq;
                const f32x4 b0 = *(const f32x4*)(bias + D + KVD + c), b1 = *(const f32x4*)(bias + D + KVD + c + 4);
#pragma unroll
                for (int ai = 0; ai < 2; ++ai)
#pragma unroll
                    for (int m = 0; m < 4; ++m) {
                        const int row = row0 + ai * HALF + m * 16; const float r = rtab[u.lt * BM + ai * HALF + wr * 64 + m * 16 + fr];
                        *(u32x4*)((char*)Vb + (unsigned)(row * KVD + c) * 2u) = pack8(acc[ai][bj][m][0] * r + b0, acc[ai][bj][m][1] * r + b1);
                    }
            }
        }
    }
};
}
#define XB_TMO      128
#define XB_XCNT(j)  (256  + 64 * (j))
#define XB_XSUB(j)  (1280 + 64 * (j))
#define XB_XGEN(j)  (2304 + 64 * (j))
#define XB_TOP      3328
#define XB_TOPGEN   3392
#define XCD_BAR_WORDS 3456
#define XB_SPIN_CAP (1u << 18)

__device__ __forceinline__ unsigned xb_ld(unsigned* p)              { return __hip_atomic_load(p, __ATOMIC_RELAXED, __HIP_MEMORY_SCOPE_AGENT); }
__device__ __forceinline__ unsigned xb_add(unsigned* p, unsigned v) { return __hip_atomic_fetch_add(p, v, __ATOMIC_RELAXED, __HIP_MEMORY_SCOPE_AGENT); }
__device__ __forceinline__ unsigned xb_xcc_id() { return (unsigned)__builtin_amdgcn_s_getreg((3 << 11) | 20) & 0xFu; }
#define XB_SPIN(cond, bar) do { unsigned _sp = 0; while (cond) { __builtin_amdgcn_s_sleep(1); \
    if ((++_sp & 255u) == 0u) { if (xb_ld(&(bar)[XB_TMO])) break; if (_sp > XB_SPIN_CAP) { atomicAdd(&(bar)[XB_TMO], 1u); break; } } } } while (0)

struct XcdBarrier {
    unsigned* bar; unsigned x;
    volatile LAS unsigned* st;
};

__device__ __forceinline__ XcdBarrier xcd_barrier_post(unsigned* bar, volatile LAS unsigned* st, int wave) {
    XcdBarrier b; b.bar = bar; b.x = xb_xcc_id(); b.st = st;
    if (wave == 0 && hw_lane() == 0) (void)xb_add(&bar[XB_XCNT(b.x)], 1u);
    return b;
}
__device__ __forceinline__ void xcd_barrier_complete(unsigned* bar, unsigned x, unsigned& nloc, unsigned& nx) {
    const unsigned G = gridDim.x * gridDim.y * gridDim.z;
    unsigned sum, cnt, mine, sp = 0u;
    for (;;) {
        sum = 0u; cnt = 0u; mine = 0u;
#pragma unroll
        for (unsigned j = 0; j < 16; ++j) { const unsigned c = xb_ld(&bar[XB_XCNT(j)]); sum += c; cnt += (c > 0u) ? 1u : 0u; mine = (j == x) ? c : mine; }
        if (sum == G) break;
        __builtin_amdgcn_s_sleep(1);
        if ((++sp & 255u) == 0u) { if (xb_ld(&bar[XB_TMO])) break; if (sp > XB_SPIN_CAP) { atomicAdd(&bar[XB_TMO], 1u); break; } }
    }
    nloc = mine > 0u ? mine : 1u; nx = cnt > 0u ? cnt : 1u;
}

__device__ __forceinline__ void xcd_barrier(const XcdBarrier& b, int wave) {
    asm volatile("s_waitcnt vmcnt(0)" ::: "memory");
    __syncthreads();
    if (wave == 0 && hw_lane() == 0) {
        unsigned* bar = b.bar;
        __builtin_amdgcn_s_waitcnt(0);
        unsigned nloc = b.st[0], nx = b.st[1];
        if (nloc == 0u) { xcd_barrier_complete(bar, b.x, nloc, nx); b.st[0] = nloc; b.st[1] = nx; }
        const unsigned old = xb_add(&bar[XB_XSUB(b.x)], 1u);
        const unsigned gen = old / nloc;
        if (old + 1u == (gen + 1u) * nloc) {
            __builtin_amdgcn_fence(__ATOMIC_RELEASE, "agent");
            asm volatile("s_waitcnt vmcnt(0)" ::: "memory");
            const unsigned og = xb_add(&bar[XB_TOP], 1u);
            const unsigned tg = og / nx;
            if (og + 1u == (tg + 1u) * nx) xb_add(&bar[XB_TOPGEN], 1u);
            else XB_SPIN(xb_ld(&bar[XB_TOPGEN]) == tg, bar);
            __builtin_amdgcn_fence(__ATOMIC_ACQUIRE, "agent");
            xb_add(&bar[XB_XGEN(b.x)], 1u);
            asm volatile("s_waitcnt vmcnt(0)" ::: "memory");
        } else {
            XB_SPIN(xb_ld(&bar[XB_XGEN(b.x)]) == gen, bar);
            __builtin_amdgcn_fence(__ATOMIC_ACQUIRE, "agent");
            asm volatile("s_waitcnt vmcnt(0)" ::: "memory");
        }
    }
    __syncthreads();
}

struct MoeInfo { int ts[9]; int cnt[8]; };
__device__ __forceinline__ void moe_info_load(const unsigned* ctl, MoeInfo& mi) {
    int t = 0;
#pragma unroll
    for (int e = 0; e < 8; ++e) { const int c = (int)__builtin_amdgcn_readfirstlane(__hip_atomic_load(ctl + CW_CNT + 64 * e, RLX_AGENT)); mi.cnt[e] = c; mi.ts[e] = t; t += (c + 255) >> 8; }
    mi.ts[8] = t;
}
__device__ __forceinline__ void moe_info_to_lds(const unsigned* ctl, LAS int* ml, int wave) {
    MoeInfo mi; moe_info_load(ctl, mi);
    if (wave == 0 && hw_lane() == 0) {
#pragma unroll
        for (int e = 0; e < 9; ++e) ml[e] = mi.ts[e];
#pragma unroll
        for (int e = 0; e < 8; ++e) ml[16 + e] = mi.cnt[e];
    }
    __syncthreads();
}
__device__ __forceinline__ void moe_find(const LAS int* ml, int T, int& e, int& ts, int& ne) {
    int ee = 0;
#pragma unroll
    for (int j = 1; j < 8; ++j) ee += (T >= ml[j]) ? 1 : 0;
    e = __builtin_amdgcn_readfirstlane(ee); ts = __builtin_amdgcn_readfirstlane(ml[e]); ne = __builtin_amdgcn_readfirstlane(ml[16 + e]);
}
__device__ __forceinline__ char* hm_tile_ptr(unsigned char* dout, unsigned char* ws, int ltc  ) {
    return (char*)(ltc < HM_OUT_TILES ? dout + (size_t)ltc * HM_TILE_BYTES : ws + WS_HM + (size_t)(ltc - HM_OUT_TILES) * HM_TILE_BYTES);
}
namespace pg8 {
struct MoeUpSched {
    static constexpr bool GATHER = true, FP8 = true; static constexpr int REPK = PROBE_KL, REPE = PROBE_EPI;
    const char* A; const char* Bt; const int* list; const LAS int* ml; int KB, nM, G, c, tbase; static constexpr int nN = NGU / 256;
    __device__ __forceinline__ bool next(int i, Unit& u) const {
        const int L = i * G + c; if (L >= nM * nN) return false;
        int pmc; order_unit(L, nM, nN, pmc, u.pn); const int T = tbase + pmc; int e, ts, ne; moe_find(ml, T, e, ts, ne);
        u.pm = T; u.e = e | (ne << 4); u.lt = T - ts; u.ord = i; return true; }
    __device__ __forceinline__ const char* aptr(const Unit&) const { return A; }
    __device__ __forceinline__ const char* bptr(const Unit& u) const { return Bt + ((size_t)(u.e & 15) * NGU + (size_t)u.pn * BM) * D; }
    __device__ __forceinline__ unsigned arow(const Unit& u, int r) const { const int idx = u.lt * BM + r; const int tok = idx < (u.e >> 4) ? list[(size_t)(u.e & 15) * M + idx] : 0; return (unsigned)tok * (unsigned)D; }
    __device__ __forceinline__ int arow_raw(const Unit& u, int r) const { const int ne = u.e >> 4; int idx = u.lt * BM + r; idx = idx < ne ? idx : ne - 1; return list[(size_t)(u.e & 15) * M + idx]; }
    __device__ __forceinline__ unsigned arow_fin(int tok) const { return (unsigned)tok * (unsigned)D; }    __device__ __forceinline__ int ktiles() const { return KB / (BK * 2); }
};
struct MoeDownSched {
    static constexpr bool GATHER = false, FP8 = true; static constexpr int REPK = 1, REPE = 1;
    unsigned char* dout; unsigned char* ws; const char* Bt; const LAS int* ml; int KB, nM, G, c, tbase; static constexpr int nN = D / 256;
    __device__ __forceinline__ bool next(int i, Unit& u) const {
        int L = i * G + c; if (L >= nM * nN) return false;
        if (HM_PLAIN_FROM < 64 && (nM * nN) % G == 0) L = (nM * nN / G - 1 - i) * G + c;
        int pmc; order_unit(L, nM, nN, pmc, u.pn); const int T = tbase + pmc;
        int e, ts, ne; moe_find(ml, T, e, ts, ne);
        u.pm = T; u.e = e; u.lt = 0; return true; }
    __device__ __forceinline__ const char* aptr(const Unit& u) const { return hm_tile_ptr(dout, ws, u.pm - tbase); }
    __device__ __forceinline__ const char* bptr(const Unit& u) const { return Bt + ((size_t)(u.e & 15) * D + (size_t)u.pn * BM) * DFF; }
    __device__ __forceinline__ unsigned arow(const Unit&, int r) const { return (unsigned)r * (unsigned)DFF; }    __device__ __forceinline__ int ktiles() const { return KB / (BK * 2); }
};
struct MoeDownTailSched {
    static constexpr bool GATHER = false, FP8 = true; static constexpr int REPK = 1, REPE = 1;
    unsigned char* dout; unsigned char* ws; const char* Bt; const LAS int* ml; int KB, nsub, G, c;
    __device__ __forceinline__ bool next(int i, Unit& u) const {
        const int q = i * G + c; if (q >= nsub) return false;
        const int tr = q / (4 * DOWN_KS), rem = q % (4 * DOWN_KS); u.pn = rem / DOWN_KS; u.lt = rem % DOWN_KS; u.pm = DOWN_MAIN_TILES + tr;
        int e, ts, ne; moe_find(ml, u.pm, e, ts, ne); u.e = e; return true; }
    __device__ __forceinline__ const char* aptr(const Unit& u) const { return hm_tile_ptr(dout, ws, u.pm) + u.lt * 512; }
    __device__ __forceinline__ const char* bptr(const Unit& u) const { return Bt + ((size_t)(u.e & 15) * D + (size_t)u.pn * BM) * DFF + u.lt * 512; }
    __device__ __forceinline__ unsigned arow(const Unit&, int r) const { return (unsigned)r * (unsigned)DFF; }
    __device__ __forceinline__ int ktiles() const { int n = 4; asm volatile("" : "+s"(n)); return n; }
};

struct EpiMoeUp {
    static constexpr bool PERM = true; static constexpr int REPE = 1;
    unsigned char* dout; unsigned char* ws; int tbase;
    __device__ __forceinline__ void operator()(const f32x4 (&acc)[2][2][4][2], const Unit& u, int wr, int wc, int fr, int fq) const {
        constexpr float s = 1.0f / (XQ_SCALE * WGU_SCALE), c1 = -s * LOG2E, c3 = 1.0f / (s * s * HQ_SCALE);
        unsigned off0 = (unsigned)((wr * 64 + fr) * DFF + u.pn * HALF + wc * 32 + 8 * fq); asm volatile("" : "+v"(off0));
        char* H = (char*)pg8::sopaque(hm_tile_ptr(dout, ws, u.pm - tbase)) + off0;
#pragma unroll
        for (int ai = 0; ai < 2; ++ai)
#pragma unroll
            for (int m = 0; m < 4; ++m) {
                f32x4 h[2];
#pragma unroll
                for (int n = 0; n < 2; ++n) {
                    const f32x4 g = acc[ai][0][m][n], uu = acc[ai][1][m][n]; const f32x4 t = g * c1; f32x4 e;
#pragma unroll
                    for (int i = 0; i < 4; ++i) e[i] = __builtin_amdgcn_exp2f(t[i]);
                    const f32x4 d = e * c3 + c3; f32x4 r;
#pragma unroll
                    for (int i = 0; i < 4; ++i) r[i] = __builtin_amdgcn_rcpf(d[i]);
                    h[n] = (g * uu) * r;
                }
                const u32x2 hw = (u32x2){pk4_fp8(h[0][0], h[0][1], h[0][2], h[0][3]), pk4_fp8(h[1][0], h[1][1], h[1][2], h[1][3])};
                if (u.ord >= HM_PLAIN_FROM) *(u32x2*)(H + (ai * HALF + m * 16) * DFF) = hw; else __builtin_nontemporal_store(hw, (u32x2*)(H + (ai * HALF + m * 16) * DFF));
            }
    }
};
struct EpiMoeDown {
    static constexpr bool PERM = true; static constexpr int REPE = 1;
    unsigned char* Y;
    __device__ __forceinline__ void operator()(const f32x4 (&acc)[2][2][4][2], const Unit& u, int wr, int wc, int fr, int fq) const {
        unsigned off0 = (unsigned)((u.pm * BM + wr * 64 + fr) * D + u.pn * BM + wc * 32 + 8 * fq); asm volatile("" : "+v"(off0));
        char* Yp = (char*)pg8::sopaque((const char*)Y) + off0;
#pragma unroll
        for (int ai = 0; ai < 2; ++ai)
#pragma unroll
            for (int m = 0; m < 4; ++m)
#pragma unroll
                for (int bj = 0; bj < 2; ++bj) { const f32x4 v0 = acc[ai][bj][m][0], v1 = acc[ai][bj][m][1];
                    *(u32x2*)(Yp + (ai * HALF + m * 16) * D + bj * HALF) = (u32x2){pk4_fp8(v0[0], v0[1], v0[2], v0[3]), pk4_fp8(v1[0], v1[1], v1[2], v1[3])}; }
    }
};
struct EpiMoeDownPart {
    static constexpr bool PERM = true; static constexpr int REPE = 1;
    bf16* P;
    __device__ __forceinline__ void operator()(const f32x4 (&acc)[2][2][4][2], const Unit& u, int wr, int wc, int fr, int fq) const {
        unsigned off0 = (unsigned)((((u.pm - DOWN_MAIN_TILES) * 4 + u.pn) * DOWN_KS + u.lt) * 65536 + (wr * 64 + fr) * 256 + wc * 32 + 8 * fq) * 2u; asm volatile("" : "+v"(off0));
        char* Pp = (char*)pg8::sopaque((const char*)P) + off0;
#pragma unroll
        for (int ai = 0; ai < 2; ++ai)
#pragma unroll
            for (int m = 0; m < 4; ++m)
#pragma unroll
                for (int bj = 0; bj < 2; ++bj) *(u32x4*)(Pp + ((ai * HALF + m * 16) * 256 + bj * HALF) * 2) = pack8(acc[ai][bj][m][0], acc[ai][bj][m][1]);
    }
};
}

constexpr int META_LDS_OFF = RING_BYTES + 1024;
static_assert(META_LDS_OFF + 7 * 64 * 8 * 4 <= LDS_BYTES, "meta scratch");
template <class F>
__device__ __forceinline__ void meta_dual(LAS unsigned char* lds, const bf16* A, int K, const bf16* Bt, int n0, int n1, int lane, int wave, const F& epi) {
    const int r16 = lane & 15, kq = lane >> 4; const int kw = K / 8, kb = wave * kw;
    const bf16* ap = A + (size_t)r16 * K + kb + 8 * kq; const bf16* b0p = Bt + (size_t)(n0 + r16) * K + kb + 8 * kq; const bf16* b1p = Bt + (size_t)(n1 + r16) * K + kb + 8 * kq;
    f32x4 acc0 = (f32x4){0.f, 0.f, 0.f, 0.f}, acc1 = (f32x4){0.f, 0.f, 0.f, 0.f};
#pragma unroll 2
    for (int k = 0; k < kw; k += 64) {
        const bf16x8 a = *(const bf16x8*)(ap + k), b0 = *(const bf16x8*)(b0p + k), b1 = *(const bf16x8*)(b1p + k);
        const bf16x8 a2 = *(const bf16x8*)(ap + k + 32), b02 = *(const bf16x8*)(b0p + k + 32), b12 = *(const bf16x8*)(b1p + k + 32);
        acc0 = __builtin_amdgcn_mfma_f32_16x16x32_bf16(a, b0, acc0, 0, 0, 0); acc1 = __builtin_amdgcn_mfma_f32_16x16x32_bf16(a, b1, acc1, 0, 0, 0);
        acc0 = __builtin_amdgcn_mfma_f32_16x16x32_bf16(a2, b02, acc0, 0, 0, 0); acc1 = __builtin_amdgcn_mfma_f32_16x16x32_bf16(a2, b12, acc1, 0, 0, 0);
    }
    LAS f32x4* sc = (LAS f32x4*)(lds + META_LDS_OFF);
    if (wave > 0) { sc[((wave - 1) * 64 + lane) * 2] = acc0; sc[((wave - 1) * 64 + lane) * 2 + 1] = acc1; }
    __syncthreads();
    if (wave == 0) {
#pragma unroll
        for (int w = 0; w < 7; ++w) { acc0 += sc[(w * 64 + lane) * 2]; acc1 += sc[(w * 64 + lane) * 2 + 1]; }
        epi(acc0, acc1, r16, kq);
    }
}
__device__ __forceinline__ f32x4 meta_rstd_parts(const float* parts, int lane) {
    float s = 0.f;
    for (int j = 0; j < 32; ++j) s += parts[j * 16 + (lane & 15)];
    const float r = 1.0f / sqrtf(s * (1.0f / (float)D) + RMS_EPS); const int kq = lane >> 4; f32x4 o;
#pragma unroll
    for (int g = 0; g < 4; ++g) o[g] = __shfl(r, 4 * kq + g);
    return o;
}

__device__ __forceinline__ void p0_item(const float* W, int ldw, int K, int k0, int n0, bf16* dst, const float* gain, LAS float* scr, int lane) {
    { float t[32]; const float* wp = W + (size_t)(k0 + (lane >> 5)) * ldw + n0 + (lane & 31);
#pragma unroll
      for (int i = 0; i < 32; ++i) t[i] = wp[(size_t)(2 * i) * ldw];
#pragma unroll
      for (int i = 0; i < 32; ++i) scr[(2 * i + (lane >> 5)) * 33 + (lane & 31)] = t[i]; }
    LDS_WAIT(); asm volatile("" ::: "memory");
    const int c = lane & 7;
    float g[8];
#pragma unroll
    for (int e = 0; e < 8; ++e) g[e] = gain ? gain[k0 + 8 * c + e] : 1.0f;
#pragma unroll
    for (int j = 0; j < 4; ++j) { const int n = (lane >> 3) + 8 * j; const LAS float* s = scr + (8 * c) * 33 + n;
        u32x4 o; o.x = pk2(s[0 * 33] * g[0], s[1 * 33] * g[1]); o.y = pk2(s[2 * 33] * g[2], s[3 * 33] * g[3]); o.z = pk2(s[4 * 33] * g[4], s[5 * 33] * g[5]); o.w = pk2(s[6 * 33] * g[6], s[7 * 33] * g[7]);
        *(GAS u32x4*)(dst + (size_t)n * K + k0 + 8 * c) = o; }
    LDS_WAIT(); asm volatile("" ::: "memory");
}
__device__ __forceinline__ void p0_item_dual(const float* W, int ldw, int K, int k0, int n0, bf16* dst, unsigned char* dst8, const float* gain, float sc, LAS float* scr, int lane) {
    { float t[32]; const float* wp = W + (size_t)(k0 + (lane >> 5)) * ldw + n0 + (lane & 31);
#pragma unroll
      for (int i = 0; i < 32; ++i) t[i] = wp[(size_t)(2 * i) * ldw];
#pragma unroll
      for (int i = 0; i < 32; ++i) scr[(2 * i + (lane >> 5)) * 33 + (lane & 31)] = t[i]; }
    LDS_WAIT(); asm volatile("" ::: "memory");
    const int c = lane & 7;
    float g[8];
#pragma unroll
    for (int e = 0; e < 8; ++e) g[e] = gain ? gain[k0 + 8 * c + e] : 1.0f;
#pragma unroll
    for (int j = 0; j < 4; ++j) { const int n = (lane >> 3) + 8 * j; const LAS float* s = scr + (8 * c) * 33 + n;
        float v[8];
#pragma unroll
        for (int e = 0; e < 8; ++e) v[e] = s[e * 33] * g[e];
        u32x4 o; o.x = pk2(v[0], v[1]); o.y = pk2(v[2], v[3]); o.z = pk2(v[4], v[5]); o.w = pk2(v[6], v[7]);
        *(GAS u32x4*)(dst + (size_t)n * K + k0 + 8 * c) = o;
        u32x2 o8; o8.x = pk4_fp8(v[0] * sc, v[1] * sc, v[2] * sc, v[3] * sc); o8.y = pk4_fp8(v[4] * sc, v[5] * sc, v[6] * sc, v[7] * sc);
        *(GAS u32x2*)(dst8 + (size_t)n * K + k0 + 8 * c) = o8; }
    LDS_WAIT(); asm volatile("" ::: "memory");
}
__device__ __forceinline__ void p0_item8(const float* W, int ldw, int K, int k0, int n0, unsigned char* dst, const float* gain, float sc, LAS float* scr, int lane) {
    { float t[32]; const float* wp = W + (size_t)(k0 + (lane >> 5)) * ldw + n0 + (lane & 31);
#pragma unroll
      for (int i = 0; i < 32; ++i) t[i] = wp[(size_t)(2 * i) * ldw];
#pragma unroll
      for (int i = 0; i < 32; ++i) scr[(2 * i + (lane >> 5)) * 33 + (lane & 31)] = t[i]; }
    LDS_WAIT(); asm volatile("" ::: "memory");
    const int c = lane & 7;
    float g[8];
#pragma unroll
    for (int e = 0; e < 8; ++e) g[e] = (gain ? gain[k0 + 8 * c + e] : 1.0f) * sc;
#pragma unroll
    for (int j = 0; j < 4; ++j) { const int n = (lane >> 3) + 8 * j; const LAS float* s = scr + (8 * c) * 33 + n;
        u32x2 o; o.x = pk4_fp8(s[0 * 33] * g[0], s[1 * 33] * g[1], s[2 * 33] * g[2], s[3 * 33] * g[3]); o.y = pk4_fp8(s[4 * 33] * g[4], s[5 * 33] * g[5], s[6 * 33] * g[6], s[7 * 33] * g[7]);
        *(GAS u32x2*)(dst + (size_t)n * K + k0 + 8 * c) = o; }
    LDS_WAIT(); asm volatile("" ::: "memory");
}
__device__ __forceinline__ int ileave(int ch, int kind) { return 256 * (ch >> 7) + 128 * kind + (ch & 127); }

struct Args { const float* in[21]; float* out; unsigned char* ws; float inv[32]; int ph_lo, ph_hi; };

constexpr int EXP_ITEMS = 24 * 16 * 112, BG_ORDS = 20, BG_P1 = 6, BG_P4 = 14;
__device__ __forceinline__ int bg_cover(int G) { if (!BG_CVT) return 0; const int c = BG_ORDS * G * NWAVES; return c < EXP_ITEMS ? c : EXP_ITEMS; }
struct ExpertCvtBg {
    const float* gate; const float* up; const float* down; const float* gain; unsigned char* ws; int first, base_ord, nmax, gw, NGW;
    f32x4 t[8]; f32x4 gA, gB; unsigned char* dbase; unsigned doff; int K; float sc; bool active;
    __device__ __forceinline__ void issue(int ui) {
        const int r = first + (base_ord + ui) * NGW + gw;
        active = ui < nmax && r < EXP_ITEMS;
        if (!active) return;
        const int mat = r / (16 * 112), q = r - mat * (16 * 112), kind = mat >> 3, e = mat & 7;
        const int ln = hw_lane(), kq = ln >> 3, nq = ln & 7;
        const float* W; int ldw, k0, n0;
        if (kind < 2) { const int kb = q / 112, nb = q - kb * 112; k0 = kb * 64; n0 = nb * 32; W = (kind ? up : gate) + (size_t)e * D * DFF; ldw = DFF; K = D; sc = WGU_SCALE;
            dbase = ws + WS_EWGU + ((size_t)e * NGU + ileave(n0, kind)) * D; }
        else { const int kb = q >> 5, nb = q & 31; k0 = kb * 64; n0 = nb * 32; W = down + (size_t)e * DFF * D; ldw = D; K = DFF; sc = WD_SCALE; dbase = ws + WS_EWD + ((size_t)e * D + n0) * DFF; }
        const GAS float* wp = (const GAS float*)W + (size_t)(k0 + 8 * kq) * ldw + n0 + 4 * nq;
#pragma unroll
        for (int j = 0; j < 8; ++j) t[j] = *(const GAS f32x4*)(wp + (size_t)j * ldw);
        if (kind < 2) { gA = *(const GAS f32x4*)(gain + k0 + 8 * kq); gB = *(const GAS f32x4*)(gain + k0 + 8 * kq + 4); } else { gA = (f32x4){1.f, 1.f, 1.f, 1.f}; gB = gA; }
        doff = (unsigned)((4 * nq) * K + k0 + 8 * kq);
    }
    __device__ __forceinline__ void finish() {
        if (!active) return;
        active = false;
        const float g[8] = {gA.x * sc, gA.y * sc, gA.z * sc, gA.w * sc, gB.x * sc, gB.y * sc, gB.z * sc, gB.w * sc};
#pragma unroll
        for (int i = 0; i < 4; ++i) {
            u32x2 o; o.x = pk4_fp8(t[0][i] * g[0], t[1][i] * g[1], t[2][i] * g[2], t[3][i] * g[3]); o.y = pk4_fp8(t[4][i] * g[4], t[5][i] * g[5], t[6][i] * g[6], t[7][i] * g[7]);
            *(GAS u32x2*)(dbase + (doff + (unsigned)(i * K))) = o;
        }
    }
};

__device__ __forceinline__ void p0_prologue(const Args& a, LAS unsigned char* lds, int vcu, int G, int wave, int lane) {
    unsigned char* ws = a.ws;
    LAS float* scr = (LAS float*)(lds + wave * 16384);
    const int gw = vcu * NWAVES + wave, NGW = G * NWAVES;
    constexpr int I_WIN = 16 * 96, I_WOUT = 16 * 32, I_G = 16 * 112, I_DN = 56 * 32, I_QKV = 16 * 48, I_WO = 16 * 32;
    constexpr int NITEMS = I_WIN + I_WOUT + 2 * I_G + I_DN + I_QKV + I_WO + 24 * I_G;
    static_assert(I_DN == I_G, "item counts");
    const int nitems = NITEMS - bg_cover(G);
    for (int it = gw; it < nitems; it += NGW) {
        int r = it;
        if (r < I_WIN) { const int kb = r / 96, nb = r % 96, n0 = nb * 32; int d0;
            if (n0 < D) d0 = n0; else if (n0 < 2 * D) d0 = D + ileave(n0 - D, 0); else d0 = D + ileave(n0 - 2 * D, 1);
            p0_item(a.in[3], NCONV, D, kb * 64, n0, (bf16*)(ws + WS_WIN) + (size_t)d0 * D, a.in[2], scr, lane); continue; } r -= I_WIN;
        if (r < I_WOUT) { const int kb = r / 32, nb = r % 32; p0_item(a.in[5], D, D, kb * 64, nb * 32, (bf16*)(ws + WS_WOUT) + (size_t)(nb * 32) * D, nullptr, scr, lane); continue; } r -= I_WOUT;
        if (r < I_G) { const int kb = r / 112, nb = r % 112;
            if (FFN8) p0_item_dual(a.in[7], DFF, D, kb * 64, nb * 32, (bf16*)(ws + WS_WGU) + (size_t)ileave(nb * 32, 0) * D, ws + WS_WGU8 + (size_t)ileave(nb * 32, 0) * D, a.in[6], WGU8_SCALE, scr, lane);
            else p0_item(a.in[7], DFF, D, kb * 64, nb * 32, (bf16*)(ws + WS_WGU) + (size_t)ileave(nb * 32, 0) * D, a.in[6], scr, lane); continue; } r -= I_G;
        if (r < I_G) { const int kb = r / 112, nb = r % 112;
            if (FFN8) p0_item_dual(a.in[8], DFF, D, kb * 64, nb * 32, (bf16*)(ws + WS_WGU) + (size_t)ileave(nb * 32, 1) * D, ws + WS_WGU8 + (size_t)ileave(nb * 32, 1) * D, a.in[6], WGU8_SCALE, scr, lane);
            else p0_item(a.in[8], DFF, D, kb * 64, nb * 32, (bf16*)(ws + WS_WGU) + (size_t)ileave(nb * 32, 1) * D, a.in[6], scr, lane); continue; } r -= I_G;
        if (r < I_DN) { const int kb = r / 32, nb = r % 32;
            if (FFN8) p0_item_dual(a.in[9], D, DFF, kb * 64, nb * 32, (bf16*)(ws + WS_WD) + (size_t)(nb * 32) * DFF, ws + WS_WD8 + (size_t)(nb * 32) * DFF, nullptr, WD8_SCALE, scr, lane);
            else p0_item(a.in[9], D, DFF, kb * 64, nb * 32, (bf16*)(ws + WS_WD) + (size_t)(nb * 32) * DFF, nullptr, scr, lane); continue; } r -= I_DN;
        if (r < I_QKV) { const int kb = r / 48, nb = r % 48, n0 = nb * 32; int d0;
            if (n0 < D + KVD) { const int c = n0 & 255; d0 = (n0 & ~255) + 128 * ((c >> 5) & 1) + 32 * (c >> 6); } else d0 = n0;
            p0_item(a.in[11], NQKV, D, kb * 64, n0, (bf16*)(ws + WS_WQKV) + (size_t)d0 * D, a.in[10], scr, lane); continue; } r -= I_QKV;
        if (r < I_WO) { const int kb = r / 32, nb = r % 32; p0_item(a.in[14], D, D, kb * 64, nb * 32, (bf16*)(ws + WS_WO) + (size_t)(nb * 32) * D, nullptr, scr, lane); continue; } r -= I_WO;
        { const int mat = r / I_G, q = r % I_G, kind = mat >> 3, e = mat & 7;
          if (kind < 2) { const int kb = q / 112, nb = q % 112;
              p0_item8(a.in[17 + kind] + (size_t)e * D * DFF, DFF, D, kb * 64, nb * 32, ws + WS_EWGU + ((size_t)e * NGU + ileave(nb * 32, kind)) * D, a.in[15], WGU_SCALE, scr, lane); }
          else { const int kb = q / 32, nb = q % 32;
              p0_item8(a.in[19] + (size_t)e * DFF * D, D, DFF, kb * 64, nb * 32, ws + WS_EWD + ((size_t)e * D + nb * 32) * DFF, nullptr, WD_SCALE, scr, lane); } }
    }
    {
        bf16* hb = (bf16*)(ws + WS_HB); float* ssq = (float*)(ws + WS_SSQ);
        constexpr int RB = 4;
        for (int m0 = gw; m0 < M + NMETA; m0 += RB * NGW) {
            f32x4 v[RB][4];
#pragma unroll
            for (int q = 0; q < RB; ++q) { const int m = m0 + q * NGW < M + NMETA ? m0 + q * NGW : m0; const bool meta = m >= M;
                const GAS f32x4* xr = (const GAS f32x4*)(meta ? a.in[1] + (size_t)(m - M) * D : a.in[0] + (size_t)m * D) + lane;
#pragma unroll
                for (int j = 0; j < 4; ++j) v[q][j] = xr[64 * j]; }
#pragma unroll
            for (int q = 0; q < RB; ++q) { const int m = m0 + q * NGW; if (m >= M + NMETA) break; const bool meta = m >= M;
                float s = 0.f;
#pragma unroll
                for (int j = 0; j < 4; ++j) s += (v[q][j].x * v[q][j].x + v[q][j].y * v[q][j].y) + (v[q][j].z * v[q][j].z + v[q][j].w * v[q][j].w);
                s = wave_sum(s);
                bf16* orow = meta ? (bf16*)(ws + WS_MISC + MS_MB) + (size_t)(m - M) * D : hb + (size_t)m * D;
                GAS unsigned long long* o8 = (GAS unsigned long long*)orow + lane;
#pragma unroll
                for (int j = 0; j < 4; ++j) o8[64 * j] = (unsigned long long)pk2(v[q][j].x, v[q][j].y) | ((unsigned long long)pk2(v[q][j].z, v[q][j].w) << 32);
                if (meta) { if (lane == 0) ((float*)(ws + WS_MISC + MS_SSQ0))[m - M] = s; }
                else if (lane < 16) ssq[(size_t)m * 16 + lane] = lane == 0 ? s : 0.f; }
        }
    }
    {
        f32x2* rope = (f32x2*)(ws + WS_ROPE);
        const int gt = gw * 64 + lane, NGT = NGW * 64;
        for (int idx = gt; idx < LPOS * 32; idx += NGT) {
            const int p = idx >> 5, f = idx & 31; const float ang = (float)p * a.inv[f];
            const double rev = (double)ang * 0.15915494309189535; const float fr = (float)(rev - rint(rev));
            rope[idx] = (f32x2){__builtin_amdgcn_cosf(fr), __builtin_amdgcn_sinf(fr)};
        }
    }
}

__device__ __forceinline__ void unpack8(const u32x4 w, float (&f)[8]) { f[0] = bflo(w.x); f[1] = bfhi(w.x); f[2] = bflo(w.y); f[3] = bfhi(w.y); f[4] = bflo(w.z); f[5] = bfhi(w.z); f[6] = bflo(w.w); f[7] = bfhi(w.w); }
__device__ __forceinline__ void conv_phase(const Args& a, int G, int tid) {
    unsigned char* ws = a.ws;
    const bf16* Bc = (const bf16*)(ws + WS_BC); const bf16* Vc = (const bf16*)(ws + WS_VC); bf16* Yc = (bf16*)(ws + WS_YC);
    const float* vm = (const float*)(ws + WS_MISC + MS_VM); const float* cw = a.in[4];
    const int cg = tid & 127, strip = tid >> 7, ch0 = cg * 8;
    float w0[8], w1[8], w2[8];
#pragma unroll
    for (int e = 0; e < 8; ++e) { w0[e] = cw[ch0 + e]; w1[e] = cw[D + ch0 + e]; w2[e] = cw[2 * D + ch0 + e]; }
    for (int blk = blockIdx.x; blk < M / 128; blk += G) {
        const int r0 = blk * 128 + strip * 32;
        float p2[8], p1[8];
        if ((r0 & (SEQ - 1)) == 0) {
#pragma unroll
            for (int e = 0; e < 8; ++e) { p2[e] = vm[14 * D + ch0 + e]; p1[e] = vm[15 * D + ch0 + e]; }
        } else { unpack8(*(const u32x4*)(Vc + (size_t)(r0 - 2) * D + ch0), p2); unpack8(*(const u32x4*)(Vc + (size_t)(r0 - 1) * D + ch0), p1); }
#if CONV_BATCH
        const GAS char* vp = (const GAS char*)Vc + ((size_t)r0 * D + ch0) * 2; const GAS char* bp = (const GAS char*)Bc + ((size_t)r0 * D + ch0) * 2; GAS char* yp = (GAS char*)Yc + ((size_t)r0 * D + ch0) * 2;
        u32x4 vq[2][8], bq[2][8];
#pragma unroll
        for (int i = 0; i < 8; ++i) { vq[0][i] = *(const GAS u32x4*)(vp + i * (D * 2)); bq[0][i] = *(const GAS u32x4*)(bp + i * (D * 2)); }
#pragma unroll
        for (int bt = 0; bt < 4; ++bt) {
            if (bt + 1 < 4) {
#pragma unroll
                for (int i = 0; i < 8; ++i) { vq[(bt + 1) & 1][i] = *(const GAS u32x4*)(vp + ((bt + 1) * 8 + i) * (D * 2)); bq[(bt + 1) & 1][i] = *(const GAS u32x4*)(bp + ((bt + 1) * 8 + i) * (D * 2)); }
            }
#pragma unroll
            for (int i = 0; i < 8; ++i) {
                float v[8], b[8]; unpack8(vq[bt & 1][i], v); unpack8(bq[bt & 1][i], b);
                float y[8];
#pragma unroll
                for (int e = 0; e < 8; ++e) { y[e] = b[e] * (w0[e] * p2[e] + w1[e] * p1[e] + w2[e] * v[e]); p2[e] = p1[e]; p1[e] = v[e]; }
                u32x4 o; o.x = cvt_pk_bf16(y[0], y[1]); o.y = cvt_pk_bf16(y[2], y[3]); o.z = cvt_pk_bf16(y[4], y[5]); o.w = cvt_pk_bf16(y[6], y[7]);
                if (YC_NT) __builtin_nontemporal_store(o, (GAS u32x4*)(yp + (bt * 8 + i) * (D * 2))); else *(GAS u32x4*)(yp + (bt * 8 + i) * (D * 2)) = o;
            }
        }
    }
#else
#pragma unroll 4
        for (int rr = 0; rr < 32; ++rr) {
            const size_t off = (size_t)(r0 + rr) * D + ch0;
            float v[8], b[8]; unpack8(*(const u32x4*)(Vc + off), v); unpack8(*(const u32x4*)(Bc + off), b);
            float y[8];
#pragma unroll
            for (int e = 0; e < 8; ++e) { y[e] = b[e] * (w0[e] * p2[e] + w1[e] * p1[e] + w2[e] * v[e]); p2[e] = p1[e]; p1[e] = v[e]; }
            u32x4 o; o.x = cvt_pk_bf16(y[0], y[1]); o.y = cvt_pk_bf16(y[2], y[3]); o.z = cvt_pk_bf16(y[4], y[5]); o.w = cvt_pk_bf16(y[6], y[7]);
            __builtin_nontemporal_store(o, (u32x4*)(Yc + off));
        }
    }
#endif
    if (blockIdx.x == (unsigned)(G - 1)) {
        const float* bm = (const float*)(ws + WS_MISC + MS_BM); bf16* ycm = (bf16*)(ws + WS_MISC + MS_YCM);
        for (int idx = tid; idx < NMETA * D; idx += NWAVES * 64) {
            const int i = idx >> 10, ch = idx & (D - 1);
            const float v0 = i >= 2 ? vm[(i - 2) * D + ch] : 0.f, v1 = i >= 1 ? vm[(i - 1) * D + ch] : 0.f, v2 = vm[i * D + ch];
            ycm[idx] = (bf16)f2bf(bm[idx] * (cw[ch] * v0 + cw[D + ch] * v1 + cw[2 * D + ch] * v2));
        }
    }
}

constexpr int KIMG_ROW = 144, AT_NSLOT = 3, KIMG_BYTES = AT_NSLOT * 128 * KIMG_ROW, VT_ROW = AT_NSLOT * 128 * 2 + 8, VT_BYTES = 64 * VT_ROW;
static_assert(KIMG_BYTES + VT_BYTES <= RING_BYTES, "attention LDS");
constexpr int QPRE_N = 2;
template <int QI, bool FIRST>
__device__ __forceinline__ void attn_qgroup(const LAS unsigned char* kimg, const LAS unsigned char* vimg, int pbase, int cbase, const bf16x8 (&qf)[4], bf16x8 (&qpre)[4], const bf16* qn, bf16* Og, float sk, int lane) {
    const int q = lane & 31, h = lane >> 5;
    f32x16 S[5];
#pragma unroll
    for (int bi = 0; bi < 5; ++bi) S[bi] = (f32x16){};
#pragma unroll
    for (int s = 0; s < 4; ++s)
#pragma unroll
        for (int bi = 0; bi < 5; ++bi) {
            const int rowbase = (bi < 4 - QI) ? pbase + 32 * (QI + bi) : cbase + 32 * (bi - (4 - QI));
            const bf16x8 kf = *(const LAS bf16x8*)(kimg + (rowbase + q) * KIMG_ROW + (16 * s + 8 * h) * 2);
            S[bi] = __builtin_amdgcn_mfma_f32_32x32x16_bf16(kf, qf[s], S[bi], 0, 0, 0);
        }
    if (QI & 1) {
#pragma unroll
        for (int s = 0; s < QPRE_N; ++s) qpre[s] = *(const GAS bf16x8*)(qn + 16 * s);
    }
    int tq = q - 4 * h; asm volatile("" : "+v"(tq));
    float mx = sk;
#pragma unroll
    for (int bi = 0; bi < 5; ++bi) {
        const bool prev = bi < 4 - QI; const int kb = prev ? QI + bi : bi - (4 - QI);
#pragma unroll
        for (int r = 0; r < 16; ++r) {
            const int cr = (r & 3) + 8 * (r >> 2);
            float sv = S[bi][r];
            if (prev) {
                if (FIRST) { if (kb < 3) sv = -INFINITY; else { if (!(cr + 4 * h >= 16)) sv = -INFINITY; if (kb == QI && !(cr > tq)) sv = -INFINITY; } }
                else if (kb == QI) { if (!(cr > tq)) sv = -INFINITY; }
            } else if (kb == QI) { if (!(cr <= tq)) sv = -INFINITY; }
            S[bi][r] = sv; mx = fmaxf(mx, sv);
        }
    }
    mx = fmaxf(mx, __shfl_xor(mx, 32));
    float l = 0.f;
#pragma unroll
    for (int bi = 0; bi < 5; ++bi)
#pragma unroll
        for (int r = 0; r < 16; ++r) { const float p = __builtin_amdgcn_exp2f(S[bi][r] - mx); S[bi][r] = p; l += p; }
    l += __shfl_xor(l, 32); l += __builtin_amdgcn_exp2f(sk - mx);
    f32x16 O[2][2];
#pragma unroll
    for (int c = 0; c < 2; ++c) { O[c][0] = (f32x16){}; O[c][1] = (f32x16){}; }
#pragma unroll
    for (int bi = 0; bi < 5; ++bi) {
        const int rowbase = (bi < 4 - QI) ? pbase + 32 * (QI + bi) : cbase + 32 * (bi - (4 - QI));
#pragma unroll
        for (int s2 = 0; s2 < 2; ++s2) {
            u32x4 pw; pw.x = cvt_pk_bf16(S[bi][8 * s2 + 0], S[bi][8 * s2 + 1]); pw.y = cvt_pk_bf16(S[bi][8 * s2 + 2], S[bi][8 * s2 + 3]);
            pw.z = cvt_pk_bf16(S[bi][8 * s2 + 4], S[bi][8 * s2 + 5]); pw.w = cvt_pk_bf16(S[bi][8 * s2 + 6], S[bi][8 * s2 + 7]);
            const bf16x8 pf = __builtin_bit_cast(bf16x8, pw);
#pragma unroll
            for (int c = 0; c < 2; ++c) {
                const LAS unsigned char* vp = vimg + (32 * c + q) * VT_ROW + (rowbase + 16 * s2 + 4 * h) * 2;
                const u32x2 lo = *(const LAS u32x2*)vp, hi = *(const LAS u32x2*)(vp + 16);
                const u32x4 vw = (u32x4){lo.x, lo.y, hi.x, hi.y};
                O[c][s2] = __builtin_amdgcn_mfma_f32_32x32x16_bf16(__builtin_bit_cast(bf16x8, vw), pf, O[c][s2], 0, 0, 0);
            }
        }
    }
    const float inv = __builtin_amdgcn_rcpf(l);
    bf16* orow = Og + (size_t)(32 * QI + q) * D;
#pragma unroll
    for (int c = 0; c < 2; ++c)
#pragma unroll
        for (int u4 = 0; u4 < 4; ++u4) {
            u32x2 w; w.x = cvt_pk_bf16((O[c][0][4 * u4 + 0] + O[c][1][4 * u4 + 0]) * inv, (O[c][0][4 * u4 + 1] + O[c][1][4 * u4 + 1]) * inv);
            w.y = cvt_pk_bf16((O[c][0][4 * u4 + 2] + O[c][1][4 * u4 + 2]) * inv, (O[c][0][4 * u4 + 3] + O[c][1][4 * u4 + 3]) * inv);
            *(u32x2*)(orow + 32 * c + 8 * u4 + 4 * h) = w;
        }
}
__device__ __forceinline__ void attn_load_block(const bf16* Kb, const bf16* Vb, const bf16* Km, const bf16* Vm, int b, int kvh, int jb, int tid, u32x4 (&kv)[2], u32x4 (&vv)[2]) {
#pragma unroll
    for (int ii = 0; ii < 2; ++ii) {
        const int c = tid + 512 * ii, row = c >> 3, ch = c & 7;
        kv[ii] = (u32x4){0u, 0u, 0u, 0u}; vv[ii] = (u32x4){0u, 0u, 0u, 0u};
        if (jb >= 0) { const size_t off = (size_t)(b * SEQ + 128 * jb + row) * KVD + kvh * HD + ch * 8; kv[ii] = *(const u32x4*)(Kb + off); vv[ii] = *(const u32x4*)(Vb + off); }
        else if (row >= 112) { const size_t off = (size_t)(row - 112) * KVD + kvh * HD + ch * 8; kv[ii] = *(const u32x4*)(Km + off); vv[ii] = *(const u32x4*)(Vm + off); }
    }
}
__device__ __forceinline__ void attn_store_block(LAS unsigned char* kimg, LAS unsigned char* vimg, int slot, int tid, const u32x4 (&kv)[2], const u32x4 (&vv)[2]) {
#pragma unroll
    for (int ii = 0; ii < 2; ++ii) {
        const int c = tid + 512 * ii, row = slot * 128 + (c >> 3), ch = c & 7;
        *(LAS u32x4*)(kimg + row * KIMG_ROW + ch * 16) = kv[ii];
        LAS unsigned short* vt = (LAS unsigned short*)(vimg + (ch * 8) * VT_ROW + row * 2);
        vt[0 * (VT_ROW / 2)] = (unsigned short)(vv[ii].x & 0xffffu); vt[1 * (VT_ROW / 2)] = (unsigned short)(vv[ii].x >> 16);
        vt[2 * (VT_ROW / 2)] = (unsigned short)(vv[ii].y & 0xffffu); vt[3 * (VT_ROW / 2)] = (unsigned short)(vv[ii].y >> 16);
        vt[4 * (VT_ROW / 2)] = (unsigned short)(vv[ii].z & 0xffffu); vt[5 * (VT_ROW / 2)] = (unsigned short)(vv[ii].z >> 16);
        vt[6 * (VT_ROW / 2)] = (unsigned short)(vv[ii].w & 0xffffu); vt[7 * (VT_ROW / 2)] = (unsigned short)(vv[ii].w >> 16);
    }
}
__device__ __forceinline__ void attn_phase(const Args& a, LAS unsigned char* lds, int vcu, int G, int tid, int wave, int lane) {
    unsigned char* ws = a.ws;
    const bf16* Q = (const bf16*)(ws + WS_Q); const bf16* Kb = (const bf16*)(ws + WS_KB); const bf16* Vb = (const bf16*)(ws + WS_VB);
    const bf16* Km = (const bf16*)(ws + WS_MISC + MS_KM); const bf16* Vm = (const bf16*)(ws + WS_MISC + MS_VMETA);
    LAS unsigned char* kimg = lds; LAS unsigned char* vimg = lds + KIMG_BYTES;
    constexpr int NUNITS = BATCH * NKVH * (SEQ / 128);
    const int per = (NUNITS + G - 1) / G;
    const int g = wave >> 1, half = wave & 1, q = lane & 31, h = lane >> 5;
    bf16x8 qf[2][4];
    for (int i = 0; i < per; ++i) {
        const int uid = vcu * per + i; if (uid >= NUNITS) break;
        const int b = uid >> 8, kvh = (uid >> 6) & 3, j = uid & 63; const int Rb = b * SEQ + 128 * j;
        const int hq = kvh * 4 + g;
#pragma unroll
        for (int qg = 0; qg < 2; ++qg) {
#pragma unroll
            for (int s = 0; s < 4; ++s) if (!(qg == 0 && i != 0 && s < QPRE_N)) qf[qg][s] = *(const GAS bf16x8*)(Q + (size_t)(Rb + 64 * half + 32 * qg + q) * D + hq * HD + 16 * s + 8 * h); }
        const bf16* qn;
        { const int un = (i + 1 < per && uid + 1 < NUNITS) ? uid + 1 : uid; const int bn = un >> 8, kvhn = (un >> 6) & 3, jn = un & 63;
          qn = Q + (size_t)(bn * SEQ + 128 * jn + 64 * half + q) * D + (kvhn * 4 + g) * HD + 8 * h; }
        const bool fresh = (i == 0) || (j == 0);
        if (fresh) {
            __syncthreads();
            u32x4 kv[2], vv[2], kv2[2], vv2[2];
            attn_load_block(Kb, Vb, Km, Vm, b, kvh, j - 1, tid, kv, vv); attn_load_block(Kb, Vb, Km, Vm, b, kvh, j, tid, kv2, vv2);
            attn_store_block(kimg, vimg, (j + 2) % 3, tid, kv, vv);      attn_store_block(kimg, vimg, j % 3, tid, kv2, vv2);
        }
        __syncthreads();
        const bool pre = (i + 1 < per) && (uid + 1 < NUNITS) && (j + 1 < 64);
        u32x4 nk[2], nv[2];
        if (pre) attn_load_block(Kb, Vb, Km, Vm, b, kvh, j + 1, tid, nk, nv);
        const float sk = a.in[13][hq] * LOG2E;
        bf16* Og = (bf16*)(ws + WS_O) + (size_t)Rb * D + hq * HD;
        const int pbase = ((j + 2) % 3) * 128, cbase = (j % 3) * 128;
        if (j != 0) {
            if (half == 0) { attn_qgroup<0, false>(kimg, vimg, pbase, cbase, qf[0], qf[0], qn, Og, sk, lane); attn_qgroup<1, false>(kimg, vimg, pbase, cbase, qf[1], qf[0], qn, Og, sk, lane); }
            else           { attn_qgroup<2, false>(kimg, vimg, pbase, cbase, qf[0], qf[0], qn, Og, sk, lane); attn_qgroup<3, false>(kimg, vimg, pbase, cbase, qf[1], qf[0], qn, Og, sk, lane); }
        } else {
            if (half == 0) { attn_qgroup<0, true>(kimg, vimg, pbase, cbase, qf[0], qf[0], qn, Og, sk, lane); attn_qgroup<1, true>(kimg, vimg, pbase, cbase, qf[1], qf[0], qn, Og, sk, lane); }
            else           { attn_qgroup<2, true>(kimg, vimg, pbase, cbase, qf[0], qf[0], qn, Og, sk, lane); attn_qgroup<3, true>(kimg, vimg, pbase, cbase, qf[1], qf[0], qn, Og, sk, lane); }
        }
        if (pre) attn_store_block(kimg, vimg, (j + 1) % 3, tid, nk, nv);
    }
    __syncthreads();
}

__device__ __forceinline__ void route_phase(const Args& a, LAS unsigned char* lds, unsigned* ctl, int G, int tid, int wave, int lane) {
    unsigned char* ws = a.ws;
    LAS float* wr_l = (LAS float*)lds;
    LAS int* cntL = (LAS int*)(lds + 32768); LAS int* baseL = (LAS int*)(lds + 32768 + 64);
    const float* Wr = a.in[16]; const float* gm = a.in[15];
    for (int idx = tid; idx < NE * D; idx += NWAVES * 64) { const int e = idx >> 10, k = idx & (D - 1); wr_l[idx] = Wr[k * NE + e] * gm[k]; }
    const bf16* hsrc = (const bf16*)(ws + WS_HB);
    unsigned char* xq = ws + WS_XQ;
    int* list = (int*)(ws + WS_LIST); u32x2* tokep = (u32x2*)(ws + WS_TOKEP); f32x2* tokg = (f32x2*)(ws + WS_TOKG);
    for (int blk = blockIdx.x; blk < M / 128; blk += G) {
        __syncthreads();
        if (tid < 8) cntL[tid] = 0;
        __syncthreads();
        int my_e1 = -1, my_e2 = -1; float my_g1 = 0.f, my_g2 = 0.f;
        const int rbase = blk * 128 + wave * 16;
        constexpr int RB = 2;
        u32x2 nx[RB][4];
#pragma unroll
        for (int q = 0; q < RB; ++q)
#pragma unroll
            for (int j = 0; j < 4; ++j) nx[q][j] = *(const GAS u32x2*)(hsrc + (size_t)(rbase + q) * D + 4 * lane + 256 * j);
        for (int jj0 = 0; jj0 < 16; jj0 += RB) {
            f32x4 hv[RB][4]; float s[RB], d[RB][8];
#pragma unroll
            for (int q = 0; q < RB; ++q) { s[q] = 0.f;
#pragma unroll
                for (int j = 0; j < 4; ++j) { const u32x2 w = nx[q][j]; hv[q][j] = (f32x4){bflo(w.x), bfhi(w.x), bflo(w.y), bfhi(w.y)};
                    s[q] += (hv[q][j].x * hv[q][j].x + hv[q][j].y * hv[q][j].y) + (hv[q][j].z * hv[q][j].z + hv[q][j].w * hv[q][j].w); } }
            { const int jn = jj0 + RB < 16 ? jj0 + RB : jj0;
#pragma unroll
              for (int q = 0; q < RB; ++q)
#pragma unroll
                  for (int j = 0; j < 4; ++j) nx[q][j] = *(const GAS u32x2*)(hsrc + (size_t)(rbase + jn + q) * D + 4 * lane + 256 * j); }
#pragma unroll
            for (int e = 0; e < 8; ++e) {
#pragma unroll
                for (int q = 0; q < RB; ++q) d[q][e] = 0.f;
#pragma unroll
                for (int j = 0; j < 4; ++j) { const f32x4 w = *(const LAS f32x4*)(wr_l + e * D + 4 * lane + 256 * j);
#pragma unroll
                    for (int q = 0; q < RB; ++q) d[q][e] += (hv[q][j].x * w.x + hv[q][j].y * w.y) + (hv[q][j].z * w.z + hv[q][j].w * w.w); } }
#pragma unroll
            for (int o = 1; o < 64; o <<= 1) {
#pragma unroll
                for (int q = 0; q < RB; ++q) { s[q] += __shfl_xor(s[q], o);
#pragma unroll
                    for (int e = 0; e < 8; ++e) d[q][e] += __shfl_xor(d[q][e], o); } }
#pragma unroll
            for (int q = 0; q < RB; ++q) {
                const int jj = jj0 + q;
                const float rstd = 1.0f / sqrtf(s[q] * (1.0f / (float)D) + RMS_EPS);
                { const float sc = rstd * XQ_SCALE; unsigned char* xr = xq + (size_t)(rbase + jj) * D + 4 * lane;
#pragma unroll
                  for (int j = 0; j < 4; ++j) *(unsigned*)(xr + 256 * j) = pk4_fp8(hv[q][j].x * sc, hv[q][j].y * sc, hv[q][j].z * sc, hv[q][j].w * sc); }
                float lg[8];
#pragma unroll
                for (int e = 0; e < 8; ++e) lg[e] = d[q][e] * rstd;
                int e1 = 0; float v1 = lg[0];
#pragma unroll
                for (int e = 1; e < 8; ++e) if (lg[e] > v1) { v1 = lg[e]; e1 = e; }
                int e2 = -1; float v2 = -INFINITY;
#pragma unroll
                for (int e = 0; e < 8; ++e) if (e != e1 && lg[e] > v2) { v2 = lg[e]; e2 = e; }
                const float g1 = 1.0f / (1.0f + expf(v2 - v1));
                if (lane == jj) { my_e1 = e1; my_e2 = e2; my_g1 = g1; my_g2 = 1.0f - g1; }
            }
        }
        unsigned long long mk[8]; int wb = 0;
#pragma unroll
        for (int e = 0; e < 8; ++e) { mk[e] = __ballot(my_e1 == e || my_e2 == e); if (lane == e) wb = __popcll(mk[e]); }
        if (lane < 8) wb = atomicAdd((int*)(cntL + lane), wb);
        __syncthreads();
        if (tid < 8) baseL[tid] = (int)__hip_atomic_fetch_add(ctl + CW_CNT + 64 * tid, (unsigned)cntL[tid], RLX_AGENT);
        __syncthreads();
        {
            int pos1 = 0, pos2 = 0;
#pragma unroll
            for (int e = 0; e < 8; ++e) {
                const int wbe = __shfl(wb, e); const int p = baseL[e] + wbe + __popcll(mk[e] & ((1ull << lane) - 1ull));
                if (my_e1 == e) pos1 = p; if (my_e2 == e) pos2 = p;
            }
            if (lane < 16) {
                const int tok = rbase + lane;
                list[(size_t)my_e1 * M + pos1] = tok; list[(size_t)my_e2 * M + pos2] = tok;
                tokep[tok] = (u32x2){((unsigned)my_e1 << 28) | (unsigned)pos1, ((unsigned)my_e2 << 28) | (unsigned)pos2};
                tokg[tok] = (f32x2){my_g1, my_g2};
            }
        }
    }
    __syncthreads();
}

__device__ __forceinline__ void unpack8_fp8(const u32x2 w, float (&f)[8]) {
    const f32x2 a = __builtin_amdgcn_cvt_pk_f32_fp8((int)w.x, false), b = __builtin_amdgcn_cvt_pk_f32_fp8((int)w.x, true), c = __builtin_amdgcn_cvt_pk_f32_fp8((int)w.y, false), d = __builtin_amdgcn_cvt_pk_f32_fp8((int)w.y, true);
    f[0] = a.x; f[1] = a.y; f[2] = b.x; f[3] = b.y; f[4] = c.x; f[5] = c.y; f[6] = d.x; f[7] = d.y;
}
__device__ __forceinline__ void final_y_tail(const bf16* YP, size_t s, int k, float (&y)[8]) {
    const int T = (int)(s >> 8);
    const bf16* p = YP + ((size_t)((T - DOWN_MAIN_TILES) * 4 + (k >> 8)) * DOWN_KS) * 65536 + (size_t)(s & 255) * 256 + (k & 255);
#pragma unroll
    for (int e = 0; e < 8; ++e) y[e] = 0.f;
#pragma unroll
    for (int ks = 0; ks < DOWN_KS; ++ks) { float t[8]; unpack8(*(const u32x4*)(p + (size_t)ks * 65536), t);
#pragma unroll
        for (int e = 0; e < 8; ++e) y[e] += t[e]; }
}
__device__ __forceinline__ void final_phase(const Args& a, unsigned* ctl, int vcu, int G, int wave, int lane) {
    unsigned char* ws = a.ws;
    MoeInfo mi; moe_info_load(ctl, mi);
    const bf16* hb = (const bf16*)(ws + WS_HB); const unsigned char* Y = ws + WS_Y; const bf16* YP = (const bf16*)(ws + WS_YP);
    const u32x2* tokep = (const u32x2*)(ws + WS_TOKEP); const f32x2* tokg = (const f32x2*)(ws + WS_TOKG); const float* gf = a.in[20];
    const int gw = vcu * NWAVES + wave, NGW = G * NWAVES;
    float gfv[16];
#pragma unroll
    for (int j = 0; j < 2; ++j)
#pragma unroll
        for (int e = 0; e < 8; ++e) gfv[j * 8 + e] = gf[8 * lane + 512 * j + e];
    constexpr int RB = 4;
    u32x2 epn[RB]; f32x2 gn[RB];
#pragma unroll
    for (int q = 0; q < RB; ++q) { const int r = gw + q * NGW < M ? gw + q * NGW : gw; epn[q] = ((const GAS u32x2*)tokep)[r]; gn[q] = ((const GAS f32x2*)tokg)[r]; }
    for (int r0 = gw; r0 < M; r0 += RB * NGW) {
        u32x2 ep[RB]; f32x2 g[RB]; size_t s1[RB], s2[RB]; u32x4 wh[RB][2]; u32x2 w1[RB][2], w2[RB][2];
#pragma unroll
        for (int q = 0; q < RB; ++q) { ep[q] = epn[q]; g[q] = gn[q] * (1.0f / (HQ_SCALE * WD_SCALE)); }
#pragma unroll
        for (int q = 0; q < RB; ++q) {
            const int r = r0 + q * NGW < M ? r0 + q * NGW : r0;
            int ts1 = 0, ts2 = 0; const int e1 = (int)(ep[q].x >> 28), e2 = (int)(ep[q].y >> 28);
#pragma unroll
            for (int e = 0; e < 8; ++e) { if (e1 == e) ts1 = mi.ts[e]; if (e2 == e) ts2 = mi.ts[e]; }
            s1[q] = (size_t)ts1 * 256 + (ep[q].x & 0x0fffffffu); s2[q] = (size_t)ts2 * 256 + (ep[q].y & 0x0fffffffu);
#pragma unroll
            for (int j = 0; j < 2; ++j) { const int k = 8 * lane + 512 * j;
                wh[q][j] = *(const u32x4*)(hb + (size_t)r * D + k); w1[q][j] = *(const u32x2*)(Y + s1[q] * D + k); w2[q][j] = *(const u32x2*)(Y + s2[q] * D + k); }
        }
        { const int rn0 = r0 + RB * NGW;
#pragma unroll
          for (int q = 0; q < RB; ++q) { const int r = rn0 + q * NGW < M ? rn0 + q * NGW : gw; epn[q] = ((const GAS u32x2*)tokep)[r]; gn[q] = ((const GAS f32x2*)tokg)[r]; } }
#pragma unroll
        for (int q = 0; q < RB; ++q) {
            const int r = r0 + q * NGW; if (r >= M) break;
            const bool t1 = (s1[q] >> 8) >= (size_t)DOWN_MAIN_TILES, t2 = (s2[q] >> 8) >= (size_t)DOWN_MAIN_TILES;
            float v[16]; float s = 0.f;
#pragma unroll
            for (int j = 0; j < 2; ++j) {
                const int k = 8 * lane + 512 * j; float hf[8], y1[8], y2[8];
                unpack8(wh[q][j], hf); unpack8_fp8(w1[q][j], y1); unpack8_fp8(w2[q][j], y2);
                if (t1) final_y_tail(YP, s1[q], k, y1);
                if (t2) final_y_tail(YP, s2[q], k, y2);
#pragma unroll
                for (int e = 0; e < 8; ++e) { const float t = hf[e] + g[q].x * y1[e] + g[q].y * y2[e]; v[j * 8 + e] = t; s += t * t; }
            }
            s = wave_sum(s); const float rstd = 1.0f / sqrtf(s * (1.0f / (float)D) + RMS_EPS);
#pragma unroll
            for (int j = 0; j < 2; ++j) {
                float* o = a.out + (size_t)r * D + 8 * lane + 512 * j;
                *(f32x4*)o = (f32x4){v[j * 8 + 0] * rstd * gfv[j * 8 + 0], v[j * 8 + 1] * rstd * gfv[j * 8 + 1], v[j * 8 + 2] * rstd * gfv[j * 8 + 2], v[j * 8 + 3] * rstd * gfv[j * 8 + 3]};
                *(f32x4*)(o + 4) = (f32x4){v[j * 8 + 4] * rstd * gfv[j * 8 + 4], v[j * 8 + 5] * rstd * gfv[j * 8 + 5], v[j * 8 + 6] * rstd * gfv[j * 8 + 6], v[j * 8 + 7] * rstd * gfv[j * 8 + 7]};
            }
        }
    }
}

constexpr int N_PHASES = 13;
#ifndef REP_P0
#define REP_P0 1
#endif
#ifndef REP_P4
#define REP_P4 1
#endif
#ifndef REP_MOE
#define REP_MOE 1
#endif
#ifndef REP_EW
#define REP_EW 1
#endif
#ifndef REP_CONV
#define REP_CONV 1
#endif
#ifndef REP_QKV
#define REP_QKV 1
#endif
#ifndef REP_ATT
#define REP_ATT 1
#endif
__global__ void __launch_bounds__(NWAVES * 64, 2) fwd_kernel(Args args) {
    extern __shared__ __attribute__((aligned(16))) unsigned char lds_raw[];
    LAS unsigned char* lds = (LAS unsigned char*)lds_raw;
    volatile LAS unsigned* MISC = (volatile LAS unsigned*)(lds + MISC_OFF);
    const int wave = __builtin_amdgcn_readfirstlane((int)threadIdx.x >> 6);
#define lane hw_lane()
#define tid (wave * 64 + hw_lane())
    const int G = gridDim.x; const int bx = blockIdx.x; const int vcu = (G % 8 == 0) ? (bx % 8) * (G / 8) + bx / 8 : bx;
    unsigned char* ws = args.ws;
    unsigned* ctl = (unsigned*)(ws + WS_CTL);
    for (int u = (int)threadIdx.x; u < (LDS_BYTES - LDSCTL_OFF) / 4; u += NWAVES * 64) ((LAS unsigned*)(lds + LDSCTL_OFF))[u] = 0u;
    __syncthreads();
#if !MULTI_LAUNCH
    XcdBarrier bar = xcd_barrier_post(ctl + CW_BAR, MISC + 8, wave);
#define GRID_BAR() xcd_barrier(bar, wave)
#else
#define GRID_BAR() do { } while (0)
#endif
    const int lo = args.ph_lo, hi = args.ph_hi;
#define IN(k) (lo <= (k) && (k) < hi)
#define SEAM(k) do { if (IN(k) && IN((k) + 1)) GRID_BAR(); } while (0)
    unsigned char* misc = ws + WS_MISC;
    const float* ssq = (const float*)(ws + WS_SSQ);

    if (IN(0)) { for (int rep = 0; rep < REP_P0; ++rep) { p0_prologue(args, lds, vcu, G, wave, lane); SEAM(0); } }

    if (IN(1)) {
        typedef pg8::DenseSched<M / 256, NCONV / 256> DS; DS S{(const char*)(ws + WS_HB), (const char*)(ws + WS_WIN), 2 * D, G, bx};
        LAS float* rtab = (LAS float*)(lds + pg8::RSTD_TAB_OFF);
        auto pre = [&]() {
            if (bx < 96) {
                const float* ms0 = (const float*)(misc + MS_SSQ0); float* bm = (float*)(misc + MS_BM); float* vm = (float*)(misc + MS_VM);
                int n0, n1, vch = -1; if (bx < 32) { n0 = 32 * bx; n1 = n0 + 16; } else { const int j2 = bx - 32; n0 = D + 256 * (j2 >> 3) + 16 * (j2 & 7); n1 = n0 + 128; vch = 128 * (j2 >> 3) + 16 * (j2 & 7); }
                meta_dual(lds, (const bf16*)(misc + MS_MB), D, (const bf16*)(ws + WS_WIN), n0, n1, lane, wave, [&](const f32x4& a0, const f32x4& a1, int r16, int kq) {
    #pragma unroll
                    for (int g = 0; g < 4; ++g) { const int i = 4 * kq + g; const float r = 1.0f / sqrtf(ms0[i] * (1.0f / (float)D) + RMS_EPS);
                        if (vch < 0) { bm[i * D + n0 + r16] = a0[g] * r; bm[i * D + n1 + r16] = a1[g] * r; } else vm[i * D + vch + r16] = (a0[g] * r) * (a1[g] * r); } });
            }
            __syncthreads(); pg8::rstd_table_fill(S, ssq, rtab, tid); __syncthreads();
        };
        pg8::EpiConvIn E{(bf16*)(ws + WS_BC), (bf16*)(ws + WS_VC), rtab};
        ExpertCvtBg bg{args.in[17], args.in[18], args.in[19], args.in[15], ws, EXP_ITEMS - bg_cover(G), 0, BG_P1, bx * NWAVES + wave, G * NWAVES, {}, {}, {}, nullptr, 0u, 0, 0.f, false};
#if BG_CVT
        pg8::gemm_phase<pg8::EpiConvIn, DS, true>(lds, S, E, wave, pre, bg);
#else
        (void)bg; pg8::gemm_phase<pg8::EpiConvIn, DS, true>(lds, S, E, wave, pre);
#endif
        SEAM(1);
    }
    if (IN(2)) { for (int rep = 0; rep < REP_CONV; ++rep) { conv_phase(args, G, tid); SEAM(2); } }

    if (IN(3)) {
        typedef pg8::DenseSched<M / 256, D / 256> DS; DS S{(const char*)(ws + WS_YC), (const char*)(ws + WS_WOUT), 2 * D, G, bx};
        auto pre = [&]() {
            if (bx < 32) {
                const float* meta = args.in[1]; float* hm = (float*)(misc + MS_HM); bf16* hmb = (bf16*)(misc + MS_HMB); float* p1 = (float*)(misc + MS_SSQ1);
                const int n0 = 32 * bx, n1 = n0 + 16;
                meta_dual(lds, (const bf16*)(misc + MS_YCM), D, (const bf16*)(ws + WS_WOUT), n0, n1, lane, wave, [&](const f32x4& a0, const f32x4& a1, int r16, int kq) {
    #pragma unroll
                    for (int g = 0; g < 4; ++g) { const int i = 4 * kq + g; const float v0 = meta[i * D + n0 + r16] + a0[g], v1 = meta[i * D + n1 + r16] + a1[g];
                        hm[i * D + n0 + r16] = v0; hm[i * D + n1 + r16] = v1; hmb[i * D + n0 + r16] = (bf16)f2bf(v0); hmb[i * D + n1 + r16] = (bf16)f2bf(v1);
                        float q = v0 * v0 + v1 * v1; q += __shfl_xor(q, 1); q += __shfl_xor(q, 2); q += __shfl_xor(q, 4); q += __shfl_xor(q, 8);
                        if (r16 == 0) p1[bx * 16 + i] = q; } });
            }
        };
        pg8::EpiResidT<FFN8 != 0> E{(bf16*)(ws + WS_HB), (float*)(ws + WS_SSQ), 1.0f, ws + WS_XQ};
        pg8::gemm_phase<pg8::EpiResidT<FFN8 != 0>, DS, true>(lds, S, E, wave, pre);
        SEAM(3);
    }
    if (IN(4)) for (int rep = 0; rep < REP_P4; ++rep) {
#if FFN8
        typedef pg8::DenseSched<M / 256, NGU / 256, true> DS; DS S{(const char*)(ws + WS_XQ), (const char*)(ws + WS_WGU8), D, G, bx};
#else
        typedef pg8::DenseSched<M / 256, NGU / 256> DS; DS S{(const char*)(ws + WS_HB), (const char*)(ws + WS_WGU), 2 * D, G, bx};
#endif
        LAS float* rtab = (LAS float*)(lds + pg8::RSTD_TAB_OFF);
        auto pre = [&]() {
            if (bx < 224) {
                const f32x4 rs = meta_rstd_parts((const float*)(misc + MS_SSQ1), lane); bf16* hdm = (bf16*)(misc + MS_HDM);
                const int n0 = 256 * (bx >> 3) + 16 * (bx & 7), n1 = n0 + 128, hch = 128 * (bx >> 3) + 16 * (bx & 7);
                meta_dual(lds, (const bf16*)(misc + MS_HMB), D, (const bf16*)(ws + WS_WGU), n0, n1, lane, wave, [&](const f32x4& a0, const f32x4& a1, int r16, int kq) {
    #pragma unroll
                    for (int g = 0; g < 4; ++g) { const int i = 4 * kq + g; hdm[i * DFF + hch + r16] = (bf16)f2bf(pg8::silu_mul(a0[g] * rs[g], a1[g] * rs[g])); } });
            }
            __syncthreads(); pg8::rstd_table_fill(S, ssq, rtab, tid); __syncthreads();
        };
#if FFN8
        typedef pg8::EpiSwiGLU8T<FFN8 == 1> EPI4; EPI4 E{ws + WS_HD, rtab};
#else
        typedef pg8::EpiSwiGLU EPI4; EPI4 E{(bf16*)(ws + WS_HD), rtab};
#endif
        ExpertCvtBg bg{args.in[17], args.in[18], args.in[19], args.in[15], ws, EXP_ITEMS - bg_cover(G), BG_P1, BG_P4, bx * NWAVES + wave, G * NWAVES, {}, {}, {}, nullptr, 0u, 0, 0.f, false};
#if BG_CVT
        pg8::gemm_phase<EPI4, DS, true>(lds, S, E, wave, pre, bg);
#else
        (void)bg; pg8::gemm_phase<EPI4, DS, true>(lds, S, E, wave, pre);
#endif
        SEAM(4);
    }
    if (IN(5)) {
#if FFN8 == 1
        typedef pg8::DenseSched<M / 256, D / 256, true> DS; DS S{(const char*)(ws + WS_HD), (const char*)(ws + WS_WD8), DFF, G, bx};
#else
        typedef pg8::DenseSched<M / 256, D / 256> DS; DS S{(const char*)(ws + WS_HD), (const char*)(ws + WS_WD), 2 * DFF, G, bx};
#endif
        auto pre = [&]() {
            if (bx < 32) {
                float* hm = (float*)(misc + MS_HM); bf16* hmb = (bf16*)(misc + MS_HMB); float* p2 = (float*)(misc + MS_SSQ2);
                const int n0 = 32 * bx, n1 = n0 + 16;
                meta_dual(lds, (const bf16*)(misc + MS_HDM), DFF, (const bf16*)(ws + WS_WD), n0, n1, lane, wave, [&](const f32x4& a0, const f32x4& a1, int r16, int kq) {
    #pragma unroll
                    for (int g = 0; g < 4; ++g) { const int i = 4 * kq + g; const float v0 = hm[i * D + n0 + r16] + a0[g], v1 = hm[i * D + n1 + r16] + a1[g];
                        hm[i * D + n0 + r16] = v0; hm[i * D + n1 + r16] = v1; hmb[i * D + n0 + r16] = (bf16)f2bf(v0); hmb[i * D + n1 + r16] = (bf16)f2bf(v1);
                        float q = v0 * v0 + v1 * v1; q += __shfl_xor(q, 1); q += __shfl_xor(q, 2); q += __shfl_xor(q, 4); q += __shfl_xor(q, 8);
                        if (r16 == 0) p2[bx * 16 + i] = q; } });
            }
        };
        typedef pg8::EpiResidT<false, FFN8 == 1> EPI5; EPI5 E{(bf16*)(ws + WS_HB), (float*)(ws + WS_SSQ), FFN8 == 1 ? 1.0f / (HDQ_SCALE * WD8_SCALE) : 1.0f, nullptr};
        pg8::gemm_phase<EPI5, DS, true>(lds, S, E, wave, pre);
        SEAM(5);
    }
    if (IN(6)) {
        typedef pg8::DenseSched<M / 256, NQKV / 256> DS; DS S{(const char*)(ws + WS_HB), (const char*)(ws + WS_WQKV), 2 * D, G, bx};
        LAS float* rtab = (LAS float*)(lds + pg8::RSTD_TAB_OFF);
        auto pre = [&]() {
            if (bx < 16) {
                const f32x4 rs = meta_rstd_parts((const float*)(misc + MS_SSQ2), lane); const float* bias = args.in[12]; const f32x2* rope = (const f32x2*)(ws + WS_ROPE);
                bf16* km = (bf16*)(misc + MS_KM); bf16* vmt = (bf16*)(misc + MS_VMETA);
                int n0, n1; if (bx < 8) { n0 = D + 32 * (bx >> 1) + 16 * (bx & 1); n1 = n0 + 128; } else { n0 = D + KVD + 32 * (bx - 8); n1 = n0 + 16; }
                meta_dual(lds, (const bf16*)(misc + MS_HMB), D, (const bf16*)(ws + WS_WQKV), n0, n1, lane, wave, [&](const f32x4& a0, const f32x4& a1, int r16, int kq) {
    #pragma unroll
                    for (int g = 0; g < 4; ++g) { const int i = 4 * kq + g;
                        if (bx < 8) { const int wc = bx >> 1, dlo = 16 * (bx & 1) + r16; const float lo_ = a0[g] * rs[g] + bias[D + 64 * wc + dlo], hi_ = a1[g] * rs[g] + bias[D + 64 * wc + dlo + 32];
                            const f32x2 cs = rope[i * 32 + dlo]; km[i * KVD + 64 * wc + dlo] = (bf16)f2bf(lo_ * cs.x - hi_ * cs.y); km[i * KVD + 64 * wc + dlo + 32] = (bf16)f2bf(hi_ * cs.x + lo_ * cs.y); }
                        else { const int c0 = n0 - (D + KVD) + r16; vmt[i * KVD + c0] = (bf16)f2bf(a0[g] * rs[g] + bias[n0 + r16]); vmt[i * KVD + c0 + 16] = (bf16)f2bf(a1[g] * rs[g] + bias[n1 + r16]); } } });
            }
            __syncthreads(); pg8::rstd_table_fill(S, ssq, rtab, tid); __syncthreads();
        };
        pg8::EpiQKV E{(bf16*)(ws + WS_Q), (bf16*)(ws + WS_KB), (bf16*)(ws + WS_VB), rtab, args.in[12], (const f32x2*)(ws + WS_ROPE)};
        for (int rep = 0; rep < REP_QKV; ++rep) { pg8::gemm_phase<pg8::EpiQKV, DS, true>(lds, S, E, wave, pre);
        SEAM(6); }
    }
    if (IN(7)) { for (int rep = 0; rep < REP_ATT; ++rep) { attn_phase(args, lds, vcu, G, tid, wave, lane); SEAM(7); } }

    if (IN(8)) {
        typedef pg8::DenseSched<M / 256, D / 256> DS; DS S{(const char*)(ws + WS_O), (const char*)(ws + WS_WO), 2 * D, G, bx};
        pg8::EpiResid E{(bf16*)(ws + WS_HB), (float*)(ws + WS_SSQ), 1.0f, nullptr};
        pg8::gemm_phase<pg8::EpiResid, DS, true>(lds, S, E, wave);
        SEAM(8);
    }
    if (IN(9)) { route_phase(args, lds, ctl, G, tid, wave, lane); SEAM(9); }

    for (int rep = 0; rep < REP_MOE; ++rep) {
        if (IN(10)) {
            LAS int* ml = (LAS int*)(lds + MISC_OFF + 64); moe_info_to_lds(ctl, ml, wave);
            const int ntile = __builtin_amdgcn_readfirstlane(ml[8]);
            pg8::MoeUpSched S{(const char*)(ws + WS_XQ), (const char*)(ws + WS_EWGU), (const int*)(ws + WS_LIST), ml, D, ntile, G, bx, 0};
            pg8::EpiMoeUp E{(unsigned char*)args.out, ws, 0};
            pg8::gemm_phase<pg8::EpiMoeUp, pg8::MoeUpSched, true>(lds, S, E, wave);
            SEAM(10);
        }
        if (IN(11)) {
            LAS int* ml = (LAS int*)(lds + MISC_OFF + 64); moe_info_to_lds(ctl, ml, wave);
            const int ntile = __builtin_amdgcn_readfirstlane(ml[8]);
            const int nmain = ntile < DOWN_MAIN_TILES ? ntile : DOWN_MAIN_TILES;
            pg8::MoeDownSched S{(unsigned char*)args.out, ws, (const char*)(ws + WS_EWD), ml, DFF, nmain, G, bx, 0};
            pg8::EpiMoeDown E{ws + WS_Y};
            pg8::gemm_phase<pg8::EpiMoeDown, pg8::MoeDownSched, true>(lds, S, E, wave);
            pg8::MoeDownTailSched S2{(unsigned char*)args.out, ws, (const char*)(ws + WS_EWD), ml, DFF, (ntile - nmain) * 4 * DOWN_KS, G, bx};
            pg8::EpiMoeDownPart E2{(bf16*)(ws + WS_YP)};
            pg8::gemm_phase<pg8::EpiMoeDownPart, pg8::MoeDownTailSched, true>(lds, S2, E2, wave);
            SEAM(11);
        }
    }
    if (IN(12)) { for (int rep = 0; rep < REP_EW; ++rep) { if (rep) GRID_BAR(); final_phase(args, ctl, vcu, G, wave, lane); } }
#undef IN
#undef SEAM
#undef lane
#undef tid
}

extern "C" void kernel_launch(void* const* d_in, const int* in_sizes, int n_in, void* d_out, int out_size, void* d_ws, size_t ws_size, hipStream_t stream) {
    static int grid = 0;
    if (grid == 0) {
        if (n_in != 21 || in_sizes[0] != M * D || out_size != M * D || ws_size < WS_END2) { fprintf(stderr, "kernel_launch: unexpected shapes (n_in %d, in0 %d, out %d, ws %zu); nothing launched\n", n_in, n_in > 0 ? in_sizes[0] : -1, out_size, ws_size); grid = -1; return; }
        int dev = 0, cus = 0, per_cu = 0;
        if (hipGetDevice(&dev) != hipSuccess || hipDeviceGetAttribute(&cus, hipDeviceAttributeMultiprocessorCount, dev) != hipSuccess) { grid = -1; return; }
        if (hipFuncSetAttribute((const void*)fwd_kernel, hipFuncAttributeMaxDynamicSharedMemorySize, LDS_BYTES) != hipSuccess) { fprintf(stderr, "kernel_launch: hipFuncSetAttribute failed\n"); grid = -1; return; }
        if (hipOccupancyMaxActiveBlocksPerMultiprocessor(&per_cu, (const void*)fwd_kernel, NWAVES * 64, LDS_BYTES) != hipSuccess || per_cu < 1) fprintf(stderr, "kernel_launch: occupancy query reports %d\n", per_cu);
        (void)hipGetLastError();
        grid = cus;
    }
    if (grid < 0) return;
    if (hipMemsetAsync((char*)d_ws + WS_CTL, 0, CTL_ZERO_BYTES, stream) != hipSuccess) return;
    Args a{};
    for (int i = 0; i < 21; ++i) a.in[i] = (const float*)d_in[i];
    a.out = (float*)d_out; a.ws = (unsigned char*)d_ws;
    for (int f = 0; f < 32; ++f) a.inv[f] = (float)std::pow(10000.0, -(double)f / 32.0);
#if MULTI_LAUNCH
    for (int p = 0; p < N_PHASES; ++p) { a.ph_lo = p; a.ph_hi = p + 1; hipLaunchKernelGGL(fwd_kernel, dim3(grid), dim3(NWAVES * 64), LDS_BYTES, stream, a); }
#else
    a.ph_lo = 0; a.ph_hi = N_PHASES;
    hipLaunchKernelGGL(fwd_kernel, dim3(grid), dim3(NWAVES * 64), LDS_BYTES, stream, a);
#endif
}
```

```cpp
#define CV_NT 0
#define ORDER_B 0
#include <hip/hip_runtime.h>
#include <cstdio>
#include <cstdint>
#include <cmath>

#ifndef NAIVE_GEMM
#define NAIVE_GEMM 0
#endif
#ifndef PROBE_KL
#define PROBE_KL 1
#endif
#ifndef PROBE_DEPI
#define PROBE_DEPI 1
#endif
#ifndef PROBE_EPI
#define PROBE_EPI 1
#endif
#ifndef MULTI_LAUNCH
#define MULTI_LAUNCH 0
#endif

#define GAS __attribute__((address_space(1)))
#define LAS __attribute__((address_space(3)))
typedef unsigned short bf16;
typedef short bf16x8 __attribute__((ext_vector_type(8)));
typedef float f32x4 __attribute__((ext_vector_type(4)));
typedef float f32x2 __attribute__((ext_vector_type(2)));
typedef float f32x16 __attribute__((ext_vector_type(16)));
typedef unsigned u32x4 __attribute__((ext_vector_type(4)));
typedef unsigned u32x2 __attribute__((ext_vector_type(2)));
typedef int i32x8 __attribute__((ext_vector_type(8)));
typedef int i32x4 __attribute__((ext_vector_type(4)));

constexpr int D = 1024, BATCH = 4, SEQ = 8192, NMETA = 16, M = BATCH * SEQ;
constexpr int NCONV = 3 * D, DFF = 3584, NGU = 2 * DFF, NQKV = 1536, NE = 8;
constexpr int NQH = 16, NKVH = 4, HD = 64, KVD = NKVH * HD;
constexpr int LPOS = SEQ + NMETA;
constexpr float RMS_EPS = 1e-5f;
constexpr float LOG2E = 1.4426950408889634f;
constexpr float QSCALE = 0.125f * LOG2E;
constexpr int RING_BYTES_ = 131072;

__device__ __forceinline__ unsigned cvt_pk_bf16(float lo, float hi) { unsigned r; asm volatile("v_cvt_pk_bf16_f32 %0, %1, %2" : "=v"(r) : "v"(lo), "v"(hi)); return r; }
__device__ __forceinline__ float bf2f(unsigned short b) { return __uint_as_float(((unsigned)b) << 16); }
__device__ __forceinline__ float bflo(unsigned w) { return __uint_as_float(w << 16); }
__device__ __forceinline__ float bfhi(unsigned w) { return __uint_as_float(w & 0xffff0000u); }
__device__ __forceinline__ int hw_lane() { int l; asm volatile("v_mbcnt_lo_u32_b32 %0, -1, 0\n\tv_mbcnt_hi_u32_b32 %0, -1, %0" : "=v"(l)); return l; }
__device__ __forceinline__ float wave_sum(float v) {
#pragma unroll
    for (int o = 1; o < 64; o <<= 1) v += __shfl_xor(v, o);
    return v;
}

namespace pg8 {
constexpr int BM = 256, BK = 64, HALF = 128, HTB = HALF * BK * 2, STAGE_BYTES = 8 * HTB, NXCD = 8, WGM = 8;
__host__ __device__ __forceinline__ int lds_byte(int r, int c) { const int st = (r >> 4) * 2 + (c >> 5), rr = r & 15, cc = c & 31, ob = rr * 64 + cc * 2; return st * 1024 + (ob ^ (((ob >> 9) & 1) << 5)); }
__host__ __device__ __forceinline__ void stage_rc(int b, int& R, int& C) { const int st = b / 1024, sb = b % 1024, swz = sb ^ (((sb >> 9) & 1) << 5); R = (st >> 1) * 16 + swz / 64; C = (st & 1) * 32 + (swz % 64) / 2; }
__host__ __device__ __forceinline__ int perm32(int rho) { const int n = rho >> 4, i = rho & 15; return 8 * (i >> 2) + 4 * n + (i & 3); }

struct Unit { int pm, pn, e, lt; int ord = 0; };

__device__ __forceinline__ void order_unit(int L, int nM, int nN, int& pm, int& pn) {
    const int nwg = nM * nN; int wgid = L;
    { const int q = nwg / NXCD, r = nwg % NXCD, xcd = wgid % NXCD, off = wgid / NXCD; wgid = (xcd < r ? xcd * (q + 1) : r * (q + 1) + (xcd - r) * q) + off; }
    const int nig = WGM * nN, gid = wgid / nig, fm = gid * WGM, gsz = (nM - fm) < WGM ? (nM - fm) : WGM;
    pm = fm + ((wgid % nig) % gsz); pn = (wgid % nig) / gsz;
}

__device__ __forceinline__ const char* uptr(const char* p) { const unsigned long long v = (unsigned long long)p; const unsigned lo = __builtin_amdgcn_readfirstlane((unsigned)v), hi = __builtin_amdgcn_readfirstlane((unsigned)(v >> 32)); return (const char*)(((unsigned long long)hi << 32) | lo); }
__device__ __forceinline__ const char* sopaque(const char* p) { unsigned long long v = (unsigned long long)p; asm volatile("" : "+s"(v)); return (const char*)v; }
__device__ __forceinline__ void order_unit_b(int L, int nM, int nN, int& pm, int& pn) {
    const int nwg = nM * nN; int wgid = L;
    { const int q = nwg / NXCD, r = nwg % NXCD, xcd = wgid % NXCD, off = wgid / NXCD; wgid = (xcd < r ? xcd * (q + 1) : r * (q + 1) + (xcd - r) * q) + off; }
    const int gN = (nN % 4 == 0) ? 4 : ((nN % 3 == 0) ? 3 : nN);
    const int per_g = nM * gN, g = wgid / per_g, w = wgid % per_g;
    const int blk = WGM * gN, pmb = w / blk, wi = w % blk, fm = pmb * WGM, gsz = (nM - fm) < WGM ? (nM - fm) : WGM;
    pm = fm + wi % gsz; pn = g * gN + wi / gsz;
}
#ifndef FFN8
#define FFN8 1
#endif
#ifndef HD_NT
#define HD_NT 0
#endif
#ifndef YC_NT
#define YC_NT 1
#endif
#ifndef HM_PLAIN_FROM
#define HM_PLAIN_FROM 1000
#endif
#ifndef CV_NT
#define CV_NT 1
#endif
#ifndef BG_DEFER
#define BG_DEFER 0
#endif
#ifndef BG_CVT
#define BG_CVT 0
#endif
#ifndef BAL_LDS
#define BAL_LDS 0
#endif
#ifndef QKV_PIPE
#define QKV_PIPE 1
#endif
#ifndef CONV_BATCH
#define CONV_BATCH 1
#endif
#ifndef ORDER_B
#define ORDER_B 1
#endif
template <int NM, int NN, bool F8 = false>
struct DenseSched {
    static constexpr bool GATHER = false, FP8 = F8; static constexpr int REPK = 1, REPE = 1;
    const char* A; const char* Bt; int KB  , G, c;
    __device__ __forceinline__ bool next(int i, Unit& u) const { const int L = i * G + c; if (L >= NM * NN) return false; if (ORDER_B) order_unit_b(L, NM, NN, u.pm, u.pn); else order_unit(L, NM, NN, u.pm, u.pn); u.e = 0; u.lt = i; return true; }
    __device__ __forceinline__ const char* aptr(const Unit& u) const { return A + (size_t)u.pm * BM * KB; }
    __device__ __forceinline__ const char* bptr(const Unit& u) const { return Bt + (size_t)u.pn * BM * KB; }
    __device__ __forceinline__ unsigned arow(const Unit&, int r) const { return (unsigned)r * (unsigned)KB; }
    __device__ __forceinline__ int ktiles() const { return KB / (BK * 2); }
};

#define PG8_SA(b, h) (((b) * 2 + (h)) * HTB)
#define PG8_SB(b, h) ((4 + (b) * 2 + (h)) * HTB)
template <int OFF> __device__ __forceinline__ void glds16_s(const char* sbase, unsigned voff, unsigned lbase) { unsigned keep;
    asm volatile("s_mov_b32 %0, m0\n\ts_add_u32 m0, %3, %4\n\ts_nop 0\n\tglobal_load_lds_dwordx4 %1, %2\n\ts_mov_b32 m0, %0" : "=&s"(keep) : "v"(voff), "s"(sbase), "s"(lbase), "i"(OFF) : "memory", "scc"); }
#define PG8_STAGE(bufoff, gbase, voff) do { const char* _gb = (const char*)(gbase); glds16_s<(bufoff)>(_gb, (voff)[0], ldsb); glds16_s<(bufoff) + 8192>(_gb, (voff)[1], ldsb); } while (0)
#define PG8_STAGE_A1(bufoff, gbase) do { if constexpr (Sched::GATHER) PG8_STAGE(bufoff, gbase, aof1); else PG8_STAGE(bufoff, (const char*)(gbase) + hstepA, aof0); } while (0)
#define PG8_LDA(dst, b, h) do { _Pragma("unroll") for (int m = 0; m < 4; ++m) _Pragma("unroll") for (int k = 0; k < 2; ++k) dst[m][k] = *(const LAS bf16x8*)(lds + PG8_SA(b, h) + aoff + m * 2048 + k * 1024); } while (0)
#define PG8_LDB(dst, b, h) do { _Pragma("unroll") for (int n = 0; n < 2; ++n) _Pragma("unroll") for (int k = 0; k < 2; ++k) dst[n][k] = *(const LAS bf16x8*)(lds + PG8_SB(b, h) + boff + n * 2048 + k * 1024); } while (0)
#define PG8_MMA(ai, bj, At, Bt) do { __builtin_amdgcn_s_setprio(1); _Pragma("unroll") for (int m = 0; m < 4; ++m) _Pragma("unroll") for (int n = 0; n < 2; ++n) _Pragma("unroll") for (int k = 0; k < 2; ++k) \
        acc[ai][bj][m][n] = __builtin_amdgcn_mfma_f32_16x16x32_bf16(Bt[n][k], At[m][k], acc[ai][bj][m][n], 0, 0, 0); __builtin_amdgcn_s_setprio(0); } while (0)
#define PG8_CAT(x) __builtin_shufflevector(__builtin_bit_cast(i32x4, x[0]), __builtin_bit_cast(i32x4, x[1]), 0, 1, 2, 3, 4, 5, 6, 7)
#define PG8_MMA8(ai, bj, At, Bt) do { __builtin_amdgcn_s_setprio(1); _Pragma("unroll") for (int m = 0; m < 4; ++m) _Pragma("unroll") for (int n = 0; n < 2; ++n) \
        acc[ai][bj][m][n] = __builtin_amdgcn_mfma_scale_f32_16x16x128_f8f6f4(PG8_CAT(Bt[n]), PG8_CAT(At[m]), acc[ai][bj][m][n], 0, 0, 0, 0, 0, 0); __builtin_amdgcn_s_setprio(0); } while (0)
#define PG8_MM(ai, bj, At, Bt) do { if constexpr (Sched::FP8) PG8_MMA8(ai, bj, At, Bt); else PG8_MMA(ai, bj, At, Bt); } while (0)
#define PG8_WAIT_V(n) asm volatile("s_waitcnt vmcnt(" #n ")" ::: "memory")
#define PG8_WAIT_L(n) asm volatile("s_waitcnt lgkmcnt(" #n ")" ::: "memory")
#define PG8_BAR __builtin_amdgcn_s_barrier()
#define PG8_SCHED __builtin_amdgcn_sched_barrier(0)

#if !NAIVE_GEMM
struct NoPre { __device__ __forceinline__ void operator()() const {} };
struct NoBg { __device__ __forceinline__ void issue(int) {} __device__ __forceinline__ void finish() {} };
template <class Epi, class Sched, bool ALIGN_EPI, class Pre = NoPre, class Bg = NoBg>
__device__ __forceinline__ void gemm_phase(LAS unsigned char* lds, const Sched& S, const Epi& E, const int wid, const Pre& pre = Pre(), Bg bg = Bg()) {
    const int lane = hw_lane(), tid = wid * 64 + lane, wr = wid >> 2, wc = wid & 3, fr = lane & 15, fq = lane >> 4;
    const int KB = S.KB, nt = S.ktiles();
    int R_[2], C_[2]; unsigned voffB[2]; unsigned aof0[2], aof1[2];
#pragma unroll
    for (int i = 0; i < 2; ++i) { int R, C; stage_rc(tid * 16 + i * 8192, R, C); R_[i] = R; C_[i] = C; const int Rb = Epi::PERM ? ((R & ~31) + perm32(R & 31)) : R;
        voffB[i] = (unsigned)(Rb * KB + C * 2); }
    const size_t kstep = (size_t)(BK * 2);
    const size_t hstep = (size_t)HALF * KB;
    const size_t hstepA = (size_t)S.arow(Unit{0, 0, 0, 0}, HALF);
    const unsigned ldsb = (unsigned)(size_t)lds + (unsigned)wid * 1024u;
    const int aoff = lds_byte(wr * 64 + fr, fq * 8), boff = lds_byte(wc * 32 + fr, fq * 8);
    Unit cur, nxt; int ui = 0;
    if (!S.next(0, cur)) { pre(); return; }
    f32x4 acc[2][2][4][2];
#pragma unroll
    for (int a = 0; a < 2; ++a)
#pragma unroll
        for (int b = 0; b < 2; ++b)
#pragma unroll
            for (int m = 0; m < 4; ++m)
#pragma unroll
                for (int n = 0; n < 2; ++n) acc[a][b][m][n] = (f32x4){0.f, 0.f, 0.f, 0.f};
    bf16x8 At[4][2], B0[2][2], B1[2][2];
    const char* cA = uptr(S.aptr(cur)); const char* cB = uptr(S.bptr(cur));
#pragma unroll
    for (int i = 0; i < 2; ++i) { aof0[i] = S.arow(cur, R_[i]) + (unsigned)C_[i] * 2u; aof1[i] = Sched::GATHER ? S.arow(cur, HALF + R_[i]) + (unsigned)C_[i] * 2u : 0u; }
#if BAL_LDS == 1
    PG8_STAGE(PG8_SB(0, 0), cB, voffB); PG8_STAGE(PG8_SB(0, 1), cB + hstep, voffB); PG8_STAGE(PG8_SA(0, 0), cA, aof0); PG8_STAGE_A1(PG8_SA(0, 1), cA);
    PG8_STAGE(PG8_SB(1, 0), cB + kstep, voffB); PG8_STAGE(PG8_SA(1, 0), cA + kstep, aof0);
    pre();
    PG8_WAIT_V(4);
    if (wr == 1) PG8_BAR;
    PG8_BAR;
#else
    PG8_STAGE(PG8_SB(0, 0), cB, voffB); PG8_STAGE(PG8_SB(0, 1), cB + hstep, voffB); PG8_STAGE(PG8_SA(0, 0), cA, aof0); PG8_STAGE_A1(PG8_SA(0, 1), cA);
    pre();
    if (wr == 1) PG8_BAR;
    PG8_WAIT_V(2); PG8_BAR;
    PG8_STAGE(PG8_SB(1, 0), cB + kstep, voffB); PG8_STAGE(PG8_SA(1, 0), cA + kstep, aof0); PG8_STAGE(PG8_SB(1, 1), cB + hstep + kstep, voffB);
    PG8_WAIT_V(6); PG8_BAR;
#endif
    for (;;) {
        const bool has_next = S.next((ui + 1) / Sched::REPK, nxt);
        const char* nA = uptr(has_next ? S.aptr(nxt) : cA); const char* nB = uptr(has_next ? S.bptr(nxt) : cB);
        int ntok0[2], ntok1[2];
        if constexpr (Sched::GATHER) {
#pragma unroll
            for (int i = 0; i < 2; ++i) { int R, C; stage_rc((wid * 64 + hw_lane()) * 16 + i * 8192, R, C); ntok0[i] = S.arow_raw(has_next ? nxt : cur, R); ntok1[i] = S.arow_raw(has_next ? nxt : cur, HALF + R); }
        }
#if BAL_LDS
        PG8_SCHED; PG8_LDB(B0, 0, 0);
#endif
        for (int t = 0; t < nt; t += 2) {
            const bool last = (t == nt - 2);
            const char* a1 = cA + (size_t)(t + 1) * kstep;
            const char* a2 = last ? nA : cA + (size_t)(t + 2) * kstep; const char* b2 = last ? nB : cB + (size_t)(t + 2) * kstep;
            const char* a3 = a2 + kstep; const char* b3 = b2 + kstep;
#if BAL_LDS == 1
            const char* b1 = cB + (size_t)(t + 1) * kstep;
            PG8_LDA(At, 0, 0); PG8_STAGE_A1(PG8_SA(1, 1), a1); PG8_STAGE(PG8_SB(1, 1), b1 + hstep, voffB);
            PG8_WAIT_V(8); PG8_WAIT_L(0); PG8_BAR;
            PG8_LDB(B1, 0, 1); PG8_SCHED; PG8_MM(0, 0, At, B0); PG8_MM(0, 1, At, B1); PG8_BAR; PG8_SCHED;
            if constexpr (Sched::GATHER) { if (last) {
#pragma unroll
                for (int i = 0; i < 2; ++i) { int R, C; stage_rc((wid * 64 + hw_lane()) * 16 + i * 8192, R, C); aof0[i] = S.arow_fin(ntok0[i]) + (unsigned)C * 2u; aof1[i] = S.arow_fin(ntok1[i]) + (unsigned)C * 2u; } } }
            PG8_LDA(At, 0, 1); PG8_STAGE(PG8_SB(0, 0), b2, voffB); PG8_STAGE(PG8_SA(0, 0), a2, aof0);
            PG8_WAIT_V(8); PG8_WAIT_L(0); PG8_BAR;
            PG8_MM(1, 0, At, B0); PG8_SCHED; PG8_LDB(B0, 1, 0); PG8_SCHED; PG8_MM(1, 1, At, B1); PG8_BAR; PG8_SCHED;
            PG8_LDA(At, 1, 0); PG8_STAGE_A1(PG8_SA(0, 1), a2); PG8_STAGE(PG8_SB(0, 1), b2 + hstep, voffB);
            PG8_WAIT_V(8); PG8_WAIT_L(0); PG8_BAR;
            PG8_LDB(B1, 1, 1); PG8_SCHED; PG8_MM(0, 0, At, B0); PG8_MM(0, 1, At, B1); PG8_BAR; PG8_SCHED;
            PG8_LDA(At, 1, 1); PG8_STAGE(PG8_SB(1, 0), b3, voffB); PG8_STAGE(PG8_SA(1, 0), a3, aof0);
            PG8_WAIT_V(8); PG8_WAIT_L(0); PG8_BAR;
            PG8_MM(1, 0, At, B0); PG8_SCHED; if (!last) PG8_LDB(B0, 0, 0); PG8_SCHED; PG8_MM(1, 1, At, B1); PG8_BAR; PG8_SCHED;
#else
            if (BAL_LDS != 2) PG8_LDB(B0, 0, 0); PG8_LDB(B1, 0, 1); PG8_SCHED; PG8_LDA(At, 0, 0); PG8_STAGE_A1(PG8_SA(1, 1), a1);
            PG8_WAIT_V(8); PG8_WAIT_L(0); PG8_BAR; PG8_MM(0, 0, At, B0); PG8_MM(0, 1, At, B1); PG8_BAR; PG8_SCHED;
            if constexpr (Sched::GATHER) { if (last) {
#pragma unroll
                for (int i = 0; i < 2; ++i) { int R, C; stage_rc((wid * 64 + hw_lane()) * 16 + i * 8192, R, C); aof0[i] = S.arow_fin(ntok0[i]) + (unsigned)C * 2u; aof1[i] = S.arow_fin(ntok1[i]) + (unsigned)C * 2u; } } }
            PG8_LDA(At, 0, 1); PG8_STAGE(PG8_SB(0, 0), b2, voffB); PG8_STAGE(PG8_SB(0, 1), b2 + hstep, voffB); PG8_STAGE(PG8_SA(0, 0), a2, aof0);
            PG8_WAIT_V(8); PG8_WAIT_L(0); PG8_BAR; PG8_MM(1, 0, At, B0); if (BAL_LDS == 2) { PG8_SCHED; PG8_LDB(B0, 1, 0); PG8_SCHED; } PG8_MM(1, 1, At, B1); PG8_BAR; PG8_SCHED;
            if (BAL_LDS != 2) PG8_LDB(B0, 1, 0); PG8_LDB(B1, 1, 1); PG8_SCHED; PG8_LDA(At, 1, 0); PG8_STAGE_A1(PG8_SA(0, 1), a2);
            PG8_WAIT_V(8); PG8_WAIT_L(0); PG8_BAR; PG8_MM(0, 0, At, B0); PG8_MM(0, 1, At, B1); PG8_BAR; PG8_SCHED;
            PG8_LDA(At, 1, 1); PG8_STAGE(PG8_SB(1, 0), b3, voffB); PG8_STAGE(PG8_SB(1, 1), b3 + hstep, voffB); PG8_STAGE(PG8_SA(1, 0), a3, aof0);
            PG8_WAIT_V(8); PG8_WAIT_L(0); PG8_BAR; PG8_MM(1, 0, At, B0); if (BAL_LDS == 2) { PG8_SCHED; if (!last) PG8_LDB(B0, 0, 0); PG8_SCHED; } PG8_MM(1, 1, At, B1); PG8_BAR; PG8_SCHED;
#endif
        }
        if constexpr (ALIGN_EPI) { if (wr == 0) PG8_BAR; }
#if BG_DEFER
        PG8_SCHED; bg.finish(); bg.issue(ui); PG8_SCHED;
#else
        bg.issue(ui);
#endif
        if (Sched::REPK == 1 || (ui % Sched::REPK) == Sched::REPK - 1) { for (int re = 0; re < Sched::REPE * Epi::REPE; ++re) E(acc, cur, wr, wc, fr, fq); }
#if !BG_DEFER
        PG8_SCHED; bg.finish(); PG8_SCHED;
#endif
        if (!has_next) break;
#pragma unroll
        for (int a = 0; a < 2; ++a)
#pragma unroll
            for (int b = 0; b < 2; ++b)
#pragma unroll
                for (int m = 0; m < 4; ++m)
#pragma unroll
                    for (int n = 0; n < 2; ++n) acc[a][b][m][n] = (f32x4){0.f, 0.f, 0.f, 0.f};
        cur = nxt; cA = nA; cB = nB; ++ui;
        if constexpr (!Sched::GATHER) {   }
        if constexpr (ALIGN_EPI) { if (wr == 1) PG8_BAR; }
    }
#if BG_DEFER
    bg.finish();
#endif
    PG8_WAIT_V(0);
    if constexpr (!ALIGN_EPI) { if (wr == 0) PG8_BAR; }
    PG8_BAR;
}
#else
struct NoPre { __device__ __forceinline__ void operator()() const {} };
struct NoBg { __device__ __forceinline__ void issue(int) {} __device__ __forceinline__ void finish() {} };
template <class Epi, class Sched, bool ALIGN_EPI, class Pre = NoPre, class Bg = NoBg>
__device__ __forceinline__ void gemm_phase(LAS unsigned char* lds, const Sched& S, const Epi& E, const int wid, const Pre& pre = Pre(), Bg bg = Bg()) {
    const int lane = hw_lane(), tid = wid * 64 + lane, wr = wid >> 2, wc = wid & 3, fr = lane & 15, fq = lane >> 4;
    const int K = S.KB / 2; static_assert(!Sched::FP8, "naive body is bf16 only");
    Unit cur;
    for (int ui = 0; S.next(ui, cur); ++ui) {
        f32x4 acc[2][2][4][2];
        const char* cA = S.aptr(cur); const char* cB = S.bptr(cur);
#pragma unroll
        for (int ai = 0; ai < 2; ++ai)
#pragma unroll
            for (int m = 0; m < 4; ++m) {
                const char* arow = cA + S.arow(cur, ai * HALF + wr * 64 + m * 16 + fr);
#pragma unroll
                for (int bj = 0; bj < 2; ++bj)
#pragma unroll
                    for (int n = 0; n < 2; ++n) {
                        float s[4] = {0.f, 0.f, 0.f, 0.f};
                        const int c0 = bj * HALF + wc * 32 + (Epi::PERM ? (8 * fq + 4 * n) : (16 * n + 4 * fq));
                        for (int k = 0; k < K; k += 8) {
                            const u32x4 av = *(const u32x4*)(arow + (size_t)k * 2);
#pragma unroll
                            for (int i = 0; i < 4; ++i) {
                                const u32x4 bv = *(const u32x4*)(cB + ((size_t)(c0 + i) * K + k) * 2);
                                s[i] += bflo(av.x) * bflo(bv.x) + bfhi(av.x) * bfhi(bv.x) + bflo(av.y) * bflo(bv.y) + bfhi(av.y) * bfhi(bv.y)
                                      + bflo(av.z) * bflo(bv.z) + bfhi(av.z) * bfhi(bv.z) + bflo(av.w) * bflo(bv.w) + bfhi(av.w) * bfhi(bv.w);
                            }
                        }
                        acc[ai][bj][m][n] = (f32x4){s[0], s[1], s[2], s[3]};
                    }
            }
        bg.issue(ui); E(acc, cur, wr, wc, fr, fq); bg.finish();
    }
    (void)lds;
}
#endif
}

constexpr size_t MiB = 1u << 20;
constexpr size_t WS_CTL = 0, CTL_ZERO_BYTES = 1 * MiB;
constexpr size_t WS_MISC = 1 * MiB;
constexpr size_t WS_ROPE = 2 * MiB;
constexpr size_t WS_SSQ = 5 * MiB;
constexpr size_t WS_TOKEP = 7 * MiB;
constexpr size_t WS_TOKG = 7 * MiB + 512 * 1024;
constexpr size_t WS_LRSTD = 8 * MiB;
constexpr size_t WS_LIST = 9 * MiB;
constexpr size_t WS_WIN = 10 * MiB, WS_WOUT = 16 * MiB, WS_WGU = 18 * MiB, WS_WD = 32 * MiB, WS_WQKV = 39 * MiB, WS_WO = 42 * MiB;
constexpr size_t WS_EWGU = 44 * MiB, WS_EWD = 100 * MiB;
constexpr size_t WS_XQ = 128 * MiB;
constexpr size_t WS_HB = 160 * MiB;
constexpr size_t WS_ACT = 224 * MiB;
constexpr size_t WS_BC = WS_ACT, WS_VC = WS_ACT + 64 * MiB, WS_YC = WS_ACT + 128 * MiB, WS_HD = WS_ACT;
constexpr size_t WS_Q = WS_ACT, WS_KB = WS_ACT + 64 * MiB, WS_VB = WS_ACT + 80 * MiB, WS_O = WS_ACT + 128 * MiB;
constexpr size_t WS_Y = WS_ACT, WS_HM = WS_ACT + 132 * MiB;
constexpr size_t WS_YP = 480 * MiB;
constexpr size_t WS_END = 508 * MiB;
constexpr size_t WS_WGU8 = 508 * MiB, WS_WD8 = 516 * MiB, WS_END2 = 520 * MiB;
constexpr int DOWN_MAIN_TILES = 256, DOWN_KS = 7;
constexpr size_t HM_TILE_BYTES = (size_t)256 * DFF;
constexpr int HM_OUT_TILES = 146, HM_WS_TILES = 118, MAX_TILES = 264;
static_assert(HM_OUT_TILES * HM_TILE_BYTES <= (size_t)M * D * 4 && WS_HM + HM_WS_TILES * HM_TILE_BYTES <= WS_END && WS_Y + (size_t)MAX_TILES * 256 * D * 2 <= WS_HM, "MoE map");
static_assert(HM_OUT_TILES + HM_WS_TILES >= MAX_TILES && WS_HD + (size_t)M * DFF * 2 <= WS_END, "capacity");
constexpr float H1Q_SCALE = 16.f, WGU8_SCALE = 256.f, HDQ_SCALE = 8.f, WD8_SCALE = 512.f;
constexpr float XQ_SCALE = 32.f, WGU_SCALE = 256.f, HQ_SCALE = 8.f, WD_SCALE = 16.f;
constexpr size_t MS_MB = 0, MS_BM = 64 * 1024, MS_VM = 128 * 1024, MS_YCM = 192 * 1024, MS_HM = 256 * 1024, MS_HMB = 320 * 1024, MS_HDM = 384 * 1024,
                 MS_SSQ0 = 512 * 1024, MS_SSQ1 = 513 * 1024, MS_SSQ2 = 516 * 1024, MS_KM = 528 * 1024, MS_VMETA = 536 * 1024;
constexpr int CW_TMO = 0, CW_CODE = 1, CW_BAR = 4096, CW_CNT = 16384;
constexpr int RING_BYTES = 131072, LDSCTL_OFF = RING_BYTES, MISC_OFF = LDSCTL_OFF + 320, LDS_BYTES = 147456;
constexpr int NWAVES = 8;

#define RLX_AGENT __ATOMIC_RELAXED, __HIP_MEMORY_SCOPE_AGENT
#define LDS_WAIT() asm volatile("s_waitcnt lgkmcnt(0)" ::: "memory")
#define VM_WAIT() asm volatile("s_waitcnt vmcnt(0)" ::: "memory")
__device__ __forceinline__ unsigned f2bf(float f) { unsigned u = __builtin_bit_cast(unsigned, f); return (u + 0x7fffu + ((u >> 16) & 1u)) >> 16; }
__device__ __forceinline__ unsigned pk2(float lo, float hi) { return f2bf(lo) | (f2bf(hi) << 16); }
__device__ __forceinline__ float clamp8(float v) { return __builtin_amdgcn_fmed3f(v, -448.f, 448.f); }
__device__ __forceinline__ unsigned pk4_fp8(float a, float b, float c, float d) { unsigned w = 0u; w = (unsigned)__builtin_amdgcn_cvt_pk_fp8_f32(clamp8(a), clamp8(b), (int)w, false); w = (unsigned)__builtin_amdgcn_cvt_pk_fp8_f32(clamp8(c), clamp8(d), (int)w, true); return w; }

namespace pg8 {
__device__ __forceinline__ float rstd_from_ssq(const float* ssq, int row) {
    const f32x4* p = (const f32x4*)((const char*)ssq + (unsigned)row * 64u);
    const f32x4 a = p[0], b = p[1], c = p[2], d = p[3];
    const float s = (((a.x + a.y) + (a.z + a.w)) + ((b.x + b.y) + (b.z + b.w))) + (((c.x + c.y) + (c.z + c.w)) + ((d.x + d.y) + (d.z + d.w)));
    return __builtin_amdgcn_rsqf(s * (1.0f / (float)D) + RMS_EPS);
}
__device__ __forceinline__ u32x4 pack8(const f32x4 v0, const f32x4 v1) { u32x4 w; w.x = cvt_pk_bf16(v0[0], v0[1]); w.y = cvt_pk_bf16(v0[2], v0[3]); w.z = cvt_pk_bf16(v1[0], v1[1]); w.w = cvt_pk_bf16(v1[2], v1[3]); return w; }
__device__ __forceinline__ float silu_mul(float g, float u) { return g * u * __builtin_amdgcn_rcpf(1.0f + __builtin_amdgcn_exp2f(-g * LOG2E)); }

constexpr int RSTD_TAB_OFF = RING_BYTES_ + 1024, RSTD_TAB_MAX_UNITS = 14;
template <class Sched>
__device__ __forceinline__ void rstd_table_fill(const Sched& S, const float* ssq, LAS float* tab, int tid) {
    LAS int* pml = (LAS int*)(tab + RSTD_TAB_MAX_UNITS * BM);
    Unit u; int n = 0;
    for (int i = 0; S.next(i, u); ++i) if (i < RSTD_TAB_MAX_UNITS) { if (tid == 0) pml[i] = u.pm; n = i + 1; }
    __syncthreads();
#pragma unroll 4
    for (int idx = tid; idx < n * BM; idx += NWAVES * 64) tab[idx] = rstd_from_ssq(ssq, pml[idx >> 8] * BM + (idx & (BM - 1)));
}
static_assert(RSTD_TAB_OFF + RSTD_TAB_MAX_UNITS * BM * 4 + RSTD_TAB_MAX_UNITS * 4 <= LDS_BYTES, "rstd table");
struct EpiConvIn {
    static constexpr bool PERM = true; static constexpr int REPE = PROBE_DEPI;
    bf16* Bc; bf16* Vc; const LAS float* rtab;
    __device__ __forceinline__ void operator()(const f32x4 (&acc)[2][2][4][2], const Unit& u, int wr, int wc, int fr, int fq) const {
        int row0 = u.pm * BM + wr * 64 + fr; asm volatile("" : "+v"(row0));
#pragma unroll
        for (int ai = 0; ai < 2; ++ai)
#pragma unroll
            for (int m = 0; m < 4; ++m) {
                const int row = row0 + ai * HALF + m * 16; const float r = rtab[u.lt * BM + ai * HALF + wr * 64 + m * 16 + fr];
                if (u.pn < 4) {
#pragma unroll
                    for (int bj = 0; bj < 2; ++bj) { const u32x4 w = pack8(acc[ai][bj][m][0] * r, acc[ai][bj][m][1] * r); u32x4* p = (u32x4*)((char*)Bc + (unsigned)(row * D + u.pn * BM + bj * HALF + wc * 32 + 8 * fq) * 2u); if (CV_NT) __builtin_nontemporal_store(w, p); else *p = w; }
                } else {
                    const float r2 = r * r;
                    { const u32x4 w = pack8(acc[ai][0][m][0] * acc[ai][1][m][0] * r2, acc[ai][0][m][1] * acc[ai][1][m][1] * r2); u32x4* p = (u32x4*)((char*)Vc + (unsigned)(row * D + (u.pn - 4) * HALF + wc * 32 + 8 * fq) * 2u); if (CV_NT) __builtin_nontemporal_store(w, p); else *p = w; }
                }
            }
    }
};
template <bool Q8 = false, bool HALFB = false>
struct EpiResidT {
    static constexpr bool PERM = true; static constexpr int REPE = 1;
    bf16* hb; float* ssq; float sc  ; unsigned char* q8  ;
    __device__ __forceinline__ void operator()(const f32x4 (&acc)[2][2][4][2], const Unit& u, int wr, int wc, int fr, int fq) const {
        int row0 = u.pm * BM + wr * 64 + fr; asm volatile("" : "+v"(row0));
        unsigned off0 = (unsigned)(row0 * D + u.pn * BM + wc * 32 + 8 * fq) * 2u; asm volatile("" : "+v"(off0));
        char* hp = (char*)sopaque((const char*)hb);
        u32x4 b[2][4][2];
#pragma unroll
        for (int ai = 0; ai < (HALFB ? 1 : 2); ++ai)
#pragma unroll
            for (int m = 0; m < 4; ++m)
#pragma unroll
                for (int bj = 0; bj < 2; ++bj) b[ai][m][bj] = *(const GAS u32x4*)(hp + (off0 + (unsigned)(((ai * HALF + m * 16) * D + bj * HALF) * 2)));
#pragma unroll
        for (int ai = 0; ai < 2; ++ai) {
            if (HALFB && ai == 1) {
#pragma unroll
                for (int m = 0; m < 4; ++m)
#pragma unroll
                    for (int bj = 0; bj < 2; ++bj) b[1][m][bj] = *(const GAS u32x4*)(hp + (off0 + (unsigned)(((HALF + m * 16) * D + bj * HALF) * 2)));
            }
#pragma unroll
            for (int m = 0; m < 4; ++m) {
                const int row = row0 + ai * HALF + m * 16; float q = 0.f;
#pragma unroll
                for (int bj = 0; bj < 2; ++bj) {
                    const u32x4 bb = b[ai][m][bj];
                    const f32x4 v0 = acc[ai][bj][m][0] * sc + (f32x4){bflo(bb.x), bfhi(bb.x), bflo(bb.y), bfhi(bb.y)}, v1 = acc[ai][bj][m][1] * sc + (f32x4){bflo(bb.z), bfhi(bb.z), bflo(bb.w), bfhi(bb.w)};
                    const u32x4 pk = pack8(v0, v1);
                    *(GAS u32x4*)(hp + (off0 + (unsigned)(((ai * HALF + m * 16) * D + bj * HALF) * 2))) = pk;
                    if constexpr (Q8) {
                        const f32x4 w0 = v0 * H1Q_SCALE, w1 = v1 * H1Q_SCALE;
                        *(GAS u32x2*)((char*)sopaque((const char*)q8) + ((off0 >> 1) + (unsigned)((ai * HALF + m * 16) * D + bj * HALF))) = (u32x2){pk4_fp8(w0[0], w0[1], w0[2], w0[3]), pk4_fp8(w1[0], w1[1], w1[2], w1[3])};
                    }
                    q += ((v0[0] * v0[0] + v0[1] * v0[1]) + (v0[2] * v0[2] + v0[3] * v0[3])) + ((v1[0] * v1[0] + v1[1] * v1[1]) + (v1[2] * v1[2] + v1[3] * v1[3]));
                }
                q += __shfl_xor(q, 16); q += __shfl_xor(q, 32);
                if (fq == 0) *(float*)((char*)ssq + (unsigned)(row * 16 + u.pn * 4 + wc) * 4u) = q;
            }
        }
    }
};
typedef EpiResidT<false, false> EpiResid;
template <bool OUT8 = true>
struct EpiSwiGLU8T {
    static constexpr bool PERM = true; static constexpr int REPE = PROBE_DEPI;
    unsigned char* H; const LAS float* rtab;
    __device__ __forceinline__ void operator()(const f32x4 (&acc)[2][2][4][2], const Unit& u, int wr, int wc, int fr, int fq) const {
        int row0 = u.pm * BM + wr * 64 + fr; asm volatile("" : "+v"(row0));
        constexpr float s = 1.0f / (H1Q_SCALE * WGU8_SCALE);
#pragma unroll
        for (int ai = 0; ai < 2; ++ai)
#pragma unroll
            for (int m = 0; m < 4; ++m) {
                const int row = row0 + ai * HALF + m * 16; const float r = rtab[u.lt * BM + ai * HALF + wr * 64 + m * 16 + fr] * s; const float c1 = -r * LOG2E, c3 = __builtin_amdgcn_rcpf(r * r * (OUT8 ? HDQ_SCALE : 1.0f));
                f32x4 h[2];
#pragma unroll
                for (int n = 0; n < 2; ++n) {
                    const f32x4 g = acc[ai][0][m][n], uu = acc[ai][1][m][n]; const f32x4 t = g * c1; f32x4 e;
#pragma unroll
                    for (int i = 0; i < 4; ++i) e[i] = __builtin_amdgcn_exp2f(t[i]);
                    const f32x4 d = e * c3 + c3; f32x4 rr;
#pragma unroll
                    for (int i = 0; i < 4; ++i) rr[i] = __builtin_amdgcn_rcpf(d[i]);
                    h[n] = (g * uu) * rr;
                }
                if constexpr (OUT8) { if (HD_NT) __builtin_nontemporal_store((u32x2){pk4_fp8(h[0][0], h[0][1], h[0][2], h[0][3]), pk4_fp8(h[1][0], h[1][1], h[1][2], h[1][3])}, (u32x2*)((char*)H + (unsigned)(row * DFF + u.pn * HALF + wc * 32 + 8 * fq)));
                    else *(u32x2*)((char*)H + (unsigned)(row * DFF + u.pn * HALF + wc * 32 + 8 * fq)) = (u32x2){pk4_fp8(h[0][0], h[0][1], h[0][2], h[0][3]), pk4_fp8(h[1][0], h[1][1], h[1][2], h[1][3])}; }
                else __builtin_nontemporal_store(pack8(h[0], h[1]), (u32x4*)((char*)H + (unsigned)(row * DFF + u.pn * HALF + wc * 32 + 8 * fq) * 2u));
            }
    }
};
struct EpiSwiGLU {
    static constexpr bool PERM = true; static constexpr int REPE = PROBE_DEPI;
    bf16* H; const LAS float* rtab;
    __device__ __forceinline__ void operator()(const f32x4 (&acc)[2][2][4][2], const Unit& u, int wr, int wc, int fr, int fq) const {
        int row0 = u.pm * BM + wr * 64 + fr; asm volatile("" : "+v"(row0));
#pragma unroll
        for (int ai = 0; ai < 2; ++ai)
#pragma unroll
            for (int m = 0; m < 4; ++m) {
                const int row = row0 + ai * HALF + m * 16; const float r = rtab[u.lt * BM + ai * HALF + wr * 64 + m * 16 + fr]; const float c1 = -r * LOG2E, c3 = __builtin_amdgcn_rcpf(r * r);
                f32x4 h[2];
#pragma unroll
                for (int n = 0; n < 2; ++n) {
                    const f32x4 g = acc[ai][0][m][n], uu = acc[ai][1][m][n]; const f32x4 t = g * c1; f32x4 e;
#pragma unroll
                    for (int i = 0; i < 4; ++i) e[i] = __builtin_amdgcn_exp2f(t[i]);
                    const f32x4 d = e * c3 + c3; f32x4 rr;
#pragma unroll
                    for (int i = 0; i < 4; ++i) rr[i] = __builtin_amdgcn_rcpf(d[i]);
                    h[n] = (g * uu) * rr;
                }
                __builtin_nontemporal_store(pack8(h[0], h[1]), (u32x4*)((char*)H + (unsigned)(row * DFF + u.pn * HALF + wc * 32 + 8 * fq) * 2u));
            }
    }
};
struct EpiQKV {
    static constexpr bool PERM = true; static constexpr int REPE = PROBE_DEPI;
    bf16* Q; bf16* Kb; bf16* Vb; const LAS float* rtab; const float* bias; const f32x2* rope;
    __device__ __forceinline__ void operator()(const f32x4 (&acc)[2][2][4][2], const Unit& u, int wr, int wc, int fr, int fq) const {
        int row0 = u.pm * BM + wr * 64 + fr; asm volatile("" : "+v"(row0));
        if (u.pn < 5) {
            const int cb = (u.pn < 4 ? u.pn * BM : D) + wc * 64 + 8 * fq;
            const f32x4 b00 = *(const f32x4*)(bias + cb), b01 = *(const f32x4*)(bias + cb + 4), b10 = *(const f32x4*)(bias + cb + 32), b11 = *(const f32x4*)(bias + cb + 36);
            const float sc = u.pn < 4 ? QSCALE : 1.0f;
#if QKV_PIPE
            const char* rbase = sopaque((const char*)rope);
            unsigned roff = (unsigned)((NMETA + (row0 & (SEQ - 1))) * 32 + 8 * fq) * 8u; asm volatile("" : "+v"(roff));
            f32x4 rq[8][4];
#pragma unroll
            for (int it = 0; it < 4; ++it)
#pragma unroll
                for (int j = 0; j < 4; ++j) rq[it][j] = *(const GAS f32x4*)(rbase + (roff + (unsigned)((((it >> 2) * HALF + (it & 3) * 16) * 32) * 8 + j * 16)));
#pragma unroll
            for (int it = 0; it < 8; ++it) {
                    const int ai = it >> 2, m = it & 3;
                    const int row = row0 + ai * HALF + m * 16; const float r = rtab[u.lt * BM + ai * HALF + wr * 64 + m * 16 + fr];
                    f32x4 lo0 = acc[ai][0][m][0] * r + b00, lo1 = acc[ai][0][m][1] * r + b01, hi0 = acc[ai][1][m][0] * r + b10, hi1 = acc[ai][1][m][1] * r + b11;
                    f32x4 ol0, ol1, oh0, oh1;
#pragma unroll
                    for (int i = 0; i < 4; ++i) {
                        const f32x2 c0 = {rq[it][i >> 1][2 * (i & 1)], rq[it][i >> 1][2 * (i & 1) + 1]}, c1 = {rq[it][2 + (i >> 1)][2 * (i & 1)], rq[it][2 + (i >> 1)][2 * (i & 1) + 1]};
                        ol0[i] = (lo0[i] * c0.x - hi0[i] * c0.y) * sc; oh0[i] = (hi0[i] * c0.x + lo0[i] * c0.y) * sc;
                        ol1[i] = (lo1[i] * c1.x - hi1[i] * c1.y) * sc; oh1[i] = (hi1[i] * c1.x + lo1[i] * c1.y) * sc;
                    }
                    if (u.pn < 4) { char* p = (char*)Q + (unsigned)(row * D + u.pn * BM + wc * 64 + 8 * fq) * 2u; *(u32x4*)p = pack8(ol0, ol1); *(u32x4*)(p + 64) = pack8(oh0, oh1); }
                    else          { char* p = (char*)Kb + (unsigned)(row * KVD + wc * 64 + 8 * fq) * 2u;          *(u32x4*)p = pack8(ol0, ol1); *(u32x4*)(p + 64) = pack8(oh0, oh1); }
                    if (it + 4 < 8) {
#pragma unroll
                        for (int j = 0; j < 4; ++j) rq[it + 4][j] = *(const GAS f32x4*)(rbase + (roff + (unsigned)(((((it + 4) >> 2) * HALF + ((it + 4) & 3) * 16) * 32) * 8 + j * 16)));
                    }
            }
#else
#pragma unroll
            for (int ai = 0; ai < 2; ++ai)
#pragma unroll
                for (int m = 0; m < 4; ++m) {
                    const int row = row0 + ai * HALF + m * 16; const float r = rtab[u.lt * BM + ai * HALF + wr * 64 + m * 16 + fr];
                    const f32x2* rp = (const f32x2*)((const char*)rope + (unsigned)((NMETA + (row & (SEQ - 1))) * 32 + 8 * fq) * 8u);
                    f32x4 lo0 = acc[ai][0][m][0] * r + b00, lo1 = acc[ai][0][m][1] * r + b01, hi0 = acc[ai][1][m][0] * r + b10, hi1 = acc[ai][1][m][1] * r + b11;
                    f32x4 ol0, ol1, oh0, oh1;
#pragma unroll
                    for (int i = 0; i < 4; ++i) {
                        const f32x2 c0 = rp[i], c1 = rp[4 + i];
                        ol0[i] = (lo0[i] * c0.x - hi0[i] * c0.y) * sc; oh0[i] = (hi0[i] * c0.x + lo0[i] * c0.y) * sc;
                        ol1[i] = (lo1[i] * c1.x - hi1[i] * c1.y) * sc; oh1[i] = (hi1[i] * c1.x + lo1[i] * c1.y) * sc;
                    }
                    if (u.pn < 4) { char* p = (char*)Q + (unsigned)(row * D + u.pn * BM + wc * 64 + 8 * fq) * 2u; *(u32x4*)p = pack8(ol0, ol1); *(u32x4*)(p + 64) = pack8(oh0, oh1); }
                    else          { char* p = (char*)Kb + (unsigned)(row * KVD + wc * 64 + 8 * fq) * 2u;          *(u32x4*)p = pack8(ol0, ol1); *(u32x4*)(p + 64) = pack8(oh0, oh1); }
                }
#endif
        } else {
#pragma unroll
            for (int bj = 0; bj < 2; ++bj) {
                const int c = bj * HALF + wc * 32 + 8 * fq;
                const f32x4 b0 = *(const f32x4*)(bias + D + KVD + c), b1 = *(const f32x4*)(bias + D + KVD + c + 4);
#pragma unroll
                for (int ai = 0; ai < 2; ++ai)
#pragma unroll
                    for (int m = 0; m < 4; ++m) {
                        const int row = row0 + ai * HALF + m * 16; const float r = rtab[u.lt * BM + ai * HALF + wr * 64 + m * 16 + fr];
                        *(u32x4*)((char*)Vb + (unsigned)(row * KVD + c) * 2u) = pack8(acc[ai][bj][m][0] * r + b0, acc[ai][bj][m][1] * r + b1);
                    }
            }
        }
    }
};
}
#define XB_TMO      128
#define XB_XCNT(j)  (256  + 64 * (j))
#define XB_XSUB(j)  (1280 + 64 * (j))
#define XB_XGEN(j)  (2304 + 64 * (j))
#define XB_TOP      3328
#define XB_TOPGEN   3392
#define XCD_BAR_WORDS 3456
#define XB_SPIN_CAP (1u << 18)

__device__ __forceinline__ unsigned xb_ld(unsigned* p)              { return __hip_atomic_load(p, __ATOMIC_RELAXED, __HIP_MEMORY_SCOPE_AGENT); }
__device__ __forceinline__ unsigned xb_add(unsigned* p, unsigned v) { return __hip_atomic_fetch_add(p, v, __ATOMIC_RELAXED, __HIP_MEMORY_SCOPE_AGENT); }
__device__ __forceinline__ unsigned xb_xcc_id() { return (unsigned)__builtin_amdgcn_s_getreg((3 << 11) | 20) & 0xFu; }
#define XB_SPIN(cond, bar) do { unsigned _sp = 0; while (cond) { __builtin_amdgcn_s_sleep(1); \
    if ((++_sp & 255u) == 0u) { if (xb_ld(&(bar)[XB_TMO])) break; if (_sp > XB_SPIN_CAP) { atomicAdd(&(bar)[XB_TMO], 1u); break; } } } } while (0)

struct XcdBarrier {
    unsigned* bar; unsigned x;
    volatile LAS unsigned* st;
};

__device__ __forceinline__ XcdBarrier xcd_barrier_post(unsigned* bar, volatile LAS unsigned* st, int wave) {
    XcdBarrier b; b.bar = bar; b.x = xb_xcc_id(); b.st = st;
    if (wave == 0 && hw_lane() == 0) (void)xb_add(&bar[XB_XCNT(b.x)], 1u);
    return b;
}
__device__ __forceinline__ void xcd_barrier_complete(unsigned* bar, unsigned x, unsigned& nloc, unsigned& nx) {
    const unsigned G = gridDim.x * gridDim.y * gridDim.z;
    unsigned sum, cnt, mine, sp = 0u;
    for (;;) {
        sum = 0u; cnt = 0u; mine = 0u;
#pragma unroll
        for (unsigned j = 0; j < 16; ++j) { const unsigned c = xb_ld(&bar[XB_XCNT(j)]); sum += c; cnt += (c > 0u) ? 1u : 0u; mine = (j == x) ? c : mine; }
        if (sum == G) break;
        __builtin_amdgcn_s_sleep(1);
        if ((++sp & 255u) == 0u) { if (xb_ld(&bar[XB_TMO])) break; if (sp > XB_SPIN_CAP) { atomicAdd(&bar[XB_TMO], 1u); break; } }
    }
    nloc = mine > 0u ? mine : 1u; nx = cnt > 0u ? cnt : 1u;
}

__device__ __forceinline__ void xcd_barrier(const XcdBarrier& b, int wave) {
    asm volatile("s_waitcnt vmcnt(0)" ::: "memory");
    __syncthreads();
    if (wave == 0 && hw_lane() == 0) {
        unsigned* bar = b.bar;
        __builtin_amdgcn_s_waitcnt(0);
        unsigned nloc = b.st[0], nx = b.st[1];
        if (nloc == 0u) { xcd_barrier_complete(bar, b.x, nloc, nx); b.st[0] = nloc; b.st[1] = nx; }
        const unsigned old = xb_add(&bar[XB_XSUB(b.x)], 1u);
        const unsigned gen = old / nloc;
        if (old + 1u == (gen + 1u) * nloc) {
            __builtin_amdgcn_fence(__ATOMIC_RELEASE, "agent");
            asm volatile("s_waitcnt vmcnt(0)" ::: "memory");
            const unsigned og = xb_add(&bar[XB_TOP], 1u);
            const unsigned tg = og / nx;
            if (og + 1u == (tg + 1u) * nx) xb_add(&bar[XB_TOPGEN], 1u);
            else XB_SPIN(xb_ld(&bar[XB_TOPGEN]) == tg, bar);
            __builtin_amdgcn_fence(__ATOMIC_ACQUIRE, "agent");
            xb_add(&bar[XB_XGEN(b.x)], 1u);
            asm volatile("s_waitcnt vmcnt(0)" ::: "memory");
        } else {
            XB_SPIN(xb_ld(&bar[XB_XGEN(b.x)]) == gen, bar);
            __builtin_amdgcn_fence(__ATOMIC_ACQUIRE, "agent");
            asm volatile("s_waitcnt vmcnt(0)" ::: "memory");
        }
    }
    __syncthreads();
}

struct MoeInfo { int ts[9]; int cnt[8]; };
__device__ __forceinline__ void moe_info_load(const unsigned* ctl, MoeInfo& mi) {
    int t = 0;
#pragma unroll
    for (int e = 0; e < 8; ++e) { const int c = (int)__builtin_amdgcn_readfirstlane(__hip_atomic_load(ctl + CW_CNT + 64 * e, RLX_AGENT)); mi.cnt[e] = c; mi.ts[e] = t; t += (c + 255) >> 8; }
    mi.ts[8] = t;
}
__device__ __forceinline__ void moe_info_to_lds(const unsigned* ctl, LAS int* ml, int wave) {
    MoeInfo mi; moe_info_load(ctl, mi);
    if (wave == 0 && hw_lane() == 0) {
#pragma unroll
        for (int e = 0; e < 9; ++e) ml[e] = mi.ts[e];
#pragma unroll
        for (int e = 0; e < 8; ++e) ml[16 + e] = mi.cnt[e];
    }
    __syncthreads();
}
__device__ __forceinline__ void moe_find(const LAS int* ml, int T, int& e, int& ts, int& ne) {
    int ee = 0;
#pragma unroll
    for (int j = 1; j < 8; ++j) ee += (T >= ml[j]) ? 1 : 0;
    e = __builtin_amdgcn_readfirstlane(ee); ts = __builtin_amdgcn_readfirstlane(ml[e]); ne = __builtin_amdgcn_readfirstlane(ml[16 + e]);
}
__device__ __forceinline__ char* hm_tile_ptr(unsigned char* dout, unsigned char* ws, int ltc  ) {
    return (char*)(ltc < HM_OUT_TILES ? dout + (size_t)ltc * HM_TILE_BYTES : ws + WS_HM + (size_t)(ltc - HM_OUT_TILES) * HM_TILE_BYTES);
}
namespace pg8 {
struct MoeUpSched {
    static constexpr bool GATHER = true, FP8 = true; static constexpr int REPK = PROBE_KL, REPE = PROBE_EPI;
    const char* A; const char* Bt; const int* list; const LAS int* ml; int KB, nM, G, c, tbase; static constexpr int nN = NGU / 256;
    __device__ __forceinline__ bool next(int i, Unit& u) const {
        const int L = i * G + c; if (L >= nM * nN) return false;
        int pmc; order_unit(L, nM, nN, pmc, u.pn); const int T = tbase + pmc; int e, ts, ne; moe_find(ml, T, e, ts, ne);
        u.pm = T; u.e = e | (ne << 4); u.lt = T - ts; u.ord = i; return true; }
    __device__ __forceinline__ const char* aptr(const Unit&) const { return A; }
    __device__ __forceinline__ const char* bptr(const Unit& u) const { return Bt + ((size_t)(u.e & 15) * NGU + (size_t)u.pn * BM) * D; }
    __device__ __forceinline__ unsigned arow(const Unit& u, int r) const { const int idx = u.lt * BM + r; const int tok = idx < (u.e >> 4) ? list[(size_t)(u.e & 15) * M + idx] : 0; return (unsigned)tok * (unsigned)D; }
    __device__ __forceinline__ int arow_raw(const Unit& u, int r) const { const int ne = u.e >> 4; int idx = u.lt * BM + r; idx = idx < ne ? idx : ne - 1; return list[(size_t)(u.e & 15) * M + idx]; }
    __device__ __forceinline__ unsigned arow_fin(int tok) const { return (unsigned)tok * (unsigned)D; }    __device__ __forceinline__ int ktiles() const { return KB / (BK * 2); }
};
struct MoeDownSched {
    static constexpr bool GATHER = false, FP8 = true; static constexpr int REPK = 1, REPE = 1;
    unsigned char* dout; unsigned char* ws; const char* Bt; const LAS int* ml; int KB, nM, G, c, tbase; static constexpr int nN = D / 256;
    __device__ __forceinline__ bool next(int i, Unit& u) const {
        int L = i * G + c; if (L >= nM * nN) return false;
        if (HM_PLAIN_FROM < 64 && (nM * nN) % G == 0) L = (nM * nN / G - 1 - i) * G + c;
        int pmc; order_unit(L, nM, nN, pmc, u.pn); const int T = tbase + pmc;
        int e, ts, ne; moe_find(ml, T, e, ts, ne);
        u.pm = T; u.e = e; u.lt = 0; return true; }
    __device__ __forceinline__ const char* aptr(const Unit& u) const { return hm_tile_ptr(dout, ws, u.pm - tbase); }
    __device__ __forceinline__ const char* bptr(const Unit& u) const { return Bt + ((size_t)(u.e & 15) * D + (size_t)u.pn * BM) * DFF; }
    __device__ __forceinline__ unsigned arow(const Unit&, int r) const { return (unsigned)r * (unsigned)DFF; }    __device__ __forceinline__ int ktiles() const { return KB / (BK * 2); }
};
struct MoeDownTailSched {
    static constexpr bool GATHER = false, FP8 = true; static constexpr int REPK = 1, REPE = 1;
    unsigned char* dout; unsigned char* ws; const char* Bt; const LAS int* ml; int KB, nsub, G, c;
    __device__ __forceinline__ bool next(int i, Unit& u) const {
        const int q = i * G + c; if (q >= nsub) return false;
        const int tr = q / (4 * DOWN_KS), rem = q % (4 * DOWN_KS); u.pn = rem / DOWN_KS; u.lt = rem % DOWN_KS; u.pm = DOWN_MAIN_TILES + tr;
        int e, ts, ne; moe_find(ml, u.pm, e, ts, ne); u.e = e; return true; }
    __device__ __forceinline__ const char* aptr(const Unit& u) const { return hm_tile_ptr(dout, ws, u.pm) + u.lt * 512; }
    __device__ __forceinline__ const char* bptr(const Unit& u) const { return Bt + ((size_t)(u.e & 15) * D + (size_t)u.pn * BM) * DFF + u.lt * 512; }
    __device__ __forceinline__ unsigned arow(const Unit&, int r) const { return (unsigned)r * (unsigned)DFF; }
    __device__ __forceinline__ int ktiles() const { int n = 4; asm volatile("" : "+s"(n)); return n; }
};

struct EpiMoeUp {
    static constexpr bool PERM = true; static constexpr int REPE = 1;
    unsigned char* dout; unsigned char* ws; int tbase;
    __device__ __forceinline__ void operator()(const f32x4 (&acc)[2][2][4][2], const Unit& u, int wr, int wc, int fr, int fq) const {
        constexpr float s = 1.0f / (XQ_SCALE * WGU_SCALE), c1 = -s * LOG2E, c3 = 1.0f / (s * s * HQ_SCALE);
        unsigned off0 = (unsigned)((wr * 64 + fr) * DFF + u.pn * HALF + wc * 32 + 8 * fq); asm volatile("" : "+v"(off0));
        char* H = (char*)pg8::sopaque(hm_tile_ptr(dout, ws, u.pm - tbase)) + off0;
#pragma unroll
        for (int ai = 0; ai < 2; ++ai)
#pragma unroll
            for (int m = 0; m < 4; ++m) {
                f32x4 h[2];
#pragma unroll
                for (int n = 0; n < 2; ++n) {
                    const f32x4 g = acc[ai][0][m][n], uu = acc[ai][1][m][n]; const f32x4 t = g * c1; f32x4 e;
#pragma unroll
                    for (int i = 0; i < 4; ++i) e[i] = __builtin_amdgcn_exp2f(t[i]);
                    const f32x4 d = e * c3 + c3; f32x4 r;
#pragma unroll
                    for (int i = 0; i < 4; ++i) r[i] = __builtin_amdgcn_rcpf(d[i]);
                    h[n] = (g * uu) * r;
                }
                const u32x2 hw = (u32x2){pk4_fp8(h[0][0], h[0][1], h[0][2], h[0][3]), pk4_fp8(h[1][0], h[1][1], h[1][2], h[1][3])};
                if (u.ord >= HM_PLAIN_FROM) *(u32x2*)(H + (ai * HALF + m * 16) * DFF) = hw; else __builtin_nontemporal_store(hw, (u32x2*)(H + (ai * HALF + m * 16) * DFF));
            }
    }
};
struct EpiMoeDown {
    static constexpr bool PERM = true; static constexpr int REPE = 1;
    unsigned char* Y;
    __device__ __forceinline__ void operator()(const f32x4 (&acc)[2][2][4][2], const Unit& u, int wr, int wc, int fr, int fq) const {
        unsigned off0 = (unsigned)((u.pm * BM + wr * 64 + fr) * D + u.pn * BM + wc * 32 + 8 * fq); asm volatile("" : "+v"(off0));
        char* Yp = (char*)pg8::sopaque((const char*)Y) + off0;
#pragma unroll
        for (int ai = 0; ai < 2; ++ai)
#pragma unroll
            for (int m = 0; m < 4; ++m)
#pragma unroll
                for (int bj = 0; bj < 2; ++bj) { const f32x4 v0 = acc[ai][bj][m][0], v1 = acc[ai][bj][m][1];
                    *(u32x2*)(Yp + (ai * HALF + m * 16) * D + bj * HALF) = (u32x2){pk4_fp8(v0[0], v0[1], v0[2], v0[3]), pk4_fp8(v1[0], v1[1], v1[2], v1[3])}; }
    }
};
struct EpiMoeDownPart {
    static constexpr bool PERM = true; static constexpr int REPE = 1;
    bf16* P;
    __device__ __forceinline__ void operator()(const f32x4 (&acc)[2][2][4][2], const Unit& u, int wr, int wc, int fr, int fq) const {
        unsigned off0 = (unsigned)((((u.pm - DOWN_MAIN_TILES) * 4 + u.pn) * DOWN_KS + u.lt) * 65536 + (wr * 64 + fr) * 256 + wc * 32 + 8 * fq) * 2u; asm volatile("" : "+v"(off0));
        char* Pp = (char*)pg8::sopaque((const char*)P) + off0;
#pragma unroll
        for (int ai = 0; ai < 2; ++ai)
#pragma unroll
            for (int m = 0; m < 4; ++m)
#pragma unroll
                for (int bj = 0; bj < 2; ++bj) *(u32x4*)(Pp + ((ai * HALF + m * 16) * 256 + bj * HALF) * 2) = pack8(acc[ai][bj][m][0], acc[ai][bj][m][1]);
    }
};
}

constexpr int META_LDS_OFF = RING_BYTES + 1024;
static_assert(META_LDS_OFF + 7 * 64 * 8 * 4 <= LDS_BYTES, "meta scratch");
template <class F>
__device__ __forceinline__ void meta_dual(LAS unsigned char* lds, const bf16* A, int K, const bf16* Bt, int n0, int n1, int lane, int wave, const F& epi) {
    const int r16 = lane & 15, kq = lane >> 4; const int kw = K / 8, kb = wave * kw;
    const bf16* ap = A + (size_t)r16 * K + kb + 8 * kq; const bf16* b0p = Bt + (size_t)(n0 + r16) * K + kb + 8 * kq; const bf16* b1p = Bt + (size_t)(n1 + r16) * K + kb + 8 * kq;
    f32x4 acc0 = (f32x4){0.f, 0.f, 0.f, 0.f}, acc1 = (f32x4){0.f, 0.f, 0.f, 0.f};
#pragma unroll 2
    for (int k = 0; k < kw; k += 64) {
        const bf16x8 a = *(const bf16x8*)(ap + k), b0 = *(const bf16x8*)(b0p + k), b1 = *(const bf16x8*)(b1p + k);
        const bf16x8 a2 = *(const bf16x8*)(ap + k + 32), b02 = *(const bf16x8*)(b0p + k + 32), b12 = *(const bf16x8*)(b1p + k + 32);
        acc0 = __builtin_amdgcn_mfma_f32_16x16x32_bf16(a, b0, acc0, 0, 0, 0); acc1 = __builtin_amdgcn_mfma_f32_16x16x32_bf16(a, b1, acc1, 0, 0, 0);
        acc0 = __builtin_amdgcn_mfma_f32_16x16x32_bf16(a2, b02, acc0, 0, 0, 0); acc1 = __builtin_amdgcn_mfma_f32_16x16x32_bf16(a2, b12, acc1, 0, 0, 0);
    }
    LAS f32x4* sc = (LAS f32x4*)(lds + META_LDS_OFF);
    if (wave > 0) { sc[((wave - 1) * 64 + lane) * 2] = acc0; sc[((wave - 1) * 64 + lane) * 2 + 1] = acc1; }
    __syncthreads();
    if (wave == 0) {
#pragma unroll
        for (int w = 0; w < 7; ++w) { acc0 += sc[(w * 64 + lane) * 2]; acc1 += sc[(w * 64 + lane) * 2 + 1]; }
        epi(acc0, acc1, r16, kq);
    }
}
__device__ __forceinline__ f32x4 meta_rstd_parts(const float* parts, int lane) {
    float s = 0.f;
    for (int j = 0; j < 32; ++j) s += parts[j * 16 + (lane & 15)];
    const float r = 1.0f / sqrtf(s * (1.0f / (float)D) + RMS_EPS); const int kq = lane >> 4; f32x4 o;
#pragma unroll
    for (int g = 0; g < 4; ++g) o[g] = __shfl(r, 4 * kq + g);
    return o;
}

__device__ __forceinline__ void p0_item(const float* W, int ldw, int K, int k0, int n0, bf16* dst, const float* gain, LAS float* scr, int lane) {
    { float t[32]; const float* wp = W + (size_t)(k0 + (lane >> 5)) * ldw + n0 + (lane & 31);
#pragma unroll
      for (int i = 0; i < 32; ++i) t[i] = wp[(size_t)(2 * i) * ldw];
#pragma unroll
      for (int i = 0; i < 32; ++i) scr[(2 * i + (lane >> 5)) * 33 + (lane & 31)] = t[i]; }
    LDS_WAIT(); asm volatile("" ::: "memory");
    const int c = lane & 7;
    float g[8];
#pragma unroll
    for (int e = 0; e < 8; ++e) g[e] = gain ? gain[k0 + 8 * c + e] : 1.0f;
#pragma unroll
    for (int j = 0; j < 4; ++j) { const int n = (lane >> 3) + 8 * j; const LAS float* s = scr + (8 * c) * 33 + n;
        u32x4 o; o.x = pk2(s[0 * 33] * g[0], s[1 * 33] * g[1]); o.y = pk2(s[2 * 33] * g[2], s[3 * 33] * g[3]); o.z = pk2(s[4 * 33] * g[4], s[5 * 33] * g[5]); o.w = pk2(s[6 * 33] * g[6], s[7 * 33] * g[7]);
        *(GAS u32x4*)(dst + (size_t)n * K + k0 + 8 * c) = o; }
    LDS_WAIT(); asm volatile("" ::: "memory");
}
__device__ __forceinline__ void p0_item_dual(const float* W, int ldw, int K, int k0, int n0, bf16* dst, unsigned char* dst8, const float* gain, float sc, LAS float* scr, int lane) {
    { float t[32]; const float* wp = W + (size_t)(k0 + (lane >> 5)) * ldw + n0 + (lane & 31);
#pragma unroll
      for (int i = 0; i < 32; ++i) t[i] = wp[(size_t)(2 * i) * ldw];
#pragma unroll
      for (int i = 0; i < 32; ++i) scr[(2 * i + (lane >> 5)) * 33 + (lane & 31)] = t[i]; }
    LDS_WAIT(); asm volatile("" ::: "memory");
    const int c = lane & 7;
    float g[8];
#pragma unroll
    for (int e = 0; e < 8; ++e) g[e] = gain ? gain[k0 + 8 * c + e] : 1.0f;
#pragma unroll
    for (int j = 0; j < 4; ++j) { const int n = (lane >> 3) + 8 * j; const LAS float* s = scr + (8 * c) * 33 + n;
        float v[8];
#pragma unroll
        for (int e = 0; e < 8; ++e) v[e] = s[e * 33] * g[e];
        u32x4 o; o.x = pk2(v[0], v[1]); o.y = pk2(v[2], v[3]); o.z = pk2(v[4], v[5]); o.w = pk2(v[6], v[7]);
        *(GAS u32x4*)(dst + (size_t)n * K + k0 + 8 * c) = o;
        u32x2 o8; o8.x = pk4_fp8(v[0] * sc, v[1] * sc, v[2] * sc, v[3] * sc); o8.y = pk4_fp8(v[4] * sc, v[5] * sc, v[6] * sc, v[7] * sc);
        *(GAS u32x2*)(dst8 + (size_t)n * K + k0 + 8 * c) = o8; }
    LDS_WAIT(); asm volatile("" ::: "memory");
}
__device__ __forceinline__ void p0_item8(const float* W, int ldw, int K, int k0, int n0, unsigned char* dst, const float* gain, float sc, LAS float* scr, int lane) {
    { float t[32]; const float* wp = W + (size_t)(k0 + (lane >> 5)) * ldw + n0 + (lane & 31);
#pragma unroll
      for (int i = 0; i < 32; ++i) t[i] = wp[(size_t)(2 * i) * ldw];
#pragma unroll
      for (int i = 0; i < 32; ++i) scr[(2 * i + (lane >> 5)) * 33 + (lane & 31)] = t[i]; }
    LDS_WAIT(); asm volatile("" ::: "memory");
    const int c = lane & 7;
    float g[8];
#pragma unroll
    for (int e = 0; e < 8; ++e) g[e] = (gain ? gain[k0 + 8 * c + e] : 1.0f) * sc;
#pragma unroll
    for (int j = 0; j < 4; ++j) { const int n = (lane >> 3) + 8 * j; const LAS float* s = scr + (8 * c) * 33 + n;
        u32x2 o; o.x = pk4_fp8(s[0 * 33] * g[0], s[1 * 33] * g[1], s[2 * 33] * g[2], s[3 * 33] * g[3]); o.y = pk4_fp8(s[4 * 33] * g[4], s[5 * 33] * g[5], s[6 * 33] * g[6], s[7 * 33] * g[7]);
        *(GAS u32x2*)(dst + (size_t)n * K + k0 + 8 * c) = o; }
    LDS_WAIT(); asm volatile("" ::: "memory");
}
__device__ __forceinline__ int ileave(int ch, int kind) { return 256 * (ch >> 7) + 128 * kind + (ch & 127); }

struct Args { const float* in[21]; float* out; unsigned char* ws; float inv[32]; int ph_lo, ph_hi; };

constexpr int EXP_ITEMS = 24 * 16 * 112, BG_ORDS = 20, BG_P1 = 6, BG_P4 = 14;
__device__ __forceinline__ int bg_cover(int G) { if (!BG_CVT) return 0; const int c = BG_ORDS * G * NWAVES; return c < EXP_ITEMS ? c : EXP_ITEMS; }
struct ExpertCvtBg {
    const float* gate; const float* up; const float* down; const float* gain; unsigned char* ws; int first, base_ord, nmax, gw, NGW;
    f32x4 t[8]; f32x4 gA, gB; unsigned char* dbase; unsigned doff; int K; float sc; bool active;
    __device__ __forceinline__ void issue(int ui) {
        const int r = first + (base_ord + ui) * NGW + gw;
        active = ui < nmax && r < EXP_ITEMS;
        if (!active) return;
        const int mat = r / (16 * 112), q = r - mat * (16 * 112), kind = mat >> 3, e = mat & 7;
        const int ln = hw_lane(), kq = ln >> 3, nq = ln & 7;
        const float* W; int ldw, k0, n0;
        if (kind < 2) { const int kb = q / 112, nb = q - kb * 112; k0 = kb * 64; n0 = nb * 32; W = (kind ? up : gate) + (size_t)e * D * DFF; ldw = DFF; K = D; sc = WGU_SCALE;
            dbase = ws + WS_EWGU + ((size_t)e * NGU + ileave(n0, kind)) * D; }
        else { const int kb = q >> 5, nb = q & 31; k0 = kb * 64; n0 = nb * 32; W = down + (size_t)e * DFF * D; ldw = D; K = DFF; sc = WD_SCALE; dbase = ws + WS_EWD + ((size_t)e * D + n0) * DFF; }
        const GAS float* wp = (const GAS float*)W + (size_t)(k0 + 8 * kq) * ldw + n0 + 4 * nq;
#pragma unroll
        for (int j = 0; j < 8; ++j) t[j] = *(const GAS f32x4*)(wp + (size_t)j * ldw);
        if (kind < 2) { gA = *(const GAS f32x4*)(gain + k0 + 8 * kq); gB = *(const GAS f32x4*)(gain + k0 + 8 * kq + 4); } else { gA = (f32x4){1.f, 1.f, 1.f, 1.f}; gB = gA; }
        doff = (unsigned)((4 * nq) * K + k0 + 8 * kq);
    }
    __device__ __forceinline__ void finish() {
        if (!active) return;
        active = false;
        const float g[8] = {gA.x * sc, gA.y * sc, gA.z * sc, gA.w * sc, gB.x * sc, gB.y * sc, gB.z * sc, gB.w * sc};
#pragma unroll
        for (int i = 0; i < 4; ++i) {
            u32x2 o; o.x = pk4_fp8(t[0][i] * g[0], t[1][i] * g[1], t[2][i] * g[2], t[3][i] * g[3]); o.y = pk4_fp8(t[4][i] * g[4], t[5][i] * g[5], t[6][i] * g[6], t[7][i] * g[7]);
            *(GAS u32x2*)(dbase + (doff + (unsigned)(i * K))) = o;
        }
    }
};

__device__ __forceinline__ void p0_prologue(const Args& a, LAS unsigned char* lds, int vcu, int G, int wave, int lane) {
    unsigned char* ws = a.ws;
    LAS float* scr = (LAS float*)(lds + wave * 16384);
    const int gw = vcu * NWAVES + wave, NGW = G * NWAVES;
    constexpr int I_WIN = 16 * 96, I_WOUT = 16 * 32, I_G = 16 * 112, I_DN = 56 * 32, I_QKV = 16 * 48, I_WO = 16 * 32;
    constexpr int NITEMS = I_WIN + I_WOUT + 2 * I_G + I_DN + I_QKV + I_WO + 24 * I_G;
    static_assert(I_DN == I_G, "item counts");
    const int nitems = NITEMS - bg_cover(G);
    for (int it = gw; it < nitems; it += NGW) {
        int r = it;
        if (r < I_WIN) { const int kb = r / 96, nb = r % 96, n0 = nb * 32; int d0;
            if (n0 < D) d0 = n0; else if (n0 < 2 * D) d0 = D + ileave(n0 - D, 0); else d0 = D + ileave(n0 - 2 * D, 1);
            p0_item(a.in[3], NCONV, D, kb * 64, n0, (bf16*)(ws + WS_WIN) + (size_t)d0 * D, a.in[2], scr, lane); continue; } r -= I_WIN;
        if (r < I_WOUT) { const int kb = r / 32, nb = r % 32; p0_item(a.in[5], D, D, kb * 64, nb * 32, (bf16*)(ws + WS_WOUT) + (size_t)(nb * 32) * D, nullptr, scr, lane); continue; } r -= I_WOUT;
        if (r < I_G) { const int kb = r / 112, nb = r % 112;
            if (FFN8) p0_item_dual(a.in[7], DFF, D, kb * 64, nb * 32, (bf16*)(ws + WS_WGU) + (size_t)ileave(nb * 32, 0) * D, ws + WS_WGU8 + (size_t)ileave(nb * 32, 0) * D, a.in[6], WGU8_SCALE, scr, lane);
            else p0_item(a.in[7], DFF, D, kb * 64, nb * 32, (bf16*)(ws + WS_WGU) + (size_t)ileave(nb * 32, 0) * D, a.in[6], scr, lane); continue; } r -= I_G;
        if (r < I_G) { const int kb = r / 112, nb = r % 112;
            if (FFN8) p0_item_dual(a.in[8], DFF, D, kb * 64, nb * 32, (bf16*)(ws + WS_WGU) + (size_t)ileave(nb * 32, 1) * D, ws + WS_WGU8 + (size_t)ileave(nb * 32, 1) * D, a.in[6], WGU8_SCALE, scr, lane);
            else p0_item(a.in[8], DFF, D, kb * 64, nb * 32, (bf16*)(ws + WS_WGU) + (size_t)ileave(nb * 32, 1) * D, a.in[6], scr, lane); continue; } r -= I_G;
        if (r < I_DN) { const int kb = r / 32, nb = r % 32;
            if (FFN8) p0_item_dual(a.in[9], D, DFF, kb * 64, nb * 32, (bf16*)(ws + WS_WD) + (size_t)(nb * 32) * DFF, ws + WS_WD8 + (size_t)(nb * 32) * DFF, nullptr, WD8_SCALE, scr, lane);
            else p0_item(a.in[9], D, DFF, kb * 64, nb * 32, (bf16*)(ws + WS_WD) + (size_t)(nb * 32) * DFF, nullptr, scr, lane); continue; } r -= I_DN;
        if (r < I_QKV) { const int kb = r / 48, nb = r % 48, n0 = nb * 32; int d0;
            if (n0 < D + KVD) { const int c = n0 & 255; d0 = (n0 & ~255) + 128 * ((c >> 5) & 1) + 32 * (c >> 6); } else d0 = n0;
            p0_item(a.in[11], NQKV, D, kb * 64, n0, (bf16*)(ws + WS_WQKV) + (size_t)d0 * D, a.in[10], scr, lane); continue; } r -= I_QKV;
        if (r < I_WO) { const int kb = r / 32, nb = r % 32; p0_item(a.in[14], D, D, kb * 64, nb * 32, (bf16*)(ws + WS_WO) + (size_t)(nb * 32) * D, nullptr, scr, lane); continue; } r -= I_WO;
        { const int mat = r / I_G, q = r % I_G, kind = mat >> 3, e = mat & 7;
          if (kind < 2) { const int kb = q / 112, nb = q % 112;
              p0_item8(a.in[17 + kind] + (size_t)e * D * DFF, DFF, D, kb * 64, nb * 32, ws + WS_EWGU + ((size_t)e * NGU + ileave(nb * 32, kind)) * D, a.in[15], WGU_SCALE, scr, lane); }
          else { const int kb = q / 32, nb = q % 32;
              p0_item8(a.in[19] + (size_t)e * DFF * D, D, DFF, kb * 64, nb * 32, ws + WS_EWD + ((size_t)e * D + nb * 32) * DFF, nullptr, WD_SCALE, scr, lane); } }
    }
    {
        bf16* hb = (bf16*)(ws + WS_HB); float* ssq = (float*)(ws + WS_SSQ);
        constexpr int RB = 4;
        for (int m0 = gw; m0 < M + NMETA; m0 += RB * NGW) {
            f32x4 v[RB][4];
#pragma unroll
            for (int q = 0; q < RB; ++q) { const int m = m0 + q * NGW < M + NMETA ? m0 + q * NGW : m0; const bool meta = m >= M;
                const GAS f32x4* xr = (const GAS f32x4*)(meta ? a.in[1] + (size_t)(m - M) * D : a.in[0] + (size_t)m * D) + lane;
#pragma unroll
                for (int j = 0; j < 4; ++j) v[q][j] = xr[64 * j]; }
#pragma unroll
            for (int q = 0; q < RB; ++q) { const int m = m0 + q * NGW; if (m >= M + NMETA) break; const bool meta = m >= M;
                float s = 0.f;
#pragma unroll
                for (int j = 0; j < 4; ++j) s += (v[q][j].x * v[q][j].x + v[q][j].y * v[q][j].y) + (v[q][j].z * v[q][j].z + v[q][j].w * v[q][j].w);
                s = wave_sum(s);
                bf16* orow = meta ? (bf16*)(ws + WS_MISC + MS_MB) + (size_t)(m - M) * D : hb + (size_t)m * D;
                GAS unsigned long long* o8 = (GAS unsigned long long*)orow + lane;
#pragma unroll
                for (int j = 0; j < 4; ++j) o8[64 * j] = (unsigned long long)pk2(v[q][j].x, v[q][j].y) | ((unsigned long long)pk2(v[q][j].z, v[q][j].w) << 32);
                if (meta) { if (lane == 0) ((float*)(ws + WS_MISC + MS_SSQ0))[m - M] = s; }
                else if (lane < 16) ssq[(size_t)m * 16 + lane] = lane == 0 ? s : 0.f; }
        }
    }
    {
        f32x2* rope = (f32x2*)(ws + WS_ROPE);
        const int gt = gw * 64 + lane, NGT = NGW * 64;
        for (int idx = gt; idx < LPOS * 32; idx += NGT) {
            const int p = idx >> 5, f = idx & 31; const float ang = (float)p * a.inv[f];
            const double rev = (double)ang * 0.15915494309189535; const float fr = (float)(rev - rint(rev));
            rope[idx] = (f32x2){__builtin_amdgcn_cosf(fr), __builtin_amdgcn_sinf(fr)};
        }
    }
}

__device__ __forceinline__ void unpack8(const u32x4 w, float (&f)[8]) { f[0] = bflo(w.x); f[1] = bfhi(w.x); f[2] = bflo(w.y); f[3] = bfhi(w.y); f[4] = bflo(w.z); f[5] = bfhi(w.z); f[6] = bflo(w.w); f[7] = bfhi(w.w); }
__device__ __forceinline__ void conv_phase(const Args& a, int G, int tid) {
    unsigned char* ws = a.ws;
    const bf16* Bc = (const bf16*)(ws + WS_BC); const bf16* Vc = (const bf16*)(ws + WS_VC); bf16* Yc = (bf16*)(ws + WS_YC);
    const float* vm = (const float*)(ws + WS_MISC + MS_VM); const float* cw = a.in[4];
    const int cg = tid & 127, strip = tid >> 7, ch0 = cg * 8;
    float w0[8], w1[8], w2[8];
#pragma unroll
    for (int e = 0; e < 8; ++e) { w0[e] = cw[ch0 + e]; w1[e] = cw[D + ch0 + e]; w2[e] = cw[2 * D + ch0 + e]; }
    for (int blk = blockIdx.x; blk < M / 128; blk += G) {
        const int r0 = blk * 128 + strip * 32;
        float p2[8], p1[8];
        if ((r0 & (SEQ - 1)) == 0) {
#pragma unroll
            for (int e = 0; e < 8; ++e) { p2[e] = vm[14 * D + ch0 + e]; p1[e] = vm[15 * D + ch0 + e]; }
        } else { unpack8(*(const u32x4*)(Vc + (size_t)(r0 - 2) * D + ch0), p2); unpack8(*(const u32x4*)(Vc + (size_t)(r0 - 1) * D + ch0), p1); }
#if CONV_BATCH
        const GAS char* vp = (const GAS char*)Vc + ((size_t)r0 * D + ch0) * 2; const GAS char* bp = (const GAS char*)Bc + ((size_t)r0 * D + ch0) * 2; GAS char* yp = (GAS char*)Yc + ((size_t)r0 * D + ch0) * 2;
        u32x4 vq[2][8], bq[2][8];
#pragma unroll
        for (int i = 0; i < 8; ++i) { vq[0][i] = *(const GAS u32x4*)(vp + i * (D * 2)); bq[0][i] = *(const GAS u32x4*)(bp + i * (D * 2)); }
#pragma unroll
        for (int bt = 0; bt < 4; ++bt) {
            if (bt + 1 < 4) {
#pragma unroll
                for (int i = 0; i < 8; ++i) { vq[(bt + 1) & 1][i] = *(const GAS u32x4*)(vp + ((bt + 1) * 8 + i) * (D * 2)); bq[(bt + 1) & 1][i] = *(const GAS u32x4*)(bp + ((bt + 1) * 8 + i) * (D * 2)); }
            }
#pragma unroll
            for (int i = 0; i < 8; ++i) {
                float v[8], b[8]; unpack8(vq[bt & 1][i], v); unpack8(bq[bt & 1][i], b);
                float y[8];
#pragma unroll
                for (int e = 0; e < 8; ++e) { y[e] = b[e] * (w0[e] * p2[e] + w1[e] * p1[e] + w2[e] * v[e]); p2[e] = p1[e]; p1[e] = v[e]; }
                u32x4 o; o.x = cvt_pk_bf16(y[0], y[1]); o.y = cvt_pk_bf16(y[2], y[3]); o.z = cvt_pk_bf16(y[4], y[5]); o.w = cvt_pk_bf16(y[6], y[7]);
                if (YC_NT) __builtin_nontemporal_store(o, (GAS u32x4*)(yp + (bt * 8 + i) * (D * 2))); else *(GAS u32x4*)(yp + (bt * 8 + i) * (D * 2)) = o;
            }
        }
    }
#else
#pragma unroll 4
        for (int rr = 0; rr < 32; ++rr) {
            const size_t off = (size_t)(r0 + rr) * D + ch0;
            float v[8], b[8]; unpack8(*(const u32x4*)(Vc + off), v); unpack8(*(const u32x4*)(Bc + off), b);
            float y[8];
#pragma unroll
            for (int e = 0; e < 8; ++e) { y[e] = b[e] * (w0[e] * p2[e] + w1[e] * p1[e] + w2[e] * v[e]); p2[e] = p1[e]; p1[e] = v[e]; }
            u32x4 o; o.x = cvt_pk_bf16(y[0], y[1]); o.y = cvt_pk_bf16(y[2], y[3]); o.z = cvt_pk_bf16(y[4], y[5]); o.w = cvt_pk_bf16(y[6], y[7]);
            __builtin_nontemporal_store(o, (u32x4*)(Yc + off));
        }
    }
#endif
    if (blockIdx.x == (unsigned)(G - 1)) {
        const float* bm = (const float*)(ws + WS_MISC + MS_BM); bf16* ycm = (bf16*)(ws + WS_MISC + MS_YCM);
        for (int idx = tid; idx < NMETA * D; idx += NWAVES * 64) {
            const int i = idx >> 10, ch = idx & (D - 1);
            const float v0 = i >= 2 ? vm[(i - 2) * D + ch] : 0.f, v1 = i >= 1 ? vm[(i - 1) * D + ch] : 0.f, v2 = vm[i * D + ch];
            ycm[idx] = (bf16)f2bf(bm[idx] * (cw[ch] * v0 + cw[D + ch] * v1 + cw[2 * D + ch] * v2));
        }
    }
}

constexpr int KIMG_ROW = 144, AT_NSLOT = 3, KIMG_BYTES = AT_NSLOT * 128 * KIMG_ROW, VT_ROW = AT_NSLOT * 128 * 2 + 8, VT_BYTES = 64 * VT_ROW;
static_assert(KIMG_BYTES + VT_BYTES <= RING_BYTES, "attention LDS");
constexpr int QPRE_N = 2;
template <int QI, bool FIRST>
__device__ __forceinline__ void attn_qgroup(const LAS unsigned char* kimg, const LAS unsigned char* vimg, int pbase, int cbase, const bf16x8 (&qf)[4], bf16x8 (&qpre)[4], const bf16* qn, bf16* Og, float sk, int lane) {
    const int q = lane & 31, h = lane >> 5;
    f32x16 S[5];
#pragma unroll
    for (int bi = 0; bi < 5; ++bi) S[bi] = (f32x16){};
#pragma unroll
    for (int s = 0; s < 4; ++s)
#pragma unroll
        for (int bi = 0; bi < 5; ++bi) {
            const int rowbase = (bi < 4 - QI) ? pbase + 32 * (QI + bi) : cbase + 32 * (bi - (4 - QI));
            const bf16x8 kf = *(const LAS bf16x8*)(kimg + (rowbase + q) * KIMG_ROW + (16 * s + 8 * h) * 2);
            S[bi] = __builtin_amdgcn_mfma_f32_32x32x16_bf16(kf, qf[s], S[bi], 0, 0, 0);
        }
    if (QI & 1) {
#pragma unroll
        for (int s = 0; s < QPRE_N; ++s) qpre[s] = *(const GAS bf16x8*)(qn + 16 * s);
    }
    int tq = q - 4 * h; asm volatile("" : "+v"(tq));
    float mx = sk;
#pragma unroll
    for (int bi = 0; bi < 5; ++bi) {
        const bool prev = bi < 4 - QI; const int kb = prev ? QI + bi : bi - (4 - QI);
#pragma unroll
        for (int r = 0; r < 16; ++r) {
            const int cr = (r & 3) + 8 * (r >> 2);
            float sv = S[bi][r];
            if (prev) {
                if (FIRST) { if (kb < 3) sv = -INFINITY; else { if (!(cr + 4 * h >= 16)) sv = -INFINITY; if (kb == QI && !(cr > tq)) sv = -INFINITY; } }
                else if (kb == QI) { if (!(cr > tq)) sv = -INFINITY; }
            } else if (kb == QI) { if (!(cr <= tq)) sv = -INFINITY; }
            S[bi][r] = sv; mx = fmaxf(mx, sv);
        }
    }
    mx = fmaxf(mx, __shfl_xor(mx, 32));
    float l = 0.f;
#pragma unroll
    for (int bi = 0; bi < 5; ++bi)
#pragma unroll
        for (int r = 0; r < 16; ++r) { const float p = __builtin_amdgcn_exp2f(S[bi][r] - mx); S[bi][r] = p; l += p; }
    l += __shfl_xor(l, 32); l += __builtin_amdgcn_exp2f(sk - mx);
    f32x16 O[2][2];
#pragma unroll
    for (int c = 0; c < 2; ++c) { O[c][0] = (f32x16){}; O[c][1] = (f32x16){}; }
#pragma unroll
    for (int bi = 0; bi < 5; ++bi) {
        const int rowbase = (bi < 4 - QI) ? pbase + 32 * (QI + bi) : cbase + 32 * (bi - (4 - QI));
#pragma unroll
        for (int s2 = 0; s2 < 2; ++s2) {
            u32x4 pw; pw.x = cvt_pk_bf16(S[bi][8 * s2 + 0], S[bi][8 * s2 + 1]); pw.y = cvt_pk_bf16(S[bi][8 * s2 + 2], S[bi][8 * s2 + 3]);
            pw.z = cvt_pk_bf16(S[bi][8 * s2 + 4], S[bi][8 * s2 + 5]); pw.w = cvt_pk_bf16(S[bi][8 * s2 + 6], S[bi][8 * s2 + 7]);
            const bf16x8 pf = __builtin_bit_cast(bf16x8, pw);
#pragma unroll
            for (int c = 0; c < 2; ++c) {
                const LAS unsigned char* vp = vimg + (32 * c + q) * VT_ROW + (rowbase + 16 * s2 + 4 * h) * 2;
                const u32x2 lo = *(const LAS u32x2*)vp, hi = *(const LAS u32x2*)(vp + 16);
                const u32x4 vw = (u32x4){lo.x, lo.y, hi.x, hi.y};
                O[c][s2] = __builtin_amdgcn_mfma_f32_32x32x16_bf16(__builtin_bit_cast(bf16x8, vw), pf, O[c][s2], 0, 0, 0);
            }
        }
    }
    const float inv = __builtin_amdgcn_rcpf(l);
    bf16* orow = Og + (size_t)(32 * QI + q) * D;
#pragma unroll
    for (int c = 0; c < 2; ++c)
#pragma unroll
        for (int u4 = 0; u4 < 4; ++u4) {
            u32x2 w; w.x = cvt_pk_bf16((O[c][0][4 * u4 + 0] + O[c][1][4 * u4 + 0]) * inv, (O[c][0][4 * u4 + 1] + O[c][1][4 * u4 + 1]) * inv);
            w.y = cvt_pk_bf16((O[c][0][4 * u4 + 2] + O[c][1][4 * u4 + 2]) * inv, (O[c][0][4 * u4 + 3] + O[c][1][4 * u4 + 3]) * inv);
            *(u32x2*)(orow + 32 * c + 8 * u4 + 4 * h) = w;
        }
}
__device__ __forceinline__ void attn_load_block(const bf16* Kb, const bf16* Vb, const bf16* Km, const bf16* Vm, int b, int kvh, int jb, int tid, u32x4 (&kv)[2], u32x4 (&vv)[2]) {
#pragma unroll
    for (int ii = 0; ii < 2; ++ii) {
        const int c = tid + 512 * ii, row = c >> 3, ch = c & 7;
        kv[ii] = (u32x4){0u, 0u, 0u, 0u}; vv[ii] = (u32x4){0u, 0u, 0u, 0u};
        if (jb >= 0) { const size_t off = (size_t)(b * SEQ + 128 * jb + row) * KVD + kvh * HD + ch * 8; kv[ii] = *(const u32x4*)(Kb + off); vv[ii] = *(const u32x4*)(Vb + off); }
        else if (row >= 112) { const size_t off = (size_t)(row - 112) * KVD + kvh * HD + ch * 8; kv[ii] = *(const u32x4*)(Km + off); vv[ii] = *(const u32x4*)(Vm + off); }
    }
}
__device__ __forceinline__ void attn_store_block(LAS unsigned char* kimg, LAS unsigned char* vimg, int slot, int tid, const u32x4 (&kv)[2], const u32x4 (&vv)[2]) {
#pragma unroll
    for (int ii = 0; ii < 2; ++ii) {
        const int c = tid + 512 * ii, row = slot * 128 + (c >> 3), ch = c & 7;
        *(LAS u32x4*)(kimg + row * KIMG_ROW + ch * 16) = kv[ii];
        LAS unsigned short* vt = (LAS unsigned short*)(vimg + (ch * 8) * VT_ROW + row * 2);
        vt[0 * (VT_ROW / 2)] = (unsigned short)(vv[ii].x & 0xffffu); vt[1 * (VT_ROW / 2)] = (unsigned short)(vv[ii].x >> 16);
        vt[2 * (VT_ROW / 2)] = (unsigned short)(vv[ii].y & 0xffffu); vt[3 * (VT_ROW / 2)] = (unsigned short)(vv[ii].y >> 16);
        vt[4 * (VT_ROW / 2)] = (unsigned short)(vv[ii].z & 0xffffu); vt[5 * (VT_ROW / 2)] = (unsigned short)(vv[ii].z >> 16);
        vt[6 * (VT_ROW / 2)] = (unsigned short)(vv[ii].w & 0xffffu); vt[7 * (VT_ROW / 2)] = (unsigned short)(vv[ii].w >> 16);
    }
}
__device__ __forceinline__ void attn_phase(const Args& a, LAS unsigned char* lds, int vcu, int G, int tid, int wave, int lane) {
    unsigned char* ws = a.ws;
    const bf16* Q = (const bf16*)(ws + WS_Q); const bf16* Kb = (const bf16*)(ws + WS_KB); const bf16* Vb = (const bf16*)(ws + WS_VB);
    const bf16* Km = (const bf16*)(ws + WS_MISC + MS_KM); const bf16* Vm = (const bf16*)(ws + WS_MISC + MS_VMETA);
    LAS unsigned char* kimg = lds; LAS unsigned char* vimg = lds + KIMG_BYTES;
    constexpr int NUNITS = BATCH * NKVH * (SEQ / 128);
    const int per = (NUNITS + G - 1) / G;
    const int g = wave >> 1, half = wave & 1, q = lane & 31, h = lane >> 5;
    bf16x8 qf[2][4];
    for (int i = 0; i < per; ++i) {
        const int uid = vcu * per + i; if (uid >= NUNITS) break;
        const int b = uid >> 8, kvh = (uid >> 6) & 3, j = uid & 63; const int Rb = b * SEQ + 128 * j;
        const int hq = kvh * 4 + g;
#pragma unroll
        for (int qg = 0; qg < 2; ++qg) {
#pragma unroll
            for (int s = 0; s < 4; ++s) if (!(qg == 0 && i != 0 && s < QPRE_N)) qf[qg][s] = *(const GAS bf16x8*)(Q + (size_t)(Rb + 64 * half + 32 * qg + q) * D + hq * HD + 16 * s + 8 * h); }
        const bf16* qn;
        { const int un = (i + 1 < per && uid + 1 < NUNITS) ? uid + 1 : uid; const int bn = un >> 8, kvhn = (un >> 6) & 3, jn = un & 63;
          qn = Q + (size_t)(bn * SEQ + 128 * jn + 64 * half + q) * D + (kvhn * 4 + g) * HD + 8 * h; }
        const bool fresh = (i == 0) || (j == 0);
        if (fresh) {
            __syncthreads();
            u32x4 kv[2], vv[2], kv2[2], vv2[2];
            attn_load_block(Kb, Vb, Km, Vm, b, kvh, j - 1, tid, kv, vv); attn_load_block(Kb, Vb, Km, Vm, b, kvh, j, tid, kv2, vv2);
            attn_store_block(kimg, vimg, (j + 2) % 3, tid, kv, vv);      attn_store_block(kimg, vimg, j % 3, tid, kv2, vv2);
        }
        __syncthreads();
        const bool pre = (i + 1 < per) && (uid + 1 < NUNITS) && (j + 1 < 64);
        u32x4 nk[2], nv[2];
        if (pre) attn_load_block(Kb, Vb, Km, Vm, b, kvh, j + 1, tid, nk, nv);
        const float sk = a.in[13][hq] * LOG2E;
        bf16* Og = (bf16*)(ws + WS_O) + (size_t)Rb * D + hq * HD;
        const int pbase = ((j + 2) % 3) * 128, cbase = (j % 3) * 128;
        if (j != 0) {
            if (half == 0) { attn_qgroup<0, false>(kimg, vimg, pbase, cbase, qf[0], qf[0], qn, Og, sk, lane); attn_qgroup<1, false>(kimg, vimg, pbase, cbase, qf[1], qf[0], qn, Og, sk, lane); }
            else           { attn_qgroup<2, false>(kimg, vimg, pbase, cbase, qf[0], qf[0], qn, Og, sk, lane); attn_qgroup<3, false>(kimg, vimg, pbase, cbase, qf[1], qf[0], qn, Og, sk, lane); }
        } else {
            if (half == 0) { attn_qgroup<0, true>(kimg, vimg, pbase, cbase, qf[0], qf[0], qn, Og, sk, lane); attn_qgroup<1, true>(kimg, vimg, pbase, cbase, qf[1], qf[0], qn, Og, sk, lane); }
            else           { attn_qgroup<2, true>(kimg, vimg, pbase, cbase, qf[0], qf[0], qn, Og, sk, lane); attn_qgroup<3, true>(kimg, vimg, pbase, cbase, qf[1], qf[0], qn, Og, sk, lane); }
        }
        if (pre) attn_store_block(kimg, vimg, (j + 1) % 3, tid, nk, nv);
    }
    __syncthreads();
}

__device__ __forceinline__ void route_phase(const Args& a, LAS unsigned char* lds, unsigned* ctl, int G, int tid, int wave, int lane) {
    unsigned char* ws = a.ws;
    LAS float* wr_l = (LAS float*)lds;
    LAS int* cntL = (LAS int*)(lds + 32768); LAS int* baseL = (LAS int*)(lds + 32768 + 64);
    const float* Wr = a.in[16]; const float* gm = a.in[15];
    for (int idx = tid; idx < NE * D; idx += NWAVES * 64) { const int e = idx >> 10, k = idx & (D - 1); wr_l[idx] = Wr[k * NE + e] * gm[k]; }
    const bf16* hsrc = (const bf16*)(ws + WS_HB);
    unsigned char* xq = ws + WS_XQ;
    int* list = (int*)(ws + WS_LIST); u32x2* tokep = (u32x2*)(ws + WS_TOKEP); f32x2* tokg = (f32x2*)(ws + WS_TOKG);
    for (int blk = blockIdx.x; blk < M / 128; blk += G) {
        __syncthreads();
        if (tid < 8) cntL[tid] = 0;
        __syncthreads();
        int my_e1 = -1, my_e2 = -1; float my_g1 = 0.f, my_g2 = 0.f;
        const int rbase = blk * 128 + wave * 16;
        constexpr int RB = 2;
        u32x2 nx[RB][4];
#pragma unroll
        for (int q = 0; q < RB; ++q)
#pragma unroll
            for (int j = 0; j < 4; ++j) nx[q][j] = *(const GAS u32x2*)(hsrc + (size_t)(rbase + q) * D + 4 * lane + 256 * j);
        for (int jj0 = 0; jj0 < 16; jj0 += RB) {
            f32x4 hv[RB][4]; float s[RB], d[RB][8];
#pragma unroll
            for (int q = 0; q < RB; ++q) { s[q] = 0.f;
#pragma unroll
                for (int j = 0; j < 4; ++j) { const u32x2 w = nx[q][j]; hv[q][j] = (f32x4){bflo(w.x), bfhi(w.x), bflo(w.y), bfhi(w.y)};
                    s[q] += (hv[q][j].x * hv[q][j].x + hv[q][j].y * hv[q][j].y) + (hv[q][j].z * hv[q][j].z + hv[q][j].w * hv[q][j].w); } }
            { const int jn = jj0 + RB < 16 ? jj0 + RB : jj0;
#pragma unroll
              for (int q = 0; q < RB; ++q)
#pragma unroll
                  for (int j = 0; j < 4; ++j) nx[q][j] = *(const GAS u32x2*)(hsrc + (size_t)(rbase + jn + q) * D + 4 * lane + 256 * j); }
#pragma unroll
            for (int e = 0; e < 8; ++e) {
#pragma unroll
                for (int q = 0; q < RB; ++q) d[q][e] = 0.f;
#pragma unroll
                for (int j = 0; j < 4; ++j) { const f32x4 w = *(const LAS f32x4*)(wr_l + e * D + 4 * lane + 256 * j);
#pragma unroll
                    for (int q = 0; q < RB; ++q) d[q][e] += (hv[q][j].x * w.x + hv[q][j].y * w.y) + (hv[q][j].z * w.z + hv[q][j].w * w.w); } }
#pragma unroll
            for (int o = 1; o < 64; o <<= 1) {
#pragma unroll
                for (int q = 0; q < RB; ++q) { s[q] += __shfl_xor(s[q], o);
#pragma unroll
                    for (int e = 0; e < 8; ++e) d[q][e] += __shfl_xor(d[q][e], o); } }
#pragma unroll
            for (int q = 0; q < RB; ++q) {
                const int jj = jj0 + q;
                const float rstd = 1.0f / sqrtf(s[q] * (1.0f / (float)D) + RMS_EPS);
                { const float sc = rstd * XQ_SCALE; unsigned char* xr = xq + (size_t)(rbase + jj) * D + 4 * lane;
#pragma unroll
                  for (int j = 0; j < 4; ++j) *(unsigned*)(xr + 256 * j) = pk4_fp8(hv[q][j].x * sc, hv[q][j].y * sc, hv[q][j].z * sc, hv[q][j].w * sc); }
                float lg[8];
#pragma unroll
                for (int e = 0; e < 8; ++e) lg[e] = d[q][e] * rstd;
                int e1 = 0; float v1 = lg[0];
#pragma unroll
                for (int e = 1; e < 8; ++e) if (lg[e] > v1) { v1 = lg[e]; e1 = e; }
                int e2 = -1; float v2 = -INFINITY;
#pragma unroll
                for (int e = 0; e < 8; ++e) if (e != e1 && lg[e] > v2) { v2 = lg[e]; e2 = e; }
                const float g1 = 1.0f / (1.0f + expf(v2 - v1));
                if (lane == jj) { my_e1 = e1; my_e2 = e2; my_g1 = g1; my_g2 = 1.0f - g1; }
            }
        }
        unsigned long long mk[8]; int wb = 0;
#pragma unroll
        for (int e = 0; e < 8; ++e) { mk[e] = __ballot(my_e1 == e || my_e2 == e); if (lane == e) wb = __popcll(mk[e]); }
        if (lane < 8) wb = atomicAdd((int*)(cntL + lane), wb);
        __syncthreads();
        if (tid < 8) baseL[tid] = (int)__hip_atomic_fetch_add(ctl + CW_CNT + 64 * tid, (unsigned)cntL[tid], RLX_AGENT);
        __syncthreads();
        {
            int pos1 = 0, pos2 = 0;
#pragma unroll
            for (int e = 0; e < 8; ++e) {
                const int wbe = __shfl(wb, e); const int p = baseL[e] + wbe + __popcll(mk[e] & ((1ull << lane) - 1ull));
                if (my_e1 == e) pos1 = p; if (my_e2 == e) pos2 = p;
            }
            if (lane < 16) {
                const int tok = rbase + lane;
                list[(size_t)my_e1 * M + pos1] = tok; list[(size_t)my_e2 * M + pos2] = tok;
                tokep[tok] = (u32x2){((unsigned)my_e1 << 28) | (unsigned)pos1, ((unsigned)my_e2 << 28) | (unsigned)pos2};
                tokg[tok] = (f32x2){my_g1, my_g2};
            }
        }
    }
    __syncthreads();
}

__device__ __forceinline__ void unpack8_fp8(const u32x2 w, float (&f)[8]) {
    const f32x2 a = __builtin_amdgcn_cvt_pk_f32_fp8((int)w.x, false), b = __builtin_amdgcn_cvt_pk_f32_fp8((int)w.x, true), c = __builtin_amdgcn_cvt_pk_f32_fp8((int)w.y, false), d = __builtin_amdgcn_cvt_pk_f32_fp8((int)w.y, true);
    f[0] = a.x; f[1] = a.y; f[2] = b.x; f[3] = b.y; f[4] = c.x; f[5] = c.y; f[6] = d.x; f[7] = d.y;
}
__device__ __forceinline__ void final_y_tail(const bf16* YP, size_t s, int k, float (&y)[8]) {
    const int T = (int)(s >> 8);
    const bf16* p = YP + ((size_t)((T - DOWN_MAIN_TILES) * 4 + (k >> 8)) * DOWN_KS) * 65536 + (size_t)(s & 255) * 256 + (k & 255);
#pragma unroll
    for (int e = 0; e < 8; ++e) y[e] = 0.f;
#pragma unroll
    for (int ks = 0; ks < DOWN_KS; ++ks) { float t[8]; unpack8(*(const u32x4*)(p + (size_t)ks * 65536), t);
#pragma unroll
        for (int e = 0; e < 8; ++e) y[e] += t[e]; }
}
__device__ __forceinline__ void final_phase(const Args& a, unsigned* ctl, int vcu, int G, int wave, int lane) {
    unsigned char* ws = a.ws;
    MoeInfo mi; moe_info_load(ctl, mi);
    const bf16* hb = (const bf16*)(ws + WS_HB); const unsigned char* Y = ws + WS_Y; const bf16* YP = (const bf16*)(ws + WS_YP);
    const u32x2* tokep = (const u32x2*)(ws + WS_TOKEP); const f32x2* tokg = (const f32x2*)(ws + WS_TOKG); const float* gf = a.in[20];
    const int gw = vcu * NWAVES + wave, NGW = G * NWAVES;
    float gfv[16];
#pragma unroll
    for (int j = 0; j < 2; ++j)
#pragma unroll
        for (int e = 0; e < 8; ++e) gfv[j * 8 + e] = gf[8 * lane + 512 * j + e];
    constexpr int RB = 4;
    u32x2 epn[RB]; f32x2 gn[RB];
#pragma unroll
    for (int q = 0; q < RB; ++q) { const int r = gw + q * NGW < M ? gw + q * NGW : gw; epn[q] = ((const GAS u32x2*)tokep)[r]; gn[q] = ((const GAS f32x2*)tokg)[r]; }
    for (int r0 = gw; r0 < M; r0 += RB * NGW) {
        u32x2 ep[RB]; f32x2 g[RB]; size_t s1[RB], s2[RB]; u32x4 wh[RB][2]; u32x2 w1[RB][2], w2[RB][2];
#pragma unroll
        for (int q = 0; q < RB; ++q) { ep[q] = epn[q]; g[q] = gn[q] * (1.0f / (HQ_SCALE * WD_SCALE)); }
#pragma unroll
        for (int q = 0; q < RB; ++q) {
            const int r = r0 + q * NGW < M ? r0 + q * NGW : r0;
            int ts1 = 0, ts2 = 0; const int e1 = (int)(ep[q].x >> 28), e2 = (int)(ep[q].y >> 28);
#pragma unroll
            for (int e = 0; e < 8; ++e) { if (e1 == e) ts1 = mi.ts[e]; if (e2 == e) ts2 = mi.ts[e]; }
            s1[q] = (size_t)ts1 * 256 + (ep[q].x & 0x0fffffffu); s2[q] = (size_t)ts2 * 256 + (ep[q].y & 0x0fffffffu);
#pragma unroll
            for (int j = 0; j < 2; ++j) { const int k = 8 * lane + 512 * j;
                wh[q][j] = *(const u32x4*)(hb + (size_t)r * D + k); w1[q][j] = *(const u32x2*)(Y + s1[q] * D + k); w2[q][j] = *(const u32x2*)(Y + s2[q] * D + k); }
        }
        { const int rn0 = r0 + RB * NGW;
#pragma unroll
          for (int q = 0; q < RB; ++q) { const int r = rn0 + q * NGW < M ? rn0 + q * NGW : gw; epn[q] = ((const GAS u32x2*)tokep)[r]; gn[q] = ((const GAS f32x2*)tokg)[r]; } }
#pragma unroll
        for (int q = 0; q < RB; ++q) {
            const int r = r0 + q * NGW; if (r >= M) break;
            const bool t1 = (s1[q] >> 8) >= (size_t)DOWN_MAIN_TILES, t2 = (s2[q] >> 8) >= (size_t)DOWN_MAIN_TILES;
            float v[16]; float s = 0.f;
#pragma unroll
            for (int j = 0; j < 2; ++j) {
                const int k = 8 * lane + 512 * j; float hf[8], y1[8], y2[8];
                unpack8(wh[q][j], hf); unpack8_fp8(w1[q][j], y1); unpack8_fp8(w2[q][j], y2);
                if (t1) final_y_tail(YP, s1[q], k, y1);
                if (t2) final_y_tail(YP, s2[q], k, y2);
#pragma unroll
                for (int e = 0; e < 8; ++e) { const float t = hf[e] + g[q].x * y1[e] + g[q].y * y2[e]; v[j * 8 + e] = t; s += t * t; }
            }
            s = wave_sum(s); const float rstd = 1.0f / sqrtf(s * (1.0f / (float)D) + RMS_EPS);
#pragma unroll
            for (int j = 0; j < 2; ++j) {
                float* o = a.out + (size_t)r * D + 8 * lane + 512 * j;
                *(f32x4*)o = (f32x4){v[j * 8 + 0] * rstd * gfv[j * 8 + 0], v[j * 8 + 1] * rstd * gfv[j * 8 + 1], v[j * 8 + 2] * rstd * gfv[j * 8 + 2], v[j * 8 + 3] * rstd * gfv[j * 8 + 3]};
                *(f32x4*)(o + 4) = (f32x4){v[j * 8 + 4] * rstd * gfv[j * 8 + 4], v[j * 8 + 5] * rstd * gfv[j * 8 + 5], v[j * 8 + 6] * rstd * gfv[j * 8 + 6], v[j * 8 + 7] * rstd * gfv[j * 8 + 7]};
            }
        }
    }
}

constexpr int N_PHASES = 13;
#ifndef REP_P0
#define REP_P0 1
#endif
#ifndef REP_P4
#define REP_P4 1
#endif
#ifndef REP_MOE
#define REP_MOE 1
#endif
#ifndef REP_EW
#define REP_EW 1
#endif
#ifndef REP_CONV
#define REP_CONV 1
#endif
#ifndef REP_QKV
#define REP_QKV 1
#endif
#ifndef REP_ATT
#define REP_ATT 1
#endif
__global__ void __launch_bounds__(NWAVES * 64, 2) fwd_kernel(Args args) {
    extern __shared__ __attribute__((aligned(16))) unsigned char lds_raw[];
    LAS unsigned char* lds = (LAS unsigned char*)lds_raw;
    volatile LAS unsigned* MISC = (volatile LAS unsigned*)(lds + MISC_OFF);
    const int wave = __builtin_amdgcn_readfirstlane((int)threadIdx.x >> 6);
#define lane hw_lane()
#define tid (wave * 64 + hw_lane())
    const int G = gridDim.x; const int bx = blockIdx.x; const int vcu = (G % 8 == 0) ? (bx % 8) * (G / 8) + bx / 8 : bx;
    unsigned char* ws = args.ws;
    unsigned* ctl = (unsigned*)(ws + WS_CTL);
    for (int u = (int)threadIdx.x; u < (LDS_BYTES - LDSCTL_OFF) / 4; u += NWAVES * 64) ((LAS unsigned*)(lds + LDSCTL_OFF))[u] = 0u;
    __syncthreads();
#if !MULTI_LAUNCH
    XcdBarrier bar = xcd_barrier_post(ctl + CW_BAR, MISC + 8, wave);
#define GRID_BAR() xcd_barrier(bar, wave)
#else
#define GRID_BAR() do { } while (0)
#endif
    const int lo = args.ph_lo, hi = args.ph_hi;
#define IN(k) (lo <= (k) && (k) < hi)
#define SEAM(k) do { if (IN(k) && IN((k) + 1)) GRID_BAR(); } while (0)
    unsigned char* misc = ws + WS_MISC;
    const float* ssq = (const float*)(ws + WS_SSQ);

    if (IN(0)) { for (int rep = 0; rep < REP_P0; ++rep) { p0_prologue(args, lds, vcu, G, wave, lane); SEAM(0); } }

    if (IN(1)) {
        typedef pg8::DenseSched<M / 256, NCONV / 256> DS; DS S{(const char*)(ws + WS_HB), (const char*)(ws + WS_WIN), 2 * D, G, bx};
        LAS float* rtab = (LAS float*)(lds + pg8::RSTD_TAB_OFF);
        auto pre = [&]() {
            if (bx < 96) {
                const float* ms0 = (const float*)(misc + MS_SSQ0); float* bm = (float*)(misc + MS_BM); float* vm = (float*)(misc + MS_VM);
                int n0, n1, vch = -1; if (bx < 32) { n0 = 32 * bx; n1 = n0 + 16; } else { const int j2 = bx - 32; n0 = D + 256 * (j2 >> 3) + 16 * (j2 & 7); n1 = n0 + 128; vch = 128 * (j2 >> 3) + 16 * (j2 & 7); }
                meta_dual(lds, (const bf16*)(misc + MS_MB), D, (const bf16*)(ws + WS_WIN), n0, n1, lane, wave, [&](const f32x4& a0, const f32x4& a1, int r16, int kq) {
    #pragma unroll
                    for (int g = 0; g < 4; ++g) { const int i = 4 * kq + g; const float r = 1.0f / sqrtf(ms0[i] * (1.0f / (float)D) + RMS_EPS);
                        if (vch < 0) { bm[i * D + n0 + r16] = a0[g] * r; bm[i * D + n1 + r16] = a1[g] * r; } else vm[i * D + vch + r16] = (a0[g] * r) * (a1[g] * r); } });
            }
            __syncthreads(); pg8::rstd_table_fill(S, ssq, rtab, tid); __syncthreads();
        };
        pg8::EpiConvIn E{(bf16*)(ws + WS_BC), (bf16*)(ws + WS_VC), rtab};
        ExpertCvtBg bg{args.in[17], args.in[18], args.in[19], args.in[15], ws, EXP_ITEMS - bg_cover(G), 0, BG_P1, bx * NWAVES + wave, G * NWAVES, {}, {}, {}, nullptr, 0u, 0, 0.f, false};
#if BG_CVT
        pg8::gemm_phase<pg8::EpiConvIn, DS, true>(lds, S, E, wave, pre, bg);
#else
        (void)bg; pg8::gemm_phase<pg8::EpiConvIn, DS, true>(lds, S, E, wave, pre);
#endif
        SEAM(1);
    }
    if (IN(2)) { for (int rep = 0; rep < REP_CONV; ++rep) { conv_phase(args, G, tid); SEAM(2); } }

    if (IN(3)) {
        typedef pg8::DenseSched<M / 256, D / 256> DS; DS S{(const char*)(ws + WS_YC), (const char*)(ws + WS_WOUT), 2 * D, G, bx};
        auto pre = [&]() {
            if (bx < 32) {
                const float* meta = args.in[1]; float* hm = (float*)(misc + MS_HM); bf16* hmb = (bf16*)(misc + MS_HMB); float* p1 = (float*)(misc + MS_SSQ1);
                const int n0 = 32 * bx, n1 = n0 + 16;
                meta_dual(lds, (const bf16*)(misc + MS_YCM), D, (const bf16*)(ws + WS_WOUT), n0, n1, lane, wave, [&](const f32x4& a0, const f32x4& a1, int r16, int kq) {
    #pragma unroll
                    for (int g = 0; g < 4; ++g) { const int i = 4 * kq + g; const float v0 = meta[i * D + n0 + r16] + a0[g], v1 = meta[i * D + n1 + r16] + a1[g];
                        hm[i * D + n0 + r16] = v0; hm[i * D + n1 + r16] = v1; hmb[i * D + n0 + r16] = (bf16)f2bf(v0); hmb[i * D + n1 + r16] = (bf16)f2bf(v1);
                        float q = v0 * v0 + v1 * v1; q += __shfl_xor(q, 1); q += __shfl_xor(q, 2); q += __shfl_xor(q, 4); q += __shfl_xor(q, 8);
                        if (r16 == 0) p1[bx * 16 + i] = q; } });
            }
        };
        pg8::EpiResidT<FFN8 != 0> E{(bf16*)(ws + WS_HB), (float*)(ws + WS_SSQ), 1.0f, ws + WS_XQ};
        pg8::gemm_phase<pg8::EpiResidT<FFN8 != 0>, DS, true>(lds, S, E, wave, pre);
        SEAM(3);
    }
    if (IN(4)) for (int rep = 0; rep < REP_P4; ++rep) {
#if FFN8
        typedef pg8::DenseSched<M / 256, NGU / 256, true> DS; DS S{(const char*)(ws + WS_XQ), (const char*)(ws + WS_WGU8), D, G, bx};
#else
        typedef pg8::DenseSched<M / 256, NGU / 256> DS; DS S{(const char*)(ws + WS_HB), (const char*)(ws + WS_WGU), 2 * D, G, bx};
#endif
        LAS float* rtab = (LAS float*)(lds + pg8::RSTD_TAB_OFF);
        auto pre = [&]() {
            if (bx < 224) {
                const f32x4 rs = meta_rstd_parts((const float*)(misc + MS_SSQ1), lane); bf16* hdm = (bf16*)(misc + MS_HDM);
                const int n0 = 256 * (bx >> 3) + 16 * (bx & 7), n1 = n0 + 128, hch = 128 * (bx >> 3) + 16 * (bx & 7);
                meta_dual(lds, (const bf16*)(misc + MS_HMB), D, (const bf16*)(ws + WS_WGU), n0, n1, lane, wave, [&](const f32x4& a0, const f32x4& a1, int r16, int kq) {
    #pragma unroll
                    for (int g = 0; g < 4; ++g) { const int i = 4 * kq + g; hdm[i * DFF + hch + r16] = (bf16)f2bf(pg8::silu_mul(a0[g] * rs[g], a1[g] * rs[g])); } });
            }
            __syncthreads(); pg8::rstd_table_fill(S, ssq, rtab, tid); __syncthreads();
        };
#if FFN8
        typedef pg8::EpiSwiGLU8T<FFN8 == 1> EPI4; EPI4 E{ws + WS_HD, rtab};
#else
        typedef pg8::EpiSwiGLU EPI4; EPI4 E{(bf16*)(ws + WS_HD), rtab};
#endif
        ExpertCvtBg bg{args.in[17], args.in[18], args.in[19], args.in[15], ws, EXP_ITEMS - bg_cover(G), BG_P1, BG_P4, bx * NWAVES + wave, G * NWAVES, {}, {}, {}, nullptr, 0u, 0, 0.f, false};
#if BG_CVT
        pg8::gemm_phase<EPI4, DS, true>(lds, S, E, wave, pre, bg);
#else
        (void)bg; pg8::gemm_phase<EPI4, DS, true>(lds, S, E, wave, pre);
#endif
        SEAM(4);
    }
    if (IN(5)) {
#if FFN8 == 1
        typedef pg8::DenseSched<M / 256, D / 256, true> DS; DS S{(const char*)(ws + WS_HD), (const char*)(ws + WS_WD8), DFF, G, bx};
#else
        typedef pg8::DenseSched<M / 256, D / 256> DS; DS S{(const char*)(ws + WS_HD), (const char*)(ws + WS_WD), 2 * DFF, G, bx};
#endif
        auto pre = [&]() {
            if (bx < 32) {
                float* hm = (float*)(misc + MS_HM); bf16* hmb = (bf16*)(misc + MS_HMB); float* p2 = (float*)(misc + MS_SSQ2);
                const int n0 = 32 * bx, n1 = n0 + 16;
                meta_dual(lds, (const bf16*)(misc + MS_HDM), DFF, (const bf16*)(ws + WS_WD), n0, n1, lane, wave, [&](const f32x4& a0, const f32x4& a1, int r16, int kq) {
    #pragma unroll
                    for (int g = 0; g < 4; ++g) { const int i = 4 * kq + g; const float v0 = hm[i * D + n0 + r16] + a0[g], v1 = hm[i * D + n1 + r16] + a1[g];
                        hm[i * D + n0 + r16] = v0; hm[i * D + n1 + r16] = v1; hmb[i * D + n0 + r16] = (bf16)f2bf(v0); hmb[i * D + n1 + r16] = (bf16)f2bf(v1);
                        float q = v0 * v0 + v1 * v1; q += __shfl_xor(q, 1); q += __shfl_xor(q, 2); q += __shfl_xor(q, 4); q += __shfl_xor(q, 8);
                        if (r16 == 0) p2[bx * 16 + i] = q; } });
            }
        };
        typedef pg8::EpiResidT<false, FFN8 == 1> EPI5; EPI5 E{(bf16*)(ws + WS_HB), (float*)(ws + WS_SSQ), FFN8 == 1 ? 1.0f / (HDQ_SCALE * WD8_SCALE) : 1.0f, nullptr};
        pg8::gemm_phase<EPI5, DS, true>(lds, S, E, wave, pre);
        SEAM(5);
    }
    if (IN(6)) {
        typedef pg8::DenseSched<M / 256, NQKV / 256> DS; DS S{(const char*)(ws + WS_HB), (const char*)(ws + WS_WQKV), 2 * D, G, bx};
        LAS float* rtab = (LAS float*)(lds + pg8::RSTD_TAB_OFF);
        auto pre = [&]() {
            if (bx < 16) {
                const f32x4 rs = meta_rstd_parts((const float*)(misc + MS_SSQ2), lane); const float* bias = args.in[12]; const f32x2* rope = (const f32x2*)(ws + WS_ROPE);
                bf16* km = (bf16*)(misc + MS_KM); bf16* vmt = (bf16*)(misc + MS_VMETA);
                int n0, n1; if (bx < 8) { n0 = D + 32 * (bx >> 1) + 16 * (bx & 1); n1 = n0 + 128; } else { n0 = D + KVD + 32 * (bx - 8); n1 = n0 + 16; }
                meta_dual(lds, (const bf16*)(misc + MS_HMB), D, (const bf16*)(ws + WS_WQKV), n0, n1, lane, wave, [&](const f32x4& a0, const f32x4& a1, int r16, int kq) {
    #pragma unroll
                    for (int g = 0; g < 4; ++g) { const int i = 4 * kq + g;
                        if (bx < 8) { const int wc = bx >> 1, dlo = 16 * (bx & 1) + r16; const float lo_ = a0[g] * rs[g] + bias[D + 64 * wc + dlo], hi_ = a1[g] * rs[g] + bias[D + 64 * wc + dlo + 32];
                            const f32x2 cs = rope[i * 32 + dlo]; km[i * KVD + 64 * wc + dlo] = (bf16)f2bf(lo_ * cs.x - hi_ * cs.y); km[i * KVD + 64 * wc + dlo + 32] = (bf16)f2bf(hi_ * cs.x + lo_ * cs.y); }
                        else { const int c0 = n0 - (D + KVD) + r16; vmt[i * KVD + c0] = (bf16)f2bf(a0[g] * rs[g] + bias[n0 + r16]); vmt[i * KVD + c0 + 16] = (bf16)f2bf(a1[g] * rs[g] + bias[n1 + r16]); } } });
            }
            __syncthreads(); pg8::rstd_table_fill(S, ssq, rtab, tid); __syncthreads();
        };
        pg8::EpiQKV E{(bf16*)(ws + WS_Q), (bf16*)(ws + WS_KB), (bf16*)(ws + WS_VB), rtab, args.in[12], (const f32x2*)(ws + WS_ROPE)};
        for (int rep = 0; rep < REP_QKV; ++rep) { pg8::gemm_phase<pg8::EpiQKV, DS, true>(lds, S, E, wave, pre);
        SEAM(6); }
    }
    if (IN(7)) { for (int rep = 0; rep < REP_ATT; ++rep) { attn_phase(args, lds, vcu, G, tid, wave, lane); SEAM(7); } }

    if (IN(8)) {
        typedef pg8::DenseSched<M / 256, D / 256> DS; DS S{(const char*)(ws + WS_O), (const char*)(ws + WS_WO), 2 * D, G, bx};
        pg8::EpiResid E{(bf16*)(ws + WS_HB), (float*)(ws + WS_SSQ), 1.0f, nullptr};
        pg8::gemm_phase<pg8::EpiResid, DS, true>(lds, S, E, wave);
        SEAM(8);
    }
    if (IN(9)) { route_phase(args, lds, ctl, G, tid, wave, lane); SEAM(9); }

    for (int rep = 0; rep < REP_MOE; ++rep) {
        if (IN(10)) {
            LAS int* ml = (LAS int*)(lds + MISC_OFF + 64); moe_info_to_lds(ctl, ml, wave);
            const int ntile = __builtin_amdgcn_readfirstlane(ml[8]);
            pg8::MoeUpSched S{(const char*)(ws + WS_XQ), (const char*)(ws + WS_EWGU), (const int*)(ws + WS_LIST), ml, D, ntile, G, bx, 0};
            pg8::EpiMoeUp E{(unsigned char*)args.out, ws, 0};
            pg8::gemm_phase<pg8::EpiMoeUp, pg8::MoeUpSched, true>(lds, S, E, wave);
            SEAM(10);
        }
        if (IN(11)) {
            LAS int* ml = (LAS int*)(lds + MISC_OFF + 64); moe_info_to_lds(ctl, ml, wave);
            const int ntile = __builtin_amdgcn_readfirstlane(ml[8]);
            const int nmain = ntile < DOWN_MAIN_TILES ? ntile : DOWN_MAIN_TILES;
            pg8::MoeDownSched S{(unsigned char*)args.out, ws, (const char*)(ws + WS_EWD), ml, DFF, nmain, G, bx, 0};
            pg8::EpiMoeDown E{ws + WS_Y};
            pg8::gemm_phase<pg8::EpiMoeDown, pg8::MoeDownSched, true>(lds, S, E, wave);
            pg8::MoeDownTailSched S2{(unsigned char*)args.out, ws, (const char*)(ws + WS_EWD), ml, DFF, (ntile - nmain) * 4 * DOWN_KS, G, bx};
            pg8::EpiMoeDownPart E2{(bf16*)(ws + WS_YP)};
            pg8::gemm_phase<pg8::EpiMoeDownPart, pg8::MoeDownTailSched, true>(lds, S2, E2, wave);
            SEAM(11);
        }
    }
    if (IN(12)) { for (int rep = 0; rep < REP_EW; ++rep) { if (rep) GRID_BAR(); final_phase(args, ctl, vcu, G, wave, lane); } }
#undef IN
#undef SEAM
#undef lane
#undef tid
}

extern "C" void kernel_launch(void* const* d_in, const int* in_sizes, int n_in, void* d_out, int out_size, void* d_ws, size_t ws_size, hipStream_t stream) {
    static int grid = 0;
    if (grid == 0) {
        if (n_in != 21 || in_sizes[0] != M * D || out_size != M * D || ws_size < WS_END2) { fprintf(stderr, "kernel_launch: unexpected shapes (n_in %d, in0 %d, out %d, ws %zu); nothing launched\n", n_in, n_in > 0 ? in_sizes[0] : -1, out_size, ws_size); grid = -1; return; }
        int dev = 0, cus = 0, per_cu = 0;
        if (hipGetDevice(&dev) != hipSuccess || hipDeviceGetAttribute(&cus, hipDeviceAttributeMultiprocessorCount, dev) != hipSuccess) { grid = -1; return; }
        if (hipFuncSetAttribute((const void*)fwd_kernel, hipFuncAttributeMaxDynamicSharedMemorySize, LDS_BYTES) != hipSuccess) { fprintf(stderr, "kernel_launch: hipFuncSetAttribute failed\n"); grid = -1; return; }
        if (hipOccupancyMaxActiveBlocksPerMultiprocessor(&per_cu, (const void*)fwd_kernel, NWAVES * 64, LDS_BYTES) != hipSuccess || per_cu < 1) fprintf(stderr, "kernel_launch: occupancy query reports %d\n", per_cu);
        (void)hipGetLastError();
        grid = cus;
    }
    if (grid < 0) return;
    if (hipMemsetAsync((char*)d_ws + WS_CTL, 0, CTL_ZERO_BYTES, stream) != hipSuccess) return;
    Args a{};
    for (int i = 0; i < 21; ++i) a.in[i] = (const float*)d_in[i];
    a.out = (float*)d_out; a.ws = (unsigned char*)d_ws;
    for (int f = 0; f < 32; ++f) a.inv[f] = (float)std::pow(10000.0, -(double)f / 32.0);
#if MULTI_LAUNCH
    for (int p = 0; p < N_PHASES; ++p) { a.ph_lo = p; a.ph_hi = p + 1; hipLaunchKernelGGL(fwd_kernel, dim3(grid), dim3(NWAVES * 64), LDS_BYTES, stream, a); }
#else
    a.ph_lo = 0; a.ph_hi = N_PHASES;
    hipLaunchKernelGGL(fwd_kernel, dim3(grid), dim3(NWAVES * 64), LDS_BYTES, stream, a);
#endif
}
```

```cpp
#define CV_NT 0
#include <hip/hip_runtime.h>
#include <cstdio>
#include <cstdint>
#include <cmath>

#ifndef NAIVE_GEMM
#define NAIVE_GEMM 0
#endif
#ifndef PROBE_KL
#define PROBE_KL 1
#endif
#ifndef PROBE_DEPI
#define PROBE_DEPI 1
#endif
#ifndef PROBE_EPI
#define PROBE_EPI 1
#endif
#ifndef MULTI_LAUNCH
#define MULTI_LAUNCH 0
#endif

#define GAS __attribute__((address_space(1)))
#define LAS __attribute__((address_space(3)))
typedef unsigned short bf16;
typedef short bf16x8 __attribute__((ext_vector_type(8)));
typedef float f32x4 __attribute__((ext_vector_type(4)));
typedef float f32x2 __attribute__((ext_vector_type(2)));
typedef float f32x16 __attribute__((ext_vector_type(16)));
typedef unsigned u32x4 __attribute__((ext_vector_type(4)));
typedef unsigned u32x2 __attribute__((ext_vector_type(2)));
typedef int i32x8 __attribute__((ext_vector_type(8)));
typedef int i32x4 __attribute__((ext_vector_type(4)));

constexpr int D = 1024, BATCH = 4, SEQ = 8192, NMETA = 16, M = BATCH * SEQ;
constexpr int NCONV = 3 * D, DFF = 3584, NGU = 2 * DFF, NQKV = 1536, NE = 8;
constexpr int NQH = 16, NKVH = 4, HD = 64, KVD = NKVH * HD;
constexpr int LPOS = SEQ + NMETA;
constexpr float RMS_EPS = 1e-5f;
constexpr float LOG2E = 1.4426950408889634f;
constexpr float QSCALE = 0.125f * LOG2E;
constexpr int RING_BYTES_ = 131072;

__device__ __forceinline__ unsigned cvt_pk_bf16(float lo, float hi) { unsigned r; asm volatile("v_cvt_pk_bf16_f32 %0, %1, %2" : "=v"(r) : "v"(lo), "v"(hi)); return r; }
__device__ __forceinline__ float bf2f(unsigned short b) { return __uint_as_float(((unsigned)b) << 16); }
__device__ __forceinline__ float bflo(unsigned w) { return __uint_as_float(w << 16); }
__device__ __forceinline__ float bfhi(unsigned w) { return __uint_as_float(w & 0xffff0000u); }
__device__ __forceinline__ int hw_lane() { int l; asm volatile("v_mbcnt_lo_u32_b32 %0, -1, 0\n\tv_mbcnt_hi_u32_b32 %0, -1, %0" : "=v"(l)); return l; }
__device__ __forceinline__ float wave_sum(float v) {
#pragma unroll
    for (int o = 1; o < 64; o <<= 1) v += __shfl_xor(v, o);
    return v;
}

namespace pg8 {
constexpr int BM = 256, BK = 64, HALF = 128, HTB = HALF * BK * 2, STAGE_BYTES = 8 * HTB, NXCD = 8, WGM = 8;
__host__ __device__ __forceinline__ int lds_byte(int r, int c) { const int st = (r >> 4) * 2 + (c >> 5), rr = r & 15, cc = c & 31, ob = rr * 64 + cc * 2; return st * 1024 + (ob ^ (((ob >> 9) & 1) << 5)); }
__host__ __device__ __forceinline__ void stage_rc(int b, int& R, int& C) { const int st = b / 1024, sb = b % 1024, swz = sb ^ (((sb >> 9) & 1) << 5); R = (st >> 1) * 16 + swz / 64; C = (st & 1) * 32 + (swz % 64) / 2; }
__host__ __device__ __forceinline__ int perm32(int rho) { const int n = rho >> 4, i = rho & 15; return 8 * (i >> 2) + 4 * n + (i & 3); }

struct Unit { int pm, pn, e, lt; int ord = 0; };

__device__ __forceinline__ void order_unit(int L, int nM, int nN, int& pm, int& pn) {
    const int nwg = nM * nN; int wgid = L;
    { const int q = nwg / NXCD, r = nwg % NXCD, xcd = wgid % NXCD, off = wgid / NXCD; wgid = (xcd < r ? xcd * (q + 1) : r * (q + 1) + (xcd - r) * q) + off; }
    const int nig = WGM * nN, gid = wgid / nig, fm = gid * WGM, gsz = (nM - fm) < WGM ? (nM - fm) : WGM;
    pm = fm + ((wgid % nig) % gsz); pn = (wgid % nig) / gsz;
}

__device__ __forceinline__ const char* uptr(const char* p) { const unsigned long long v = (unsigned long long)p; const unsigned lo = __builtin_amdgcn_readfirstlane((unsigned)v), hi = __builtin_amdgcn_readfirstlane((unsigned)(v >> 32)); return (const char*)(((unsigned long long)hi << 32) | lo); }
__device__ __forceinline__ const char* sopaque(const char* p) { unsigned long long v = (unsigned long long)p; asm volatile("" : "+s"(v)); return (const char*)v; }
__device__ __forceinline__ void order_unit_b(int L, int nM, int nN, int& pm, int& pn) {
    const int nwg = nM * nN; int wgid = L;
    { const int q = nwg / NXCD, r = nwg % NXCD, xcd = wgid % NXCD, off = wgid / NXCD; wgid = (xcd < r ? xcd * (q + 1) : r * (q + 1) + (xcd - r) * q) + off; }
    const int gN = (nN % 4 == 0) ? 4 : ((nN % 3 == 0) ? 3 : nN);
    const int per_g = nM * gN, g = wgid / per_g, w = wgid % per_g;
    const int blk = WGM * gN, pmb = w / blk, wi = w % blk, fm = pmb * WGM, gsz = (nM - fm) < WGM ? (nM - fm) : WGM;
    pm = fm + wi % gsz; pn = g * gN + wi / gsz;
}
#ifndef FFN8
#define FFN8 1
#endif
#ifndef HD_NT
#define HD_NT 0
#endif
#ifndef YC_NT
#define YC_NT 1
#endif
#ifndef HM_PLAIN_FROM
#define HM_PLAIN_FROM 1000
#endif
#ifndef CV_NT
#define CV_NT 1
#endif
#ifndef P0_PIPE
#define P0_PIPE 0
#endif
#ifndef PROBE_T_EPI
#define PROBE_T_EPI 0
#endif
#define PG8_TSW ((volatile LAS unsigned*)(lds + 147456 - 16))
#ifndef ROUTE_MFMA
#define ROUTE_MFMA 1
#endif
#ifndef BG_DEFER
#define BG_DEFER 0
#endif
#ifndef BG_CVT
#define BG_CVT 0
#endif
#ifndef BAL_LDS
#define BAL_LDS 0
#endif
#ifndef QKV_PIPE
#define QKV_PIPE 1
#endif
#ifndef CONV_BATCH
#define CONV_BATCH 1
#endif
#ifndef ORDER_B
#define ORDER_B 1
#endif
template <int NM, int NN, bool F8 = false>
struct DenseSched {
    static constexpr bool GATHER = false, FP8 = F8; static constexpr int REPK = 1, REPE = 1;
    const char* A; const char* Bt; int KB  , G, c;
    __device__ __forceinline__ bool next(int i, Unit& u) const { const int L = i * G + c; if (L >= NM * NN) return false; if (ORDER_B) order_unit_b(L, NM, NN, u.pm, u.pn); else order_unit(L, NM, NN, u.pm, u.pn); u.e = 0; u.lt = i; return true; }
    __device__ __forceinline__ const char* aptr(const Unit& u) const { return A + (size_t)u.pm * BM * KB; }
    __device__ __forceinline__ const char* bptr(const Unit& u) const { return Bt + (size_t)u.pn * BM * KB; }
    __device__ __forceinline__ unsigned arow(const Unit&, int r) const { return (unsigned)r * (unsigned)KB; }
    __device__ __forceinline__ int ktiles() const { return KB / (BK * 2); }
};

#define PG8_SA(b, h) (((b) * 2 + (h)) * HTB)
#define PG8_SB(b, h) ((4 + (b) * 2 + (h)) * HTB)
template <int OFF> __device__ __forceinline__ void glds16_s(const char* sbase, unsigned voff, unsigned lbase) { unsigned keep;
    asm volatile("s_mov_b32 %0, m0\n\ts_add_u32 m0, %3, %4\n\ts_nop 0\n\tglobal_load_lds_dwordx4 %1, %2\n\ts_mov_b32 m0, %0" : "=&s"(keep) : "v"(voff), "s"(sbase), "s"(lbase), "i"(OFF) : "memory", "scc"); }
#define PG8_STAGE(bufoff, gbase, voff) do { const char* _gb = (const char*)(gbase); glds16_s<(bufoff)>(_gb, (voff)[0], ldsb); glds16_s<(bufoff) + 8192>(_gb, (voff)[1], ldsb); } while (0)
#define PG8_STAGE_A1(bufoff, gbase) do { if constexpr (Sched::GATHER) PG8_STAGE(bufoff, gbase, aof1); else PG8_STAGE(bufoff, (const char*)(gbase) + hstepA, aof0); } while (0)
#define PG8_LDA(dst, b, h) do { _Pragma("unroll") for (int m = 0; m < 4; ++m) _Pragma("unroll") for (int k = 0; k < 2; ++k) dst[m][k] = *(const LAS bf16x8*)(lds + PG8_SA(b, h) + aoff + m * 2048 + k * 1024); } while (0)
#define PG8_LDB(dst, b, h) do { _Pragma("unroll") for (int n = 0; n < 2; ++n) _Pragma("unroll") for (int k = 0; k < 2; ++k) dst[n][k] = *(const LAS bf16x8*)(lds + PG8_SB(b, h) + boff + n * 2048 + k * 1024); } while (0)
#define PG8_MMA(ai, bj, At, Bt) do { __builtin_amdgcn_s_setprio(1); _Pragma("unroll") for (int m = 0; m < 4; ++m) _Pragma("unroll") for (int n = 0; n < 2; ++n) _Pragma("unroll") for (int k = 0; k < 2; ++k) \
        acc[ai][bj][m][n] = __builtin_amdgcn_mfma_f32_16x16x32_bf16(Bt[n][k], At[m][k], acc[ai][bj][m][n], 0, 0, 0); __builtin_amdgcn_s_setprio(0); } while (0)
#define PG8_CAT(x) __builtin_shufflevector(__builtin_bit_cast(i32x4, x[0]), __builtin_bit_cast(i32x4, x[1]), 0, 1, 2, 3, 4, 5, 6, 7)
#define PG8_MMA8(ai, bj, At, Bt) do { __builtin_amdgcn_s_setprio(1); _Pragma("unroll") for (int m = 0; m < 4; ++m) _Pragma("unroll") for (int n = 0; n < 2; ++n) \
        acc[ai][bj][m][n] = __builtin_amdgcn_mfma_scale_f32_16x16x128_f8f6f4(PG8_CAT(Bt[n]), PG8_CAT(At[m]), acc[ai][bj][m][n], 0, 0, 0, 0, 0, 0); __builtin_amdgcn_s_setprio(0); } while (0)
#define PG8_MM(ai, bj, At, Bt) do { if constexpr (Sched::FP8) PG8_MMA8(ai, bj, At, Bt); else PG8_MMA(ai, bj, At, Bt); } while (0)
#define PG8_WAIT_V(n) asm volatile("s_waitcnt vmcnt(" #n ")" ::: "memory")
#define PG8_WAIT_L(n) asm volatile("s_waitcnt lgkmcnt(" #n ")" ::: "memory")
#define PG8_BAR __builtin_amdgcn_s_barrier()
#define PG8_SCHED __builtin_amdgcn_sched_barrier(0)

#if !NAIVE_GEMM
struct NoPre { __device__ __forceinline__ void operator()() const {} };
struct NoBg { __device__ __forceinline__ void issue(int) {} __device__ __forceinline__ void finish() {} };
template <class Epi, class Sched, bool ALIGN_EPI, class Pre = NoPre, class Bg = NoBg>
__device__ __forceinline__ void gemm_phase(LAS unsigned char* lds, const Sched& S, const Epi& E, const int wid, const Pre& pre = Pre(), Bg bg = Bg()) {
    const int lane = hw_lane(), tid = wid * 64 + lane, wr = wid >> 2, wc = wid & 3, fr = lane & 15, fq = lane >> 4;
    const int KB = S.KB, nt = S.ktiles();
    int R_[2], C_[2]; unsigned voffB[2]; unsigned aof0[2], aof1[2];
#pragma unroll
    for (int i = 0; i < 2; ++i) { int R, C; stage_rc(tid * 16 + i * 8192, R, C); R_[i] = R; C_[i] = C; const int Rb = Epi::PERM ? ((R & ~31) + perm32(R & 31)) : R;
        voffB[i] = (unsigned)(Rb * KB + C * 2); }
    const size_t kstep = (size_t)(BK * 2);
    const size_t hstep = (size_t)HALF * KB;
    const size_t hstepA = (size_t)S.arow(Unit{0, 0, 0, 0}, HALF);
    const unsigned ldsb = (unsigned)(size_t)lds + (unsigned)wid * 1024u;
    const int aoff = lds_byte(wr * 64 + fr, fq * 8), boff = lds_byte(wc * 32 + fr, fq * 8);
    Unit cur, nxt; int ui = 0;
    if (!S.next(0, cur)) { pre(); return; }
    f32x4 acc[2][2][4][2];
#pragma unroll
    for (int a = 0; a < 2; ++a)
#pragma unroll
        for (int b = 0; b < 2; ++b)
#pragma unroll
            for (int m = 0; m < 4; ++m)
#pragma unroll
                for (int n = 0; n < 2; ++n) acc[a][b][m][n] = (f32x4){0.f, 0.f, 0.f, 0.f};
    bf16x8 At[4][2], B0[2][2], B1[2][2];
    const char* cA = uptr(S.aptr(cur)); const char* cB = uptr(S.bptr(cur));
#pragma unroll
    for (int i = 0; i < 2; ++i) { aof0[i] = S.arow(cur, R_[i]) + (unsigned)C_[i] * 2u; aof1[i] = Sched::GATHER ? S.arow(cur, HALF + R_[i]) + (unsigned)C_[i] * 2u : 0u; }
#if BAL_LDS == 1
    PG8_STAGE(PG8_SB(0, 0), cB, voffB); PG8_STAGE(PG8_SB(0, 1), cB + hstep, voffB); PG8_STAGE(PG8_SA(0, 0), cA, aof0); PG8_STAGE_A1(PG8_SA(0, 1), cA);
    PG8_STAGE(PG8_SB(1, 0), cB + kstep, voffB); PG8_STAGE(PG8_SA(1, 0), cA + kstep, aof0);
    pre();
    PG8_WAIT_V(4);
    if (wr == 1) PG8_BAR;
    PG8_BAR;
#else
    PG8_STAGE(PG8_SB(0, 0), cB, voffB); PG8_STAGE(PG8_SB(0, 1), cB + hstep, voffB); PG8_STAGE(PG8_SA(0, 0), cA, aof0); PG8_STAGE_A1(PG8_SA(0, 1), cA);
    pre();
    if (wr == 1) PG8_BAR;
    PG8_WAIT_V(2); PG8_BAR;
    PG8_STAGE(PG8_SB(1, 0), cB + kstep, voffB); PG8_STAGE(PG8_SA(1, 0), cA + kstep, aof0); PG8_STAGE(PG8_SB(1, 1), cB + hstep + kstep, voffB);
    PG8_WAIT_V(6); PG8_BAR;
#endif
    for (;;) {
        const bool has_next = S.next((ui + 1) / Sched::REPK, nxt);
        const char* nA = uptr(has_next ? S.aptr(nxt) : cA); const char* nB = uptr(has_next ? S.bptr(nxt) : cB);
        int ntok0[2], ntok1[2];
        if constexpr (Sched::GATHER) {
#pragma unroll
            for (int i = 0; i < 2; ++i) { int R, C; stage_rc((wid * 64 + hw_lane()) * 16 + i * 8192, R, C); ntok0[i] = S.arow_raw(has_next ? nxt : cur, R); ntok1[i] = S.arow_raw(has_next ? nxt : cur, HALF + R); }
        }
#if BAL_LDS
        PG8_SCHED; PG8_LDB(B0, 0, 0);
#endif
        for (int t = 0; t < nt; t += 2) {
            const bool last = (t == nt - 2);
            const char* a1 = cA + (size_t)(t + 1) * kstep;
            const char* a2 = last ? nA : cA + (size_t)(t + 2) * kstep; const char* b2 = last ? nB : cB + (size_t)(t + 2) * kstep;
            const char* a3 = a2 + kstep; const char* b3 = b2 + kstep;
#if BAL_LDS == 1
            const char* b1 = cB + (size_t)(t + 1) * kstep;
            PG8_LDA(At, 0, 0); PG8_STAGE_A1(PG8_SA(1, 1), a1); PG8_STAGE(PG8_SB(1, 1), b1 + hstep, voffB);
            PG8_WAIT_V(8); PG8_WAIT_L(0); PG8_BAR;
            PG8_LDB(B1, 0, 1); PG8_SCHED; PG8_MM(0, 0, At, B0); PG8_MM(0, 1, At, B1); PG8_BAR; PG8_SCHED;
            if constexpr (Sched::GATHER) { if (last) {
#pragma unroll
                for (int i = 0; i < 2; ++i) { int R, C; stage_rc((wid * 64 + hw_lane()) * 16 + i * 8192, R, C); aof0[i] = S.arow_fin(ntok0[i]) + (unsigned)C * 2u; aof1[i] = S.arow_fin(ntok1[i]) + (unsigned)C * 2u; } } }
            PG8_LDA(At, 0, 1); PG8_STAGE(PG8_SB(0, 0), b2, voffB); PG8_STAGE(PG8_SA(0, 0), a2, aof0);
            PG8_WAIT_V(8); PG8_WAIT_L(0); PG8_BAR;
            PG8_MM(1, 0, At, B0); PG8_SCHED; PG8_LDB(B0, 1, 0); PG8_SCHED; PG8_MM(1, 1, At, B1); PG8_BAR; PG8_SCHED;
            PG8_LDA(At, 1, 0); PG8_STAGE_A1(PG8_SA(0, 1), a2); PG8_STAGE(PG8_SB(0, 1), b2 + hstep, voffB);
            PG8_WAIT_V(8); PG8_WAIT_L(0); PG8_BAR;
            PG8_LDB(B1, 1, 1); PG8_SCHED; PG8_MM(0, 0, At, B0); PG8_MM(0, 1, At, B1); PG8_BAR; PG8_SCHED;
            PG8_LDA(At, 1, 1); PG8_STAGE(PG8_SB(1, 0), b3, voffB); PG8_STAGE(PG8_SA(1, 0), a3, aof0);
            PG8_WAIT_V(8); PG8_WAIT_L(0); PG8_BAR;
            PG8_MM(1, 0, At, B0); PG8_SCHED; if (!last) PG8_LDB(B0, 0, 0); PG8_SCHED; PG8_MM(1, 1, At, B1); PG8_BAR; PG8_SCHED;
#else
            if (BAL_LDS != 2) PG8_LDB(B0, 0, 0); PG8_LDB(B1, 0, 1); PG8_SCHED; PG8_LDA(At, 0, 0); PG8_STAGE_A1(PG8_SA(1, 1), a1);
            PG8_WAIT_V(8); PG8_WAIT_L(0); PG8_BAR; PG8_MM(0, 0, At, B0); PG8_MM(0, 1, At, B1); PG8_BAR; PG8_SCHED;
            if constexpr (Sched::GATHER) { if (last) {
#pragma unroll
                for (int i = 0; i < 2; ++i) { int R, C; stage_rc((wid * 64 + hw_lane()) * 16 + i * 8192, R, C); aof0[i] = S.arow_fin(ntok0[i]) + (unsigned)C * 2u; aof1[i] = S.arow_fin(ntok1[i]) + (unsigned)C * 2u; } } }
            PG8_LDA(At, 0, 1); PG8_STAGE(PG8_SB(0, 0), b2, voffB); PG8_STAGE(PG8_SB(0, 1), b2 + hstep, voffB); PG8_STAGE(PG8_SA(0, 0), a2, aof0);
            PG8_WAIT_V(8); PG8_WAIT_L(0); PG8_BAR; PG8_MM(1, 0, At, B0); if (BAL_LDS == 2) { PG8_SCHED; PG8_LDB(B0, 1, 0); PG8_SCHED; } PG8_MM(1, 1, At, B1); PG8_BAR; PG8_SCHED;
            if (BAL_LDS != 2) PG8_LDB(B0, 1, 0); PG8_LDB(B1, 1, 1); PG8_SCHED; PG8_LDA(At, 1, 0); PG8_STAGE_A1(PG8_SA(0, 1), a2);
            PG8_WAIT_V(8); PG8_WAIT_L(0); PG8_BAR; PG8_MM(0, 0, At, B0); PG8_MM(0, 1, At, B1); PG8_BAR; PG8_SCHED;
            PG8_LDA(At, 1, 1); PG8_STAGE(PG8_SB(1, 0), b3, voffB); PG8_STAGE(PG8_SB(1, 1), b3 + hstep, voffB); PG8_STAGE(PG8_SA(1, 0), a3, aof0);
            PG8_WAIT_V(8); PG8_WAIT_L(0); PG8_BAR; PG8_MM(1, 0, At, B0); if (BAL_LDS == 2) { PG8_SCHED; if (!last) PG8_LDB(B0, 0, 0); PG8_SCHED; } PG8_MM(1, 1, At, B1); PG8_BAR; PG8_SCHED;
#endif
        }
        if constexpr (ALIGN_EPI) { if (wr == 0) PG8_BAR; }
        unsigned ts_e0 = 0u; if (PROBE_T_EPI && wid == 0 && ui == PROBE_T_EPI - 1 && PG8_TSW[2] == 1u) { PG8_WAIT_V(0); ts_e0 = (unsigned)__builtin_amdgcn_s_memrealtime(); }
#if BG_DEFER
        PG8_SCHED; bg.finish(); bg.issue(ui); PG8_SCHED;
#else
        bg.issue(ui);
#endif
        if (Sched::REPK == 1 || (ui % Sched::REPK) == Sched::REPK - 1) { for (int re = 0; re < Sched::REPE * Epi::REPE; ++re) E(acc, cur, wr, wc, fr, fq); }
#if !BG_DEFER
        PG8_SCHED; bg.finish(); PG8_SCHED;
#endif
        if (PROBE_T_EPI && wid == 0 && ui == PROBE_T_EPI - 1 && PG8_TSW[2] == 1u) { PG8_WAIT_V(0); PG8_TSW[1] = (unsigned)__builtin_amdgcn_s_memrealtime() - ts_e0; }
        if (!has_next) break;
#pragma unroll
        for (int a = 0; a < 2; ++a)
#pragma unroll
            for (int b = 0; b < 2; ++b)
#pragma unroll
                for (int m = 0; m < 4; ++m)
#pragma unroll
                    for (int n = 0; n < 2; ++n) acc[a][b][m][n] = (f32x4){0.f, 0.f, 0.f, 0.f};
        cur = nxt; cA = nA; cB = nB; ++ui;
        if constexpr (!Sched::GATHER) {   }
        if constexpr (ALIGN_EPI) { if (wr == 1) PG8_BAR; }
    }
#if BG_DEFER
    bg.finish();
#endif
    PG8_WAIT_V(0);
    if constexpr (!ALIGN_EPI) { if (wr == 0) PG8_BAR; }
    PG8_BAR;
}
#else
struct NoPre { __device__ __forceinline__ void operator()() const {} };
struct NoBg { __device__ __forceinline__ void issue(int) {} __device__ __forceinline__ void finish() {} };
template <class Epi, class Sched, bool ALIGN_EPI, class Pre = NoPre, class Bg = NoBg>
__device__ __forceinline__ void gemm_phase(LAS unsigned char* lds, const Sched& S, const Epi& E, const int wid, const Pre& pre = Pre(), Bg bg = Bg()) {
    const int lane = hw_lane(), tid = wid * 64 + lane, wr = wid >> 2, wc = wid & 3, fr = lane & 15, fq = lane >> 4;
    const int K = S.KB / 2; static_assert(!Sched::FP8, "naive body is bf16 only");
    Unit cur;
    for (int ui = 0; S.next(ui, cur); ++ui) {
        f32x4 acc[2][2][4][2];
        const char* cA = S.aptr(cur); const char* cB = S.bptr(cur);
#pragma unroll
        for (int ai = 0; ai < 2; ++ai)
#pragma unroll
            for (int m = 0; m < 4; ++m) {
                const char* arow = cA + S.arow(cur, ai * HALF + wr * 64 + m * 16 + fr);
#pragma unroll
                for (int bj = 0; bj < 2; ++bj)
#pragma unroll
                    for (int n = 0; n < 2; ++n) {
                        float s[4] = {0.f, 0.f, 0.f, 0.f};
                        const int c0 = bj * HALF + wc * 32 + (Epi::PERM ? (8 * fq + 4 * n) : (16 * n + 4 * fq));
                        for (int k = 0; k < K; k += 8) {
                            const u32x4 av = *(const u32x4*)(arow + (size_t)k * 2);
#pragma unroll
                            for (int i = 0; i < 4; ++i) {
                                const u32x4 bv = *(const u32x4*)(cB + ((size_t)(c0 + i) * K + k) * 2);
                                s[i] += bflo(av.x) * bflo(bv.x) + bfhi(av.x) * bfhi(bv.x) + bflo(av.y) * bflo(bv.y) + bfhi(av.y) * bfhi(bv.y)
                                      + bflo(av.z) * bflo(bv.z) + bfhi(av.z) * bfhi(bv.z) + bflo(av.w) * bflo(bv.w) + bfhi(av.w) * bfhi(bv.w);
                            }
                        }
                        acc[ai][bj][m][n] = (f32x4){s[0], s[1], s[2], s[3]};
                    }
            }
        bg.issue(ui); E(acc, cur, wr, wc, fr, fq); bg.finish();
    }
    (void)lds;
}
#endif
}

constexpr size_t MiB = 1u << 20;
constexpr size_t WS_CTL = 0, CTL_ZERO_BYTES = 1 * MiB;
constexpr size_t WS_MISC = 1 * MiB;
constexpr size_t WS_ROPE = 2 * MiB;
constexpr size_t WS_SSQ = 5 * MiB;
constexpr size_t WS_TOKEP = 7 * MiB;
constexpr size_t WS_TOKG = 7 * MiB + 512 * 1024;
constexpr size_t WS_LRSTD = 8 * MiB;
constexpr size_t WS_LIST = 9 * MiB;
constexpr size_t WS_WIN = 10 * MiB, WS_WOUT = 16 * MiB, WS_WGU = 18 * MiB, WS_WD = 32 * MiB, WS_WQKV = 39 * MiB, WS_WO = 42 * MiB;
constexpr size_t WS_EWGU = 44 * MiB, WS_EWD = 100 * MiB;
constexpr size_t WS_XQ = 128 * MiB;
constexpr size_t WS_HB = 160 * MiB;
constexpr size_t WS_ACT = 224 * MiB;
constexpr size_t WS_BC = WS_ACT, WS_VC = WS_ACT + 64 * MiB, WS_YC = WS_ACT + 128 * MiB, WS_HD = WS_ACT;
constexpr size_t WS_Q = WS_ACT, WS_KB = WS_ACT + 64 * MiB, WS_VB = WS_ACT + 80 * MiB, WS_O = WS_ACT + 128 * MiB;
constexpr size_t WS_Y = WS_ACT, WS_HM = WS_ACT + 132 * MiB;
constexpr size_t WS_YP = 480 * MiB;
constexpr size_t WS_END = 508 * MiB;
constexpr size_t WS_WGU8 = 508 * MiB, WS_WD8 = 516 * MiB, WS_END2 = 520 * MiB;
constexpr int DOWN_MAIN_TILES = 256, DOWN_KS = 7;
constexpr size_t HM_TILE_BYTES = (size_t)256 * DFF;
constexpr int HM_OUT_TILES = 146, HM_WS_TILES = 118, MAX_TILES = 264;
static_assert(HM_OUT_TILES * HM_TILE_BYTES <= (size_t)M * D * 4 && WS_HM + HM_WS_TILES * HM_TILE_BYTES <= WS_END && WS_Y + (size_t)MAX_TILES * 256 * D * 2 <= WS_HM, "MoE map");
static_assert(HM_OUT_TILES + HM_WS_TILES >= MAX_TILES && WS_HD + (size_t)M * DFF * 2 <= WS_END, "capacity");
constexpr float H1Q_SCALE = 16.f, WGU8_SCALE = 256.f, HDQ_SCALE = 8.f, WD8_SCALE = 512.f;
constexpr float XQ_SCALE = 32.f, WGU_SCALE = 256.f, HQ_SCALE = 8.f, WD_SCALE = 16.f;
constexpr size_t MS_MB = 0, MS_BM = 64 * 1024, MS_VM = 128 * 1024, MS_YCM = 192 * 1024, MS_HM = 256 * 1024, MS_HMB = 320 * 1024, MS_HDM = 384 * 1024,
                 MS_SSQ0 = 512 * 1024, MS_SSQ1 = 513 * 1024, MS_SSQ2 = 516 * 1024, MS_KM = 528 * 1024, MS_VMETA = 536 * 1024;
constexpr int CW_TMO = 0, CW_CODE = 1, CW_BAR = 4096, CW_CNT = 16384;
constexpr int RING_BYTES = 131072, LDSCTL_OFF = RING_BYTES, MISC_OFF = LDSCTL_OFF + 320, LDS_BYTES = 147456;
constexpr int NWAVES = 8;

#define RLX_AGENT __ATOMIC_RELAXED, __HIP_MEMORY_SCOPE_AGENT
#define LDS_WAIT() asm volatile("s_waitcnt lgkmcnt(0)" ::: "memory")
#define VM_WAIT() asm volatile("s_waitcnt vmcnt(0)" ::: "memory")
__device__ __forceinline__ unsigned f2bf(float f) { unsigned u = __builtin_bit_cast(unsigned, f); return (u + 0x7fffu + ((u >> 16) & 1u)) >> 16; }
__device__ __forceinline__ unsigned pk2(float lo, float hi) { return f2bf(lo) | (f2bf(hi) << 16); }
__device__ __forceinline__ float clamp8(float v) { return __builtin_amdgcn_fmed3f(v, -448.f, 448.f); }
__device__ __forceinline__ unsigned pk4_fp8(float a, float b, float c, float d) { unsigned w = 0u; w = (unsigned)__builtin_amdgcn_cvt_pk_fp8_f32(clamp8(a), clamp8(b), (int)w, false); w = (unsigned)__builtin_amdgcn_cvt_pk_fp8_f32(clamp8(c), clamp8(d), (int)w, true); return w; }

namespace pg8 {
__device__ __forceinline__ float rstd_from_ssq(const float* ssq, int row) {
    const f32x4* p = (const f32x4*)((const char*)ssq + (unsigned)row * 64u);
    const f32x4 a = p[0], b = p[1], c = p[2], d = p[3];
    const float s = (((a.x + a.y) + (a.z + a.w)) + ((b.x + b.y) + (b.z + b.w))) + (((c.x + c.y) + (c.z + c.w)) + ((d.x + d.y) + (d.z + d.w)));
    return __builtin_amdgcn_rsqf(s * (1.0f / (float)D) + RMS_EPS);
}
__device__ __forceinline__ u32x4 pack8(const f32x4 v0, const f32x4 v1) { u32x4 w; w.x = cvt_pk_bf16(v0[0], v0[1]); w.y = cvt_pk_bf16(v0[2], v0[3]); w.z = cvt_pk_bf16(v1[0], v1[1]); w.w = cvt_pk_bf16(v1[2], v1[3]); return w; }
__device__ __forceinline__ float silu_mul(float g, float u) { return g * u * __builtin_amdgcn_rcpf(1.0f + __builtin_amdgcn_exp2f(-g * LOG2E)); }

constexpr int RSTD_TAB_OFF = RING_BYTES_ + 1024, RSTD_TAB_MAX_UNITS = 14;
template <class Sched>
__device__ __forceinline__ void rstd_table_fill(const Sched& S, const float* ssq, LAS float* tab, int tid) {
    LAS int* pml = (LAS int*)(tab + RSTD_TAB_MAX_UNITS * BM);
    Unit u; int n = 0;
    for (int i = 0; S.next(i, u); ++i) if (i < RSTD_TAB_MAX_UNITS) { if (tid == 0) pml[i] = u.pm; n = i + 1; }
    __syncthreads();
#pragma unroll 4
    for (int idx = tid; idx < n * BM; idx += NWAVES * 64) tab[idx] = rstd_from_ssq(ssq, pml[idx >> 8] * BM + (idx & (BM - 1)));
}
static_assert(RSTD_TAB_OFF + RSTD_TAB_MAX_UNITS * BM * 4 + RSTD_TAB_MAX_UNITS * 4 <= LDS_BYTES, "rstd table");
struct EpiConvIn {
    static constexpr bool PERM = true; static constexpr int REPE = PROBE_DEPI;
    bf16* Bc; bf16* Vc; const LAS float* rtab;
    __device__ __forceinline__ void operator()(const f32x4 (&acc)[2][2][4][2], const Unit& u, int wr, int wc, int fr, int fq) const {
        int row0 = u.pm * BM + wr * 64 + fr; asm volatile("" : "+v"(row0));
#pragma unroll
        for (int ai = 0; ai < 2; ++ai)
#pragma unroll
            for (int m = 0; m < 4; ++m) {
                const int row = row0 + ai * HALF + m * 16; const float r = rtab[u.lt * BM + ai * HALF + wr * 64 + m * 16 + fr];
                if (u.pn < 4) {
#pragma unroll
                    for (int bj = 0; bj < 2; ++bj) { const u32x4 w = pack8(acc[ai][bj][m][0] * r, acc[ai][bj][m][1] * r); u32x4* p = (u32x4*)((char*)Bc + (unsigned)(row * D + u.pn * BM + bj * HALF + wc * 32 + 8 * fq) * 2u); if (CV_NT) __builtin_nontemporal_store(w, p); else *p = w; }
                } else {
                    const float r2 = r * r;
                    { const u32x4 w = pack8(acc[ai][0][m][0] * acc[ai][1][m][0] * r2, acc[ai][0][m][1] * acc[ai][1][m][1] * r2); u32x4* p = (u32x4*)((char*)Vc + (unsigned)(row * D + (u.pn - 4) * HALF + wc * 32 + 8 * fq) * 2u); if (CV_NT) __builtin_nontemporal_store(w, p); else *p = w; }
                }
            }
    }
};
template <bool Q8 = false, bool HALFB = false>
struct EpiResidT {
    static constexpr bool PERM = true; static constexpr int REPE = 1;
    bf16* hb; float* ssq; float sc  ; unsigned char* q8  ;
    __device__ __forceinline__ void operator()(const f32x4 (&acc)[2][2][4][2], const Unit& u, int wr, int wc, int fr, int fq) const {
        int row0 = u.pm * BM + wr * 64 + fr; asm volatile("" : "+v"(row0));
        unsigned off0 = (unsigned)(row0 * D + u.pn * BM + wc * 32 + 8 * fq) * 2u; asm volatile("" : "+v"(off0));
        char* hp = (char*)sopaque((const char*)hb);
        u32x4 b[2][4][2];
#pragma unroll
        for (int ai = 0; ai < (HALFB ? 1 : 2); ++ai)
#pragma unroll
            for (int m = 0; m < 4; ++m)
#pragma unroll
                for (int bj = 0; bj < 2; ++bj) b[ai][m][bj] = *(const GAS u32x4*)(hp + (off0 + (unsigned)(((ai * HALF + m * 16) * D + bj * HALF) * 2)));
#pragma unroll
        for (int ai = 0; ai < 2; ++ai) {
            if (HALFB && ai == 1) {
#pragma unroll
                for (int m = 0; m < 4; ++m)
#pragma unroll
                    for (int bj = 0; bj < 2; ++bj) b[1][m][bj] = *(const GAS u32x4*)(hp + (off0 + (unsigned)(((HALF + m * 16) * D + bj * HALF) * 2)));
            }
#pragma unroll
            for (int m = 0; m < 4; ++m) {
                const int row = row0 + ai * HALF + m * 16; float q = 0.f;
#pragma unroll
                for (int bj = 0; bj < 2; ++bj) {
                    const u32x4 bb = b[ai][m][bj];
                    const f32x4 v0 = acc[ai][bj][m][0] * sc + (f32x4){bflo(bb.x), bfhi(bb.x), bflo(bb.y), bfhi(bb.y)}, v1 = acc[ai][bj][m][1] * sc + (f32x4){bflo(bb.z), bfhi(bb.z), bflo(bb.w), bfhi(bb.w)};
                    const u32x4 pk = pack8(v0, v1);
                    *(GAS u32x4*)(hp + (off0 + (unsigned)(((ai * HALF + m * 16) * D + bj * HALF) * 2))) = pk;
                    if constexpr (Q8) {
                        const f32x4 w0 = v0 * H1Q_SCALE, w1 = v1 * H1Q_SCALE;
                        *(GAS u32x2*)((char*)sopaque((const char*)q8) + ((off0 >> 1) + (unsigned)((ai * HALF + m * 16) * D + bj * HALF))) = (u32x2){pk4_fp8(w0[0], w0[1], w0[2], w0[3]), pk4_fp8(w1[0], w1[1], w1[2], w1[3])};
                    }
                    q += ((v0[0] * v0[0] + v0[1] * v0[1]) + (v0[2] * v0[2] + v0[3] * v0[3])) + ((v1[0] * v1[0] + v1[1] * v1[1]) + (v1[2] * v1[2] + v1[3] * v1[3]));
                }
                q += __shfl_xor(q, 16); q += __shfl_xor(q, 32);
                if (fq == 0) *(float*)((char*)ssq + (unsigned)(row * 16 + u.pn * 4 + wc) * 4u) = q;
            }
        }
    }
};
typedef EpiResidT<false, false> EpiResid;
template <bool OUT8 = true>
struct EpiSwiGLU8T {
    static constexpr bool PERM = true; static constexpr int REPE = PROBE_DEPI;
    unsigned char* H; const LAS float* rtab;
    __device__ __forceinline__ void operator()(const f32x4 (&acc)[2][2][4][2], const Unit& u, int wr, int wc, int fr, int fq) const {
        int row0 = u.pm * BM + wr * 64 + fr; asm volatile("" : "+v"(row0));
        constexpr float s = 1.0f / (H1Q_SCALE * WGU8_SCALE);
#pragma unroll
        for (int ai = 0; ai < 2; ++ai)
#pragma unroll
            for (int m = 0; m < 4; ++m) {
                const int row = row0 + ai * HALF + m * 16; const float r = rtab[u.lt * BM + ai * HALF + wr * 64 + m * 16 + fr] * s; const float c1 = -r * LOG2E, c3 = __builtin_amdgcn_rcpf(r * r * (OUT8 ? HDQ_SCALE : 1.0f));
                f32x4 h[2];
#pragma unroll
                for (int n = 0; n < 2; ++n) {
                    const f32x4 g = acc[ai][0][m][n], uu = acc[ai][1][m][n]; const f32x4 t = g * c1; f32x4 e;
#pragma unroll
                    for (int i = 0; i < 4; ++i) e[i] = __builtin_amdgcn_exp2f(t[i]);
                    const f32x4 d = e * c3 + c3; f32x4 rr;
#pragma unroll
                    for (int i = 0; i < 4; ++i) rr[i] = __builtin_amdgcn_rcpf(d[i]);
                    h[n] = (g * uu) * rr;
                }
                if constexpr (OUT8) { if (HD_NT) __builtin_nontemporal_store((u32x2){pk4_fp8(h[0][0], h[0][1], h[0][2], h[0][3]), pk4_fp8(h[1][0], h[1][1], h[1][2], h[1][3])}, (u32x2*)((char*)H + (unsigned)(row * DFF + u.pn * HALF + wc * 32 + 8 * fq)));
                    else *(u32x2*)((char*)H + (unsigned)(row * DFF + u.pn * HALF + wc * 32 + 8 * fq)) = (u32x2){pk4_fp8(h[0][0], h[0][1], h[0][2], h[0][3]), pk4_fp8(h[1][0], h[1][1], h[1][2], h[1][3])}; }
                else __builtin_nontemporal_store(pack8(h[0], h[1]), (u32x4*)((char*)H + (unsigned)(row * DFF + u.pn * HALF + wc * 32 + 8 * fq) * 2u));
            }
    }
};
struct EpiSwiGLU {
    static constexpr bool PERM = true; static constexpr int REPE = PROBE_DEPI;
    bf16* H; const LAS float* rtab;
    __device__ __forceinline__ void operator()(const f32x4 (&acc)[2][2][4][2], const Unit& u, int wr, int wc, int fr, int fq) const {
        int row0 = u.pm * BM + wr * 64 + fr; asm volatile("" : "+v"(row0));
#pragma unroll
        for (int ai = 0; ai < 2; ++ai)
#pragma unroll
            for (int m = 0; m < 4; ++m) {
                const int row = row0 + ai * HALF + m * 16; const float r = rtab[u.lt * BM + ai * HALF + wr * 64 + m * 16 + fr]; const float c1 = -r * LOG2E, c3 = __builtin_amdgcn_rcpf(r * r);
                f32x4 h[2];
#pragma unroll
                for (int n = 0; n < 2; ++n) {
                    const f32x4 g = acc[ai][0][m][n], uu = acc[ai][1][m][n]; const f32x4 t = g * c1; f32x4 e;
#pragma unroll
                    for (int i = 0; i < 4; ++i) e[i] = __builtin_amdgcn_exp2f(t[i]);
                    const f32x4 d = e * c3 + c3; f32x4 rr;
#pragma unroll
                    for (int i = 0; i < 4; ++i) rr[i] = __builtin_amdgcn_rcpf(d[i]);
                    h[n] = (g * uu) * rr;
                }
                __builtin_nontemporal_store(pack8(h[0], h[1]), (u32x4*)((char*)H + (unsigned)(row * DFF + u.pn * HALF + wc * 32 + 8 * fq) * 2u));
            }
    }
};
struct EpiQKV {
    static constexpr bool PERM = true; static constexpr int REPE = PROBE_DEPI;
    bf16* Q; bf16* Kb; bf16* Vb; const LAS float* rtab; const float* bias; const f32x2* rope;
    __device__ __forceinline__ void operator()(const f32x4 (&acc)[2][2][4][2], const Unit& u, int wr, int wc, int fr, int fq) const {
        int row0 = u.pm * BM + wr * 64 + fr; asm volatile("" : "+v"(row0));
        if (u.pn < 5) {
            const int cb = (u.pn < 4 ? u.pn * BM : D) + wc * 64 + 8 * fq;
            const f32x4 b00 = *(const f32x4*)(bias + cb), b01 = *(const f32x4*)(bias + cb + 4), b10 = *(const f32x4*)(bias + cb + 32), b11 = *(const f32x4*)(bias + cb + 36);
            const float sc = u.pn < 4 ? QSCALE : 1.0f;
#if QKV_PIPE
            const char* rbase = sopaque((const char*)rope);
            unsigned roff = (unsigned)((NMETA + (row0 & (SEQ - 1))) * 32 + 8 * fq) * 8u; asm volatile("" : "+v"(roff));
            f32x4 rq[8][4];
#pragma unroll
            for (int it = 0; it < 4; ++it)
#pragma unroll
                for (int j = 0; j < 4; ++j) rq[it][j] = *(const GAS f32x4*)(rbase + (roff + (unsigned)((((it >> 2) * HALF + (it & 3) * 16) * 32) * 8 + j * 16)));
#pragma unroll
            for (int it = 0; it < 8; ++it) {
                    const int ai = it >> 2, m = it & 3;
                    const int row = row0 + ai * HALF + m * 16; const float r = rtab[u.lt * BM + ai * HALF + wr * 64 + m * 16 + fr];
                    f32x4 lo0 = acc[ai][0][m][0] * r + b00, lo1 = acc[ai][0][m][1] * r + b01, hi0 = acc[ai][1][m][0] * r + b10, hi1 = acc[ai][1][m][1] * r + b11;
                    f32x4 ol0, ol1, oh0, oh1;
#pragma unroll
                    for (int i = 0; i < 4; ++i) {
                        const f32x2 c0 = {rq[it][i >> 1][2 * (i & 1)], rq[it][i >> 1][2 * (i & 1) + 1]}, c1 = {rq[it][2 + (i >> 1)][2 * (i & 1)], rq[it][2 + (i >> 1)][2 * (i & 1) + 1]};
                        ol0[i] = (lo0[i] * c0.x - hi0[i] * c0.y) * sc; oh0[i] = (hi0[i] * c0.x + lo0[i] * c0.y) * sc;
                        ol1[i] = (lo1[i] * c1.x - hi1[i] * c1.y) * sc; oh1[i] = (hi1[i] * c1.x + lo1[i] * c1.y) * sc;
                    }
                    if (u.pn < 4) { char* p = (char*)Q + (unsigned)(row * D + u.pn * BM + wc * 64 + 8 * fq) * 2u; *(u32x4*)p = pack8(ol0, ol1); *(u32x4*)(p + 64) = pack8(oh0, oh1); }
                    else          { char* p = (char*)Kb + (unsigned)(row * KVD + wc * 64 + 8 * fq) * 2u;          *(u32x4*)p = pack8(ol0, ol1); *(u32x4*)(p + 64) = pack8(oh0, oh1); }
                    if (it + 4 < 8) {
#pragma unroll
                        for (int j = 0; j < 4; ++j) rq[it + 4][j] = *(const GAS f32x4*)(rbase + (roff + (unsigned)(((((it + 4) >> 2) * HALF + ((it + 4) & 3) * 16) * 32) * 8 + j * 16)));
                    }
            }
#else
#pragma unroll
            for (int ai = 0; ai < 2; ++ai)
#pragma unroll
                for (int m = 0; m < 4; ++m) {
                    const int row = row0 + ai * HALF + m * 16; const float r = rtab[u.lt * BM + ai * HALF + wr * 64 + m * 16 + fr];
                    const f32x2* rp = (const f32x2*)((const char*)rope + (unsigned)((NMETA + (row & (SEQ - 1))) * 32 + 8 * fq) * 8u);
                    f32x4 lo0 = acc[ai][0][m][0] * r + b00, lo1 = acc[ai][0][m][1] * r + b01, hi0 = acc[ai][1][m][0] * r + b10, hi1 = acc[ai][1][m][1] * r + b11;
                    f32x4 ol0, ol1, oh0, oh1;
#pragma unroll
                    for (int i = 0; i < 4; ++i) {
                        const f32x2 c0 = rp[i], c1 = rp[4 + i];
                        ol0[i] = (lo0[i] * c0.x - hi0[i] * c0.y) * sc; oh0[i] = (hi0[i] * c0.x + lo0[i] * c0.y) * sc;
                        ol1[i] = (lo1[i] * c1.x - hi1[i] * c1.y) * sc; oh1[i] = (hi1[i] * c1.x + lo1[i] * c1.y) * sc;
                    }
                    if (u.pn < 4) { char* p = (char*)Q + (unsigned)(row * D + u.pn * BM + wc * 64 + 8 * fq) * 2u; *(u32x4*)p = pack8(ol0, ol1); *(u32x4*)(p + 64) = pack8(oh0, oh1); }
                    else          { char* p = (char*)Kb + (unsigned)(row * KVD + wc * 64 + 8 * fq) * 2u;          *(u32x4*)p = pack8(ol0, ol1); *(u32x4*)(p + 64) = pack8(oh0, oh1); }
                }
#endif
        } else {
#pragma unroll
            for (int bj = 0; bj < 2; ++bj) {
                const int c = bj * HALF + wc * 32 + 8 * fq;
                const f32x4 b0 = *(const f32x4*)(bias + D + KVD + c), b1 = *(const f32x4*)(bias + D + KVD + c + 4);
#pragma unroll
                for (int ai = 0; ai < 2; ++ai)
#pragma unroll
                    for (int m = 0; m < 4; ++m) {
                        const int row = row0 + ai * HALF + m * 16; const float r = rtab[u.lt * BM + ai * HALF + wr * 64 + m * 16 + fr];
                        *(u32x4*)((char*)Vb + (unsigned)(row * KVD + c) * 2u) = pack8(acc[ai][bj][m][0] * r + b0, acc[ai][bj][m][1] * r + b1);
                    }
            }
        }
    }
};
}
#define XB_TMO      128
#define XB_XCNT(j)  (256  + 64 * (j))
#define XB_XSUB(j)  (1280 + 64 * (j))
#define XB_XGEN(j)  (2304 + 64 * (j))
#define XB_TOP      3328
#define XB_TOPGEN   3392
#define XCD_BAR_WORDS 3456
#define XB_SPIN_CAP (1u << 18)

__device__ __forceinline__ unsigned xb_ld(unsigned* p)              { return __hip_atomic_load(p, __ATOMIC_RELAXED, __HIP_MEMORY_SCOPE_AGENT); }
__device__ __forceinline__ unsigned xb_add(unsigned* p, unsigned v) { return __hip_atomic_fetch_add(p, v, __ATOMIC_RELAXED, __HIP_MEMORY_SCOPE_AGENT); }
__device__ __forceinline__ unsigned xb_xcc_id() { return (unsigned)__builtin_amdgcn_s_getreg((3 << 11) | 20) & 0xFu; }
#define XB_SPIN(cond, bar) do { unsigned _sp = 0; while (cond) { __builtin_amdgcn_s_sleep(1); \
    if ((++_sp & 255u) == 0u) { if (xb_ld(&(bar)[XB_TMO])) break; if (_sp > XB_SPIN_CAP) { atomicAdd(&(bar)[XB_TMO], 1u); break; } } } } while (0)

struct XcdBarrier {
    unsigned* bar; unsigned x;
    volatile LAS unsigned* st;
};

__device__ __forceinline__ XcdBarrier xcd_barrier_post(unsigned* bar, volatile LAS unsigned* st, int wave) {
    XcdBarrier b; b.bar = bar; b.x = xb_xcc_id(); b.st = st;
    if (wave == 0 && hw_lane() == 0) (void)xb_add(&bar[XB_XCNT(b.x)], 1u);
    return b;
}
__device__ __forceinline__ void xcd_barrier_complete(unsigned* bar, unsigned x, unsigned& nloc, unsigned& nx) {
    const unsigned G = gridDim.x * gridDim.y * gridDim.z;
    unsigned sum, cnt, mine, sp = 0u;
    for (;;) {
        sum = 0u; cnt = 0u; mine = 0u;
#pragma unroll
        for (unsigned j = 0; j < 16; ++j) { const unsigned c = xb_ld(&bar[XB_XCNT(j)]); sum += c; cnt += (c > 0u) ? 1u : 0u; mine = (j == x) ? c : mine; }
        if (sum == G) break;
        __builtin_amdgcn_s_sleep(1);
        if ((++sp & 255u) == 0u) { if (xb_ld(&bar[XB_TMO])) break; if (sp > XB_SPIN_CAP) { atomicAdd(&bar[XB_TMO], 1u); break; } }
    }
    nloc = mine > 0u ? mine : 1u; nx = cnt > 0u ? cnt : 1u;
}

__device__ __forceinline__ void xcd_barrier(const XcdBarrier& b, int wave) {
    asm volatile("s_waitcnt vmcnt(0)" ::: "memory");
    __syncthreads();
    if (wave == 0 && hw_lane() == 0) {
        unsigned* bar = b.bar;
        __builtin_amdgcn_s_waitcnt(0);
        unsigned nloc = b.st[0], nx = b.st[1];
        if (nloc == 0u) { xcd_barrier_complete(bar, b.x, nloc, nx); b.st[0] = nloc; b.st[1] = nx; }
        const unsigned old = xb_add(&bar[XB_XSUB(b.x)], 1u);
        const unsigned gen = old / nloc;
        if (old + 1u == (gen + 1u) * nloc) {
            __builtin_amdgcn_fence(__ATOMIC_RELEASE, "agent");
            asm volatile("s_waitcnt vmcnt(0)" ::: "memory");
            const unsigned og = xb_add(&bar[XB_TOP], 1u);
            const unsigned tg = og / nx;
            if (og + 1u == (tg + 1u) * nx) xb_add(&bar[XB_TOPGEN], 1u);
            else XB_SPIN(xb_ld(&bar[XB_TOPGEN]) == tg, bar);
            __builtin_amdgcn_fence(__ATOMIC_ACQUIRE, "agent");
            xb_add(&bar[XB_XGEN(b.x)], 1u);
            asm volatile("s_waitcnt vmcnt(0)" ::: "memory");
        } else {
            XB_SPIN(xb_ld(&bar[XB_XGEN(b.x)]) == gen, bar);
            __builtin_amdgcn_fence(__ATOMIC_ACQUIRE, "agent");
            asm volatile("s_waitcnt vmcnt(0)" ::: "memory");
        }
    }
    __syncthreads();
}

struct MoeInfo { int ts[9]; int cnt[8]; };
__device__ __forceinline__ void moe_info_load(const unsigned* ctl, MoeInfo& mi) {
    int t = 0;
#pragma unroll
    for (int e = 0; e < 8; ++e) { const int c = (int)__builtin_amdgcn_readfirstlane(__hip_atomic_load(ctl + CW_CNT + 64 * e, RLX_AGENT)); mi.cnt[e] = c; mi.ts[e] = t; t += (c + 255) >> 8; }
    mi.ts[8] = t;
}
__device__ __forceinline__ void moe_info_to_lds(const unsigned* ctl, LAS int* ml, int wave) {
    MoeInfo mi; moe_info_load(ctl, mi);
    if (wave == 0 && hw_lane() == 0) {
#pragma unroll
        for (int e = 0; e < 9; ++e) ml[e] = mi.ts[e];
#pragma unroll
        for (int e = 0; e < 8; ++e) ml[16 + e] = mi.cnt[e];
    }
    __syncthreads();
}
__device__ __forceinline__ void moe_find(const LAS int* ml, int T, int& e, int& ts, int& ne) {
    int ee = 0;
#pragma unroll
    for (int j = 1; j < 8; ++j) ee += (T >= ml[j]) ? 1 : 0;
    e = __builtin_amdgcn_readfirstlane(ee); ts = __builtin_amdgcn_readfirstlane(ml[e]); ne = __builtin_amdgcn_readfirstlane(ml[16 + e]);
}
__device__ __forceinline__ char* hm_tile_ptr(unsigned char* dout, unsigned char* ws, int ltc  ) {
    return (char*)(ltc < HM_OUT_TILES ? dout + (size_t)ltc * HM_TILE_BYTES : ws + WS_HM + (size_t)(ltc - HM_OUT_TILES) * HM_TILE_BYTES);
}
namespace pg8 {
struct MoeUpSched {
    static constexpr bool GATHER = true, FP8 = true; static constexpr int REPK = PROBE_KL, REPE = PROBE_EPI;
    const char* A; const char* Bt; const int* list; const LAS int* ml; int KB, nM, G, c, tbase; static constexpr int nN = NGU / 256;
    __device__ __forceinline__ bool next(int i, Unit& u) const {
        const int L = i * G + c; if (L >= nM * nN) return false;
        int pmc; order_unit(L, nM, nN, pmc, u.pn); const int T = tbase + pmc; int e, ts, ne; moe_find(ml, T, e, ts, ne);
        u.pm = T; u.e = e | (ne << 4); u.lt = T - ts; u.ord = i; return true; }
    __device__ __forceinline__ const char* aptr(const Unit&) const { return A; }
    __device__ __forceinline__ const char* bptr(const Unit& u) const { return Bt + ((size_t)(u.e & 15) * NGU + (size_t)u.pn * BM) * D; }
    __device__ __forceinline__ unsigned arow(const Unit& u, int r) const { const int idx = u.lt * BM + r; const int tok = idx < (u.e >> 4) ? list[(size_t)(u.e & 15) * M + idx] : 0; return (unsigned)tok * (unsigned)D; }
    __device__ __forceinline__ int arow_raw(const Unit& u, int r) const { const int ne = u.e >> 4; int idx = u.lt * BM + r; idx = idx < ne ? idx : ne - 1; return list[(size_t)(u.e & 15) * M + idx]; }
    __device__ __forceinline__ unsigned arow_fin(int tok) const { return (unsigned)tok * (unsigned)D; }    __device__ __forceinline__ int ktiles() const { return KB / (BK * 2); }
};
struct MoeDownSched {
    static constexpr bool GATHER = false, FP8 = true; static constexpr int REPK = 1, REPE = 1;
    unsigned char* dout; unsigned char* ws; const char* Bt; const LAS int* ml; int KB, nM, G, c, tbase; static constexpr int nN = D / 256;
    __device__ __forceinline__ bool next(int i, Unit& u) const {
        int L = i * G + c; if (L >= nM * nN) return false;
        if (HM_PLAIN_FROM < 64 && (nM * nN) % G == 0) L = (nM * nN / G - 1 - i) * G + c;
        int pmc; order_unit(L, nM, nN, pmc, u.pn); const int T = tbase + pmc;
        int e, ts, ne; moe_find(ml, T, e, ts, ne);
        u.pm = T; u.e = e; u.lt = 0; return true; }
    __device__ __forceinline__ const char* aptr(const Unit& u) const { return hm_tile_ptr(dout, ws, u.pm - tbase); }
    __device__ __forceinline__ const char* bptr(const Unit& u) const { return Bt + ((size_t)(u.e & 15) * D + (size_t)u.pn * BM) * DFF; }
    __device__ __forceinline__ unsigned arow(const Unit&, int r) const { return (unsigned)r * (unsigned)DFF; }    __device__ __forceinline__ int ktiles() const { return KB / (BK * 2); }
};
struct MoeDownTailSched {
    static constexpr bool GATHER = false, FP8 = true; static constexpr int REPK = 1, REPE = 1;
    unsigned char* dout; unsigned char* ws; const char* Bt; const LAS int* ml; int KB, nsub, G, c;
    __device__ __forceinline__ bool next(int i, Unit& u) const {
        const int q = i * G + c; if (q >= nsub) return false;
        const int tr = q / (4 * DOWN_KS), rem = q % (4 * DOWN_KS); u.pn = rem / DOWN_KS; u.lt = rem % DOWN_KS; u.pm = DOWN_MAIN_TILES + tr;
        int e, ts, ne; moe_find(ml, u.pm, e, ts, ne); u.e = e; return true; }
    __device__ __forceinline__ const char* aptr(const Unit& u) const { return hm_tile_ptr(dout, ws, u.pm) + u.lt * 512; }
    __device__ __forceinline__ const char* bptr(const Unit& u) const { return Bt + ((size_t)(u.e & 15) * D + (size_t)u.pn * BM) * DFF + u.lt * 512; }
    __device__ __forceinline__ unsigned arow(const Unit&, int r) const { return (unsigned)r * (unsigned)DFF; }
    __device__ __forceinline__ int ktiles() const { int n = 4; asm volatile("" : "+s"(n)); return n; }
};

struct EpiMoeUp {
    static constexpr bool PERM = true; static constexpr int REPE = 1;
    unsigned char* dout; unsigned char* ws; int tbase;
    __device__ __forceinline__ void operator()(const f32x4 (&acc)[2][2][4][2], const Unit& u, int wr, int wc, int fr, int fq) const {
        constexpr float s = 1.0f / (XQ_SCALE * WGU_SCALE), c1 = -s * LOG2E, c3 = 1.0f / (s * s * HQ_SCALE);
        unsigned off0 = (unsigned)((wr * 64 + fr) * DFF + u.pn * HALF + wc * 32 + 8 * fq); asm volatile("" : "+v"(off0));
        char* H = (char*)pg8::sopaque(hm_tile_ptr(dout, ws, u.pm - tbase)) + off0;
#pragma unroll
        for (int ai = 0; ai < 2; ++ai)
#pragma unroll
            for (int m = 0; m < 4; ++m) {
                f32x4 h[2];
#pragma unroll
                for (int n = 0; n < 2; ++n) {
                    const f32x4 g = acc[ai][0][m][n], uu = acc[ai][1][m][n]; const f32x4 t = g * c1; f32x4 e;
#pragma unroll
                    for (int i = 0; i < 4; ++i) e[i] = __builtin_amdgcn_exp2f(t[i]);
                    const f32x4 d = e * c3 + c3; f32x4 r;
#pragma unroll
                    for (int i = 0; i < 4; ++i) r[i] = __builtin_amdgcn_rcpf(d[i]);
                    h[n] = (g * uu) * r;
                }
                const u32x2 hw = (u32x2){pk4_fp8(h[0][0], h[0][1], h[0][2], h[0][3]), pk4_fp8(h[1][0], h[1][1], h[1][2], h[1][3])};
                if (u.ord >= HM_PLAIN_FROM) *(u32x2*)(H + (ai * HALF + m * 16) * DFF) = hw; else __builtin_nontemporal_store(hw, (u32x2*)(H + (ai * HALF + m * 16) * DFF));
            }
    }
};
struct EpiMoeDown {
    static constexpr bool PERM = true; static constexpr int REPE = 1;
    unsigned char* Y;
    __device__ __forceinline__ void operator()(const f32x4 (&acc)[2][2][4][2], const Unit& u, int wr, int wc, int fr, int fq) const {
        unsigned off0 = (unsigned)((u.pm * BM + wr * 64 + fr) * D + u.pn * BM + wc * 32 + 8 * fq); asm volatile("" : "+v"(off0));
        char* Yp = (char*)pg8::sopaque((const char*)Y) + off0;
#pragma unroll
        for (int ai = 0; ai < 2; ++ai)
#pragma unroll
            for (int m = 0; m < 4; ++m)
#pragma unroll
                for (int bj = 0; bj < 2; ++bj) { const f32x4 v0 = acc[ai][bj][m][0], v1 = acc[ai][bj][m][1];
                    *(u32x2*)(Yp + (ai * HALF + m * 16) * D + bj * HALF) = (u32x2){pk4_fp8(v0[0], v0[1], v0[2], v0[3]), pk4_fp8(v1[0], v1[1], v1[2], v1[3])}; }
    }
};
struct EpiMoeDownPart {
    static constexpr bool PERM = true; static constexpr int REPE = 1;
    bf16* P;
    __device__ __forceinline__ void operator()(const f32x4 (&acc)[2][2][4][2], const Unit& u, int wr, int wc, int fr, int fq) const {
        unsigned off0 = (unsigned)((((u.pm - DOWN_MAIN_TILES) * 4 + u.pn) * DOWN_KS + u.lt) * 65536 + (wr * 64 + fr) * 256 + wc * 32 + 8 * fq) * 2u; asm volatile("" : "+v"(off0));
        char* Pp = (char*)pg8::sopaque((const char*)P) + off0;
#pragma unroll
        for (int ai = 0; ai < 2; ++ai)
#pragma unroll
            for (int m = 0; m < 4; ++m)
#pragma unroll
                for (int bj = 0; bj < 2; ++bj) *(u32x4*)(Pp + ((ai * HALF + m * 16) * 256 + bj * HALF) * 2) = pack8(acc[ai][bj][m][0], acc[ai][bj][m][1]);
    }
};
}

constexpr int META_LDS_OFF = RING_BYTES + 1024;
static_assert(META_LDS_OFF + 7 * 64 * 8 * 4 <= LDS_BYTES, "meta scratch");
template <class F>
__device__ __forceinline__ void meta_dual(LAS unsigned char* lds, const bf16* A, int K, const bf16* Bt, int n0, int n1, int lane, int wave, const F& epi) {
    const int r16 = lane & 15, kq = lane >> 4; const int kw = K / 8, kb = wave * kw;
    const bf16* ap = A + (size_t)r16 * K + kb + 8 * kq; const bf16* b0p = Bt + (size_t)(n0 + r16) * K + kb + 8 * kq; const bf16* b1p = Bt + (size_t)(n1 + r16) * K + kb + 8 * kq;
    f32x4 acc0 = (f32x4){0.f, 0.f, 0.f, 0.f}, acc1 = (f32x4){0.f, 0.f, 0.f, 0.f};
#pragma unroll 2
    for (int k = 0; k < kw; k += 64) {
        const bf16x8 a = *(const bf16x8*)(ap + k), b0 = *(const bf16x8*)(b0p + k), b1 = *(const bf16x8*)(b1p + k);
        const bf16x8 a2 = *(const bf16x8*)(ap + k + 32), b02 = *(const bf16x8*)(b0p + k + 32), b12 = *(const bf16x8*)(b1p + k + 32);
        acc0 = __builtin_amdgcn_mfma_f32_16x16x32_bf16(a, b0, acc0, 0, 0, 0); acc1 = __builtin_amdgcn_mfma_f32_16x16x32_bf16(a, b1, acc1, 0, 0, 0);
        acc0 = __builtin_amdgcn_mfma_f32_16x16x32_bf16(a2, b02, acc0, 0, 0, 0); acc1 = __builtin_amdgcn_mfma_f32_16x16x32_bf16(a2, b12, acc1, 0, 0, 0);
    }
    LAS f32x4* sc = (LAS f32x4*)(lds + META_LDS_OFF);
    if (wave > 0) { sc[((wave - 1) * 64 + lane) * 2] = acc0; sc[((wave - 1) * 64 + lane) * 2 + 1] = acc1; }
    __syncthreads();
    if (wave == 0) {
#pragma unroll
        for (int w = 0; w < 7; ++w) { acc0 += sc[(w * 64 + lane) * 2]; acc1 += sc[(w * 64 + lane) * 2 + 1]; }
        epi(acc0, acc1, r16, kq);
    }
}
__device__ __forceinline__ f32x4 meta_rstd_parts(const float* parts, int lane) {
    float s = 0.f;
    for (int j = 0; j < 32; ++j) s += parts[j * 16 + (lane & 15)];
    const float r = 1.0f / sqrtf(s * (1.0f / (float)D) + RMS_EPS); const int kq = lane >> 4; f32x4 o;
#pragma unroll
    for (int g = 0; g < 4; ++g) o[g] = __shfl(r, 4 * kq + g);
    return o;
}

__device__ __forceinline__ void p0_item(const float* W, int ldw, int K, int k0, int n0, bf16* dst, const float* gain, LAS float* scr, int lane) {
    { float t[32]; const float* wp = W + (size_t)(k0 + (lane >> 5)) * ldw + n0 + (lane & 31);
#pragma unroll
      for (int i = 0; i < 32; ++i) t[i] = wp[(size_t)(2 * i) * ldw];
#pragma unroll
      for (int i = 0; i < 32; ++i) scr[(2 * i + (lane >> 5)) * 33 + (lane & 31)] = t[i]; }
    LDS_WAIT(); asm volatile("" ::: "memory");
    const int c = lane & 7;
    float g[8];
#pragma unroll
    for (int e = 0; e < 8; ++e) g[e] = gain ? gain[k0 + 8 * c + e] : 1.0f;
#pragma unroll
    for (int j = 0; j < 4; ++j) { const int n = (lane >> 3) + 8 * j; const LAS float* s = scr + (8 * c) * 33 + n;
        u32x4 o; o.x = pk2(s[0 * 33] * g[0], s[1 * 33] * g[1]); o.y = pk2(s[2 * 33] * g[2], s[3 * 33] * g[3]); o.z = pk2(s[4 * 33] * g[4], s[5 * 33] * g[5]); o.w = pk2(s[6 * 33] * g[6], s[7 * 33] * g[7]);
        *(GAS u32x4*)(dst + (size_t)n * K + k0 + 8 * c) = o; }
    LDS_WAIT(); asm volatile("" ::: "memory");
}
__device__ __forceinline__ void p0_item_dual(const float* W, int ldw, int K, int k0, int n0, bf16* dst, unsigned char* dst8, const float* gain, float sc, LAS float* scr, int lane) {
    { float t[32]; const float* wp = W + (size_t)(k0 + (lane >> 5)) * ldw + n0 + (lane & 31);
#pragma unroll
      for (int i = 0; i < 32; ++i) t[i] = wp[(size_t)(2 * i) * ldw];
#pragma unroll
      for (int i = 0; i < 32; ++i) scr[(2 * i + (lane >> 5)) * 33 + (lane & 31)] = t[i]; }
    LDS_WAIT(); asm volatile("" ::: "memory");
    const int c = lane & 7;
    float g[8];
#pragma unroll
    for (int e = 0; e < 8; ++e) g[e] = gain ? gain[k0 + 8 * c + e] : 1.0f;
#pragma unroll
    for (int j = 0; j < 4; ++j) { const int n = (lane >> 3) + 8 * j; const LAS float* s = scr + (8 * c) * 33 + n;
        float v[8];
#pragma unroll
        for (int e = 0; e < 8; ++e) v[e] = s[e * 33] * g[e];
        u32x4 o; o.x = pk2(v[0], v[1]); o.y = pk2(v[2], v[3]); o.z = pk2(v[4], v[5]); o.w = pk2(v[6], v[7]);
        *(GAS u32x4*)(dst + (size_t)n * K + k0 + 8 * c) = o;
        u32x2 o8; o8.x = pk4_fp8(v[0] * sc, v[1] * sc, v[2] * sc, v[3] * sc); o8.y = pk4_fp8(v[4] * sc, v[5] * sc, v[6] * sc, v[7] * sc);
        *(GAS u32x2*)(dst8 + (size_t)n * K + k0 + 8 * c) = o8; }
    LDS_WAIT(); asm volatile("" ::: "memory");
}
__device__ __forceinline__ void p0_item8(const float* W, int ldw, int K, int k0, int n0, unsigned char* dst, const float* gain, float sc, LAS float* scr, int lane) {
    { float t[32]; const float* wp = W + (size_t)(k0 + (lane >> 5)) * ldw + n0 + (lane & 31);
#pragma unroll
      for (int i = 0; i < 32; ++i) t[i] = wp[(size_t)(2 * i) * ldw];
#pragma unroll
      for (int i = 0; i < 32; ++i) scr[(2 * i + (lane >> 5)) * 33 + (lane & 31)] = t[i]; }
    LDS_WAIT(); asm volatile("" ::: "memory");
    const int c = lane & 7;
    float g[8];
#pragma unroll
    for (int e = 0; e < 8; ++e) g[e] = (gain ? gain[k0 + 8 * c + e] : 1.0f) * sc;
#pragma unroll
    for (int j = 0; j < 4; ++j) { const int n = (lane >> 3) + 8 * j; const LAS float* s = scr + (8 * c) * 33 + n;
        u32x2 o; o.x = pk4_fp8(s[0 * 33] * g[0], s[1 * 33] * g[1], s[2 * 33] * g[2], s[3 * 33] * g[3]); o.y = pk4_fp8(s[4 * 33] * g[4], s[5 * 33] * g[5], s[6 * 33] * g[6], s[7 * 33] * g[7]);
        *(GAS u32x2*)(dst + (size_t)n * K + k0 + 8 * c) = o; }
    LDS_WAIT(); asm volatile("" ::: "memory");
}

struct P0Desc { const float* W; int ldw, K, k0, n0; bf16* dst; unsigned char* dst8; const float* gain; float sc; };
__device__ __forceinline__ void p0_load(const P0Desc& d, float (&t)[32], float (&g)[8], int lane) {
    const GAS float* wp = (const GAS float*)d.W + (size_t)(d.k0 + (lane >> 5)) * d.ldw + d.n0 + (lane & 31);
#pragma unroll
    for (int i = 0; i < 32; ++i) t[i] = wp[(size_t)(2 * i) * d.ldw];
    const int c = lane & 7;
#pragma unroll
    for (int e = 0; e < 8; ++e) g[e] = d.gain ? ((const GAS float*)d.gain)[d.k0 + 8 * c + e] : 1.0f;
}
__device__ __forceinline__ void p0_finish(const P0Desc& d, const float (&t)[32], const float (&g)[8], LAS float* scr, int lane) {
#pragma unroll
    for (int i = 0; i < 32; ++i) scr[(2 * i + (lane >> 5)) * 33 + (lane & 31)] = t[i];
    LDS_WAIT(); asm volatile("" ::: "memory");
    const int c = lane & 7;
#pragma unroll
    for (int j = 0; j < 4; ++j) { const int n = (lane >> 3) + 8 * j; const LAS float* s = scr + (8 * c) * 33 + n;
        float v[8];
#pragma unroll
        for (int e = 0; e < 8; ++e) v[e] = s[e * 33] * g[e];
        if (d.dst) { u32x4 o; o.x = pk2(v[0], v[1]); o.y = pk2(v[2], v[3]); o.z = pk2(v[4], v[5]); o.w = pk2(v[6], v[7]); *(GAS u32x4*)(d.dst + (size_t)n * d.K + d.k0 + 8 * c) = o; }
        if (d.dst8) { u32x2 o8; o8.x = pk4_fp8(v[0] * d.sc, v[1] * d.sc, v[2] * d.sc, v[3] * d.sc); o8.y = pk4_fp8(v[4] * d.sc, v[5] * d.sc, v[6] * d.sc, v[7] * d.sc); *(GAS u32x2*)(d.dst8 + (size_t)n * d.K + d.k0 + 8 * c) = o8; } }
    LDS_WAIT(); asm volatile("" ::: "memory");
}
__device__ __forceinline__ int ileave(int ch, int kind) { return 256 * (ch >> 7) + 128 * kind + (ch & 127); }

struct Args { const float* in[21]; float* out; unsigned char* ws; float inv[32]; int ph_lo, ph_hi; };

__device__ __forceinline__ void p0_decode(const Args& a, unsigned char* ws, int r, P0Desc& d) {
    constexpr int I_WIN = 16 * 96, I_WOUT = 16 * 32, I_G = 16 * 112, I_DN = 56 * 32, I_QKV = 16 * 48, I_WO = 16 * 32;
    d.dst = nullptr; d.dst8 = nullptr; d.gain = nullptr; d.sc = 1.0f;
    if (r < I_WIN) { const int kb = r / 96, nb = r % 96, n0 = nb * 32; int d0;
        if (n0 < D) d0 = n0; else if (n0 < 2 * D) d0 = D + ileave(n0 - D, 0); else d0 = D + ileave(n0 - 2 * D, 1);
        d.W = a.in[3]; d.ldw = NCONV; d.K = D; d.k0 = kb * 64; d.n0 = n0; d.dst = (bf16*)(ws + WS_WIN) + (size_t)d0 * D; d.gain = a.in[2]; return; } r -= I_WIN;
    if (r < I_WOUT) { const int kb = r / 32, nb = r % 32; d.W = a.in[5]; d.ldw = D; d.K = D; d.k0 = kb * 64; d.n0 = nb * 32; d.dst = (bf16*)(ws + WS_WOUT) + (size_t)(nb * 32) * D; return; } r -= I_WOUT;
    if (r < 2 * I_G) { const int kind = r >= I_G; r -= kind * I_G; const int kb = r / 112, nb = r % 112;
        d.W = a.in[7 + kind]; d.ldw = DFF; d.K = D; d.k0 = kb * 64; d.n0 = nb * 32; d.dst = (bf16*)(ws + WS_WGU) + (size_t)ileave(nb * 32, kind) * D; d.gain = a.in[6];
        if (FFN8) { d.dst8 = ws + WS_WGU8 + (size_t)ileave(nb * 32, kind) * D; d.sc = WGU8_SCALE; } return; } r -= 2 * I_G;
    if (r < I_DN) { const int kb = r / 32, nb = r % 32; d.W = a.in[9]; d.ldw = D; d.K = DFF; d.k0 = kb * 64; d.n0 = nb * 32; d.dst = (bf16*)(ws + WS_WD) + (size_t)(nb * 32) * DFF;
        if (FFN8) { d.dst8 = ws + WS_WD8 + (size_t)(nb * 32) * DFF; d.sc = WD8_SCALE; } return; } r -= I_DN;
    if (r < I_QKV) { const int kb = r / 48, nb = r % 48, n0 = nb * 32; int d0;
        if (n0 < D + KVD) { const int c = n0 & 255; d0 = (n0 & ~255) + 128 * ((c >> 5) & 1) + 32 * (c >> 6); } else d0 = n0;
        d.W = a.in[11]; d.ldw = NQKV; d.K = D; d.k0 = kb * 64; d.n0 = n0; d.dst = (bf16*)(ws + WS_WQKV) + (size_t)d0 * D; d.gain = a.in[10]; return; } r -= I_QKV;
    if (r < I_WO) { const int kb = r / 32, nb = r % 32; d.W = a.in[14]; d.ldw = D; d.K = D; d.k0 = kb * 64; d.n0 = nb * 32; d.dst = (bf16*)(ws + WS_WO) + (size_t)(nb * 32) * D; return; } r -= I_WO;
    { const int mat = r / I_G, q = r % I_G, kind = mat >> 3, e = mat & 7;
      if (kind < 2) { const int kb = q / 112, nb = q % 112;
          d.W = a.in[17 + kind] + (size_t)e * D * DFF; d.ldw = DFF; d.K = D; d.k0 = kb * 64; d.n0 = nb * 32; d.dst8 = ws + WS_EWGU + ((size_t)e * NGU + ileave(nb * 32, kind)) * D; d.gain = a.in[15]; d.sc = WGU_SCALE; }
      else { const int kb = q / 32, nb = q % 32;
          d.W = a.in[19] + (size_t)e * DFF * D; d.ldw = D; d.K = DFF; d.k0 = kb * 64; d.n0 = nb * 32; d.dst8 = ws + WS_EWD + ((size_t)e * D + nb * 32) * DFF; d.sc = WD_SCALE; } }
}

constexpr int EXP_ITEMS = 24 * 16 * 112, BG_ORDS = 20, BG_P1 = 6, BG_P4 = 14;
__device__ __forceinline__ int bg_cover(int G) { if (!BG_CVT) return 0; const int c = BG_ORDS * G * NWAVES; return c < EXP_ITEMS ? c : EXP_ITEMS; }
struct ExpertCvtBg {
    const float* gate; const float* up; const float* down; const float* gain; unsigned char* ws; int first, base_ord, nmax, gw, NGW;
    f32x4 t[8]; f32x4 gA, gB; unsigned char* dbase; unsigned doff; int K; float sc; bool active;
    __device__ __forceinline__ void issue(int ui) {
        const int r = first + (base_ord + ui) * NGW + gw;
        active = ui < nmax && r < EXP_ITEMS;
        if (!active) return;
        const int mat = r / (16 * 112), q = r - mat * (16 * 112), kind = mat >> 3, e = mat & 7;
        const int ln = hw_lane(), kq = ln >> 3, nq = ln & 7;
        const float* W; int ldw, k0, n0;
        if (kind < 2) { const int kb = q / 112, nb = q - kb * 112; k0 = kb * 64; n0 = nb * 32; W = (kind ? up : gate) + (size_t)e * D * DFF; ldw = DFF; K = D; sc = WGU_SCALE;
            dbase = ws + WS_EWGU + ((size_t)e * NGU + ileave(n0, kind)) * D; }
        else { const int kb = q >> 5, nb = q & 31; k0 = kb * 64; n0 = nb * 32; W = down + (size_t)e * DFF * D; ldw = D; K = DFF; sc = WD_SCALE; dbase = ws + WS_EWD + ((size_t)e * D + n0) * DFF; }
        const GAS float* wp = (const GAS float*)W + (size_t)(k0 + 8 * kq) * ldw + n0 + 4 * nq;
#pragma unroll
        for (int j = 0; j < 8; ++j) t[j] = *(const GAS f32x4*)(wp + (size_t)j * ldw);
        if (kind < 2) { gA = *(const GAS f32x4*)(gain + k0 + 8 * kq); gB = *(const GAS f32x4*)(gain + k0 + 8 * kq + 4); } else { gA = (f32x4){1.f, 1.f, 1.f, 1.f}; gB = gA; }
        doff = (unsigned)((4 * nq) * K + k0 + 8 * kq);
    }
    __device__ __forceinline__ void finish() {
        if (!active) return;
        active = false;
        const float g[8] = {gA.x * sc, gA.y * sc, gA.z * sc, gA.w * sc, gB.x * sc, gB.y * sc, gB.z * sc, gB.w * sc};
#pragma unroll
        for (int i = 0; i < 4; ++i) {
            u32x2 o; o.x = pk4_fp8(t[0][i] * g[0], t[1][i] * g[1], t[2][i] * g[2], t[3][i] * g[3]); o.y = pk4_fp8(t[4][i] * g[4], t[5][i] * g[5], t[6][i] * g[6], t[7][i] * g[7]);
            *(GAS u32x2*)(dbase + (doff + (unsigned)(i * K))) = o;
        }
    }
};

__device__ __forceinline__ void p0_prologue(const Args& a, LAS unsigned char* lds, int vcu, int G, int wave, int lane) {
    unsigned char* ws = a.ws;
    LAS float* scr = (LAS float*)(lds + wave * 16384);
    const int gw = vcu * NWAVES + wave, NGW = G * NWAVES;
    constexpr int I_WIN = 16 * 96, I_WOUT = 16 * 32, I_G = 16 * 112, I_DN = 56 * 32, I_QKV = 16 * 48, I_WO = 16 * 32;
    constexpr int NITEMS = I_WIN + I_WOUT + 2 * I_G + I_DN + I_QKV + I_WO + 24 * I_G;
    static_assert(I_DN == I_G, "item counts");
    const int nitems = NITEMS - bg_cover(G);
#if P0_PIPE
    {
        P0Desc dA, dB; float tA[32], tB[32], gA[8], gB[8];
        int it = gw;
        if (it < nitems) { p0_decode(a, ws, it, dA); p0_load(dA, tA, gA, lane); }
        while (it < nitems) {
            const int itn = it + NGW; const bool more = itn < nitems;
            if (more) { p0_decode(a, ws, itn, dB); p0_load(dB, tB, gB, lane); }
            p0_finish(dA, tA, gA, scr, lane);
            it = itn; if (!more) break;
            const int itn2 = it + NGW; const bool more2 = itn2 < nitems;
            if (more2) { p0_decode(a, ws, itn2, dA); p0_load(dA, tA, gA, lane); }
            p0_finish(dB, tB, gB, scr, lane);
            it = itn2;
        }
    }
#else
    for (int it = gw; it < nitems; it += NGW) {
        int r = it;
        if (r < I_WIN) { const int kb = r / 96, nb = r % 96, n0 = nb * 32; int d0;
            if (n0 < D) d0 = n0; else if (n0 < 2 * D) d0 = D + ileave(n0 - D, 0); else d0 = D + ileave(n0 - 2 * D, 1);
            p0_item(a.in[3], NCONV, D, kb * 64, n0, (bf16*)(ws + WS_WIN) + (size_t)d0 * D, a.in[2], scr, lane); continue; } r -= I_WIN;
        if (r < I_WOUT) { const int kb = r / 32, nb = r % 32; p0_item(a.in[5], D, D, kb * 64, nb * 32, (bf16*)(ws + WS_WOUT) + (size_t)(nb * 32) * D, nullptr, scr, lane); continue; } r -= I_WOUT;
        if (r < I_G) { const int kb = r / 112, nb = r % 112;
            if (FFN8) p0_item_dual(a.in[7], DFF, D, kb * 64, nb * 32, (bf16*)(ws + WS_WGU) + (size_t)ileave(nb * 32, 0) * D, ws + WS_WGU8 + (size_t)ileave(nb * 32, 0) * D, a.in[6], WGU8_SCALE, scr, lane);
            else p0_item(a.in[7], DFF, D, kb * 64, nb * 32, (bf16*)(ws + WS_WGU) + (size_t)ileave(nb * 32, 0) * D, a.in[6], scr, lane); continue; } r -= I_G;
        if (r < I_G) { const int kb = r / 112, nb = r % 112;
            if (FFN8) p0_item_dual(a.in[8], DFF, D, kb * 64, nb * 32, (bf16*)(ws + WS_WGU) + (size_t)ileave(nb * 32, 1) * D, ws + WS_WGU8 + (size_t)ileave(nb * 32, 1) * D, a.in[6], WGU8_SCALE, scr, lane);
            else p0_item(a.in[8], DFF, D, kb * 64, nb * 32, (bf16*)(ws + WS_WGU) + (size_t)ileave(nb * 32, 1) * D, a.in[6], scr, lane); continue; } r -= I_G;
        if (r < I_DN) { const int kb = r / 32, nb = r % 32;
            if (FFN8) p0_item_dual(a.in[9], D, DFF, kb * 64, nb * 32, (bf16*)(ws + WS_WD) + (size_t)(nb * 32) * DFF, ws + WS_WD8 + (size_t)(nb * 32) * DFF, nullptr, WD8_SCALE, scr, lane);
            else p0_item(a.in[9], D, DFF, kb * 64, nb * 32, (bf16*)(ws + WS_WD) + (size_t)(nb * 32) * DFF, nullptr, scr, lane); continue; } r -= I_DN;
        if (r < I_QKV) { const int kb = r / 48, nb = r % 48, n0 = nb * 32; int d0;
            if (n0 < D + KVD) { const int c = n0 & 255; d0 = (n0 & ~255) + 128 * ((c >> 5) & 1) + 32 * (c >> 6); } else d0 = n0;
            p0_item(a.in[11], NQKV, D, kb * 64, n0, (bf16*)(ws + WS_WQKV) + (size_t)d0 * D, a.in[10], scr, lane); continue; } r -= I_QKV;
        if (r < I_WO) { const int kb = r / 32, nb = r % 32; p0_item(a.in[14], D, D, kb * 64, nb * 32, (bf16*)(ws + WS_WO) + (size_t)(nb * 32) * D, nullptr, scr, lane); continue; } r -= I_WO;
        { const int mat = r / I_G, q = r % I_G, kind = mat >> 3, e = mat & 7;
          if (kind < 2) { const int kb = q / 112, nb = q % 112;
              p0_item8(a.in[17 + kind] + (size_t)e * D * DFF, DFF, D, kb * 64, nb * 32, ws + WS_EWGU + ((size_t)e * NGU + ileave(nb * 32, kind)) * D, a.in[15], WGU_SCALE, scr, lane); }
          else { const int kb = q / 32, nb = q % 32;
              p0_item8(a.in[19] + (size_t)e * DFF * D, D, DFF, kb * 64, nb * 32, ws + WS_EWD + ((size_t)e * D + nb * 32) * DFF, nullptr, WD_SCALE, scr, lane); } }
    }
#endif
    {
        bf16* hb = (bf16*)(ws + WS_HB); float* ssq = (float*)(ws + WS_SSQ);
        constexpr int RB = 4;
        auto xload = [&](int m0, f32x4 (&v)[RB][4]) {
#pragma unroll
            for (int q = 0; q < RB; ++q) { const int m = m0 + q * NGW < M + NMETA ? m0 + q * NGW : m0; const bool meta = m >= M;
                const GAS f32x4* xr = (const GAS f32x4*)(meta ? a.in[1] + (size_t)(m - M) * D : a.in[0] + (size_t)m * D) + lane;
#pragma unroll
                for (int j = 0; j < 4; ++j) v[q][j] = xr[64 * j]; }
        };
        auto xstore = [&](int m0, const f32x4 (&v)[RB][4]) {
#pragma unroll
            for (int q = 0; q < RB; ++q) { const int m = m0 + q * NGW; if (m >= M + NMETA) break; const bool meta = m >= M;
                float s = 0.f;
#pragma unroll
                for (int j = 0; j < 4; ++j) s += (v[q][j].x * v[q][j].x + v[q][j].y * v[q][j].y) + (v[q][j].z * v[q][j].z + v[q][j].w * v[q][j].w);
                s = wave_sum(s);
                bf16* orow = meta ? (bf16*)(ws + WS_MISC + MS_MB) + (size_t)(m - M) * D : hb + (size_t)m * D;
                GAS unsigned long long* o8 = (GAS unsigned long long*)orow + lane;
#pragma unroll
                for (int j = 0; j < 4; ++j) o8[64 * j] = (unsigned long long)pk2(v[q][j].x, v[q][j].y) | ((unsigned long long)pk2(v[q][j].z, v[q][j].w) << 32);
                if (meta) { if (lane == 0) ((float*)(ws + WS_MISC + MS_SSQ0))[m - M] = s; }
                else if (lane < 16) ssq[(size_t)m * 16 + lane] = lane == 0 ? s : 0.f; }
        };
        f32x4 va[RB][4], vb[RB][4];
        int m0 = gw;
        if (m0 < M + NMETA) xload(m0, va);
        while (m0 < M + NMETA) {
            const int m1 = m0 + RB * NGW; const bool more = m1 < M + NMETA;
            if (more) xload(m1, vb);
            xstore(m0, va);
            if (!more) break;
            const int m2 = m1 + RB * NGW; const bool more2 = m2 < M + NMETA;
            if (more2) xload(m2, va);
            xstore(m1, vb);
            m0 = m2;
        }
    }
    {
        f32x2* rope = (f32x2*)(ws + WS_ROPE);
        const int gt = gw * 64 + lane, NGT = NGW * 64;
        for (int idx = gt; idx < LPOS * 32; idx += NGT) {
            const int p = idx >> 5, f = idx & 31; const float ang = (float)p * a.inv[f];
            const double rev = (double)ang * 0.15915494309189535; const float fr = (float)(rev - rint(rev));
            rope[idx] = (f32x2){__builtin_amdgcn_cosf(fr), __builtin_amdgcn_sinf(fr)};
        }
    }
}

__device__ __forceinline__ void unpack8(const u32x4 w, float (&f)[8]) { f[0] = bflo(w.x); f[1] = bfhi(w.x); f[2] = bflo(w.y); f[3] = bfhi(w.y); f[4] = bflo(w.z); f[5] = bfhi(w.z); f[6] = bflo(w.w); f[7] = bfhi(w.w); }
__device__ __forceinline__ void conv_phase(const Args& a, int G, int tid) {
    unsigned char* ws = a.ws;
    const bf16* Bc = (const bf16*)(ws + WS_BC); const bf16* Vc = (const bf16*)(ws + WS_VC); bf16* Yc = (bf16*)(ws + WS_YC);
    const float* vm = (const float*)(ws + WS_MISC + MS_VM); const float* cw = a.in[4];
    const int cg = tid & 127, strip = tid >> 7, ch0 = cg * 8;
    float w0[8], w1[8], w2[8];
#pragma unroll
    for (int e = 0; e < 8; ++e) { w0[e] = cw[ch0 + e]; w1[e] = cw[D + ch0 + e]; w2[e] = cw[2 * D + ch0 + e]; }
    for (int blk = blockIdx.x; blk < M / 128; blk += G) {
        const int r0 = blk * 128 + strip * 32;
        float p2[8], p1[8];
        if ((r0 & (SEQ - 1)) == 0) {
#pragma unroll
            for (int e = 0; e < 8; ++e) { p2[e] = vm[14 * D + ch0 + e]; p1[e] = vm[15 * D + ch0 + e]; }
        } else { unpack8(*(const u32x4*)(Vc + (size_t)(r0 - 2) * D + ch0), p2); unpack8(*(const u32x4*)(Vc + (size_t)(r0 - 1) * D + ch0), p1); }
#if CONV_BATCH
        const GAS char* vp = (const GAS char*)Vc + ((size_t)r0 * D + ch0) * 2; const GAS char* bp = (const GAS char*)Bc + ((size_t)r0 * D + ch0) * 2; GAS char* yp = (GAS char*)Yc + ((size_t)r0 * D + ch0) * 2;
        u32x4 vq[2][8], bq[2][8];
#pragma unroll
        for (int i = 0; i < 8; ++i) { vq[0][i] = *(const GAS u32x4*)(vp + i * (D * 2)); bq[0][i] = *(const GAS u32x4*)(bp + i * (D * 2)); }
#pragma unroll
        for (int bt = 0; bt < 4; ++bt) {
            if (bt + 1 < 4) {
#pragma unroll
                for (int i = 0; i < 8; ++i) { vq[(bt + 1) & 1][i] = *(const GAS u32x4*)(vp + ((bt + 1) * 8 + i) * (D * 2)); bq[(bt + 1) & 1][i] = *(const GAS u32x4*)(bp + ((bt + 1) * 8 + i) * (D * 2)); }
            }
#pragma unroll
            for (int i = 0; i < 8; ++i) {
                float v[8], b[8]; unpack8(vq[bt & 1][i], v); unpack8(bq[bt & 1][i], b);
                float y[8];
#pragma unroll
                for (int e = 0; e < 8; ++e) { y[e] = b[e] * (w0[e] * p2[e] + w1[e] * p1[e] + w2[e] * v[e]); p2[e] = p1[e]; p1[e] = v[e]; }
                u32x4 o; o.x = cvt_pk_bf16(y[0], y[1]); o.y = cvt_pk_bf16(y[2], y[3]); o.z = cvt_pk_bf16(y[4], y[5]); o.w = cvt_pk_bf16(y[6], y[7]);
                if (YC_NT) __builtin_nontemporal_store(o, (GAS u32x4*)(yp + (bt * 8 + i) * (D * 2))); else *(GAS u32x4*)(yp + (bt * 8 + i) * (D * 2)) = o;
            }
        }
    }
#else
#pragma unroll 4
        for (int rr = 0; rr < 32; ++rr) {
            const size_t off = (size_t)(r0 + rr) * D + ch0;
            float v[8], b[8]; unpack8(*(const u32x4*)(Vc + off), v); unpack8(*(const u32x4*)(Bc + off), b);
            float y[8];
#pragma unroll
            for (int e = 0; e < 8; ++e) { y[e] = b[e] * (w0[e] * p2[e] + w1[e] * p1[e] + w2[e] * v[e]); p2[e] = p1[e]; p1[e] = v[e]; }
            u32x4 o; o.x = cvt_pk_bf16(y[0], y[1]); o.y = cvt_pk_bf16(y[2], y[3]); o.z = cvt_pk_bf16(y[4], y[5]); o.w = cvt_pk_bf16(y[6], y[7]);
            __builtin_nontemporal_store(o, (u32x4*)(Yc + off));
        }
    }
#endif
    if (blockIdx.x == (unsigned)(G - 1)) {
        const float* bm = (const float*)(ws + WS_MISC + MS_BM); bf16* ycm = (bf16*)(ws + WS_MISC + MS_YCM);
        for (int idx = tid; idx < NMETA * D; idx += NWAVES * 64) {
            const int i = idx >> 10, ch = idx & (D - 1);
            const float v0 = i >= 2 ? vm[(i - 2) * D + ch] : 0.f, v1 = i >= 1 ? vm[(i - 1) * D + ch] : 0.f, v2 = vm[i * D + ch];
            ycm[idx] = (bf16)f2bf(bm[idx] * (cw[ch] * v0 + cw[D + ch] * v1 + cw[2 * D + ch] * v2));
        }
    }
}

constexpr int KIMG_ROW = 144, AT_NSLOT = 3, KIMG_BYTES = AT_NSLOT * 128 * KIMG_ROW, VT_ROW = AT_NSLOT * 128 * 2 + 8, VT_BYTES = 64 * VT_ROW;
static_assert(KIMG_BYTES + VT_BYTES <= RING_BYTES, "attention LDS");
constexpr int QPRE_N = 2;
template <int QI, bool FIRST>
__device__ __forceinline__ void attn_qgroup(const LAS unsigned char* kimg, const LAS unsigned char* vimg, int pbase, int cbase, const bf16x8 (&qf)[4], bf16x8 (&qpre)[4], const bf16* qn, bf16* Og, float sk, int lane) {
    const int q = lane & 31, h = lane >> 5;
    f32x16 S[5];
#pragma unroll
    for (int bi = 0; bi < 5; ++bi) S[bi] = (f32x16){};
#pragma unroll
    for (int s = 0; s < 4; ++s)
#pragma unroll
        for (int bi = 0; bi < 5; ++bi) {
            const int rowbase = (bi < 4 - QI) ? pbase + 32 * (QI + bi) : cbase + 32 * (bi - (4 - QI));
            const bf16x8 kf = *(const LAS bf16x8*)(kimg + (rowbase + q) * KIMG_ROW + (16 * s + 8 * h) * 2);
            S[bi] = __builtin_amdgcn_mfma_f32_32x32x16_bf16(kf, qf[s], S[bi], 0, 0, 0);
        }
    if (QI & 1) {
#pragma unroll
        for (int s = 0; s < QPRE_N; ++s) qpre[s] = *(const GAS bf16x8*)(qn + 16 * s);
    }
    int tq = q - 4 * h; asm volatile("" : "+v"(tq));
    float mx = sk;
#pragma unroll
    for (int bi = 0; bi < 5; ++bi) {
        const bool prev = bi < 4 - QI; const int kb = prev ? QI + bi : bi - (4 - QI);
#pragma unroll
        for (int r = 0; r < 16; ++r) {
            const int cr = (r & 3) + 8 * (r >> 2);
            float sv = S[bi][r];
            if (prev) {
                if (FIRST) { if (kb < 3) sv = -INFINITY; else { if (!(cr + 4 * h >= 16)) sv = -INFINITY; if (kb == QI && !(cr > tq)) sv = -INFINITY; } }
                else if (kb == QI) { if (!(cr > tq)) sv = -INFINITY; }
            } else if (kb == QI) { if (!(cr <= tq)) sv = -INFINITY; }
            S[bi][r] = sv; mx = fmaxf(mx, sv);
        }
    }
    mx = fmaxf(mx, __shfl_xor(mx, 32));
    float l = 0.f;
#pragma unroll
    for (int bi = 0; bi < 5; ++bi)
#pragma unroll
        for (int r = 0; r < 16; ++r) { const float p = __builtin_amdgcn_exp2f(S[bi][r] - mx); S[bi][r] = p; l += p; }
    l += __shfl_xor(l, 32); l += __builtin_amdgcn_exp2f(sk - mx);
    f32x16 O[2][2];
#pragma unroll
    for (int c = 0; c < 2; ++c) { O[c][0] = (f32x16){}; O[c][1] = (f32x16){}; }
#pragma unroll
    for (int bi = 0; bi < 5; ++bi) {
        const int rowbase = (bi < 4 - QI) ? pbase + 32 * (QI + bi) : cbase + 32 * (bi - (4 - QI));
#pragma unroll
        for (int s2 = 0; s2 < 2; ++s2) {
            u32x4 pw; pw.x = cvt_pk_bf16(S[bi][8 * s2 + 0], S[bi][8 * s2 + 1]); pw.y = cvt_pk_bf16(S[bi][8 * s2 + 2], S[bi][8 * s2 + 3]);
            pw.z = cvt_pk_bf16(S[bi][8 * s2 + 4], S[bi][8 * s2 + 5]); pw.w = cvt_pk_bf16(S[bi][8 * s2 + 6], S[bi][8 * s2 + 7]);
            const bf16x8 pf = __builtin_bit_cast(bf16x8, pw);
#pragma unroll
            for (int c = 0; c < 2; ++c) {
                const LAS unsigned char* vp = vimg + (32 * c + q) * VT_ROW + (rowbase + 16 * s2 + 4 * h) * 2;
                const u32x2 lo = *(const LAS u32x2*)vp, hi = *(const LAS u32x2*)(vp + 16);
                const u32x4 vw = (u32x4){lo.x, lo.y, hi.x, hi.y};
                O[c][s2] = __builtin_amdgcn_mfma_f32_32x32x16_bf16(__builtin_bit_cast(bf16x8, vw), pf, O[c][s2], 0, 0, 0);
            }
        }
    }
    const float inv = __builtin_amdgcn_rcpf(l);
    bf16* orow = Og + (size_t)(32 * QI + q) * D;
#pragma unroll
    for (int c = 0; c < 2; ++c)
#pragma unroll
        for (int u4 = 0; u4 < 4; ++u4) {
            u32x2 w; w.x = cvt_pk_bf16((O[c][0][4 * u4 + 0] + O[c][1][4 * u4 + 0]) * inv, (O[c][0][4 * u4 + 1] + O[c][1][4 * u4 + 1]) * inv);
            w.y = cvt_pk_bf16((O[c][0][4 * u4 + 2] + O[c][1][4 * u4 + 2]) * inv, (O[c][0][4 * u4 + 3] + O[c][1][4 * u4 + 3]) * inv);
            *(u32x2*)(orow + 32 * c + 8 * u4 + 4 * h) = w;
        }
}
__device__ __forceinline__ void attn_load_block(const bf16* Kb, const bf16* Vb, const bf16* Km, const bf16* Vm, int b, int kvh, int jb, int tid, u32x4 (&kv)[2], u32x4 (&vv)[2]) {
#pragma unroll
    for (int ii = 0; ii < 2; ++ii) {
        const int c = tid + 512 * ii, row = c >> 3, ch = c & 7;
        kv[ii] = (u32x4){0u, 0u, 0u, 0u}; vv[ii] = (u32x4){0u, 0u, 0u, 0u};
        if (jb >= 0) { const size_t off = (size_t)(b * SEQ + 128 * jb + row) * KVD + kvh * HD + ch * 8; kv[ii] = *(const u32x4*)(Kb + off); vv[ii] = *(const u32x4*)(Vb + off); }
        else if (row >= 112) { const size_t off = (size_t)(row - 112) * KVD + kvh * HD + ch * 8; kv[ii] = *(const u32x4*)(Km + off); vv[ii] = *(const u32x4*)(Vm + off); }
    }
}
__device__ __forceinline__ void attn_store_block(LAS unsigned char* kimg, LAS unsigned char* vimg, int slot, int tid, const u32x4 (&kv)[2], const u32x4 (&vv)[2]) {
#pragma unroll
    for (int ii = 0; ii < 2; ++ii) {
        const int c = tid + 512 * ii, row = slot * 128 + (c >> 3), ch = c & 7;
        *(LAS u32x4*)(kimg + row * KIMG_ROW + ch * 16) = kv[ii];
        LAS unsigned short* vt = (LAS unsigned short*)(vimg + (ch * 8) * VT_ROW + row * 2);
        vt[0 * (VT_ROW / 2)] = (unsigned short)(vv[ii].x & 0xffffu); vt[1 * (VT_ROW / 2)] = (unsigned short)(vv[ii].x >> 16);
        vt[2 * (VT_ROW / 2)] = (unsigned short)(vv[ii].y & 0xffffu); vt[3 * (VT_ROW / 2)] = (unsigned short)(vv[ii].y >> 16);
        vt[4 * (VT_ROW / 2)] = (unsigned short)(vv[ii].z & 0xffffu); vt[5 * (VT_ROW / 2)] = (unsigned short)(vv[ii].z >> 16);
        vt[6 * (VT_ROW / 2)] = (unsigned short)(vv[ii].w & 0xffffu); vt[7 * (VT_ROW / 2)] = (unsigned short)(vv[ii].w >> 16);
    }
}
__device__ __forceinline__ void attn_phase(const Args& a, LAS unsigned char* lds, int vcu, int G, int tid, int wave, int lane) {
    unsigned char* ws = a.ws;
    const bf16* Q = (const bf16*)(ws + WS_Q); const bf16* Kb = (const bf16*)(ws + WS_KB); const bf16* Vb = (const bf16*)(ws + WS_VB);
    const bf16* Km = (const bf16*)(ws + WS_MISC + MS_KM); const bf16* Vm = (const bf16*)(ws + WS_MISC + MS_VMETA);
    LAS unsigned char* kimg = lds; LAS unsigned char* vimg = lds + KIMG_BYTES;
    constexpr int NUNITS = BATCH * NKVH * (SEQ / 128);
    const int per = (NUNITS + G - 1) / G;
    const int g = wave >> 1, half = wave & 1, q = lane & 31, h = lane >> 5;
    bf16x8 qf[2][4];
    for (int i = 0; i < per; ++i) {
        const int uid = vcu * per + i; if (uid >= NUNITS) break;
        const int b = uid >> 8, kvh = (uid >> 6) & 3, j = uid & 63; const int Rb = b * SEQ + 128 * j;
        const int hq = kvh * 4 + g;
#pragma unroll
        for (int qg = 0; qg < 2; ++qg) {
#pragma unroll
            for (int s = 0; s < 4; ++s) if (!(qg == 0 && i != 0 && s < QPRE_N)) qf[qg][s] = *(const GAS bf16x8*)(Q + (size_t)(Rb + 64 * half + 32 * qg + q) * D + hq * HD + 16 * s + 8 * h); }
        const bf16* qn;
        { const int un = (i + 1 < per && uid + 1 < NUNITS) ? uid + 1 : uid; const int bn = un >> 8, kvhn = (un >> 6) & 3, jn = un & 63;
          qn = Q + (size_t)(bn * SEQ + 128 * jn + 64 * half + q) * D + (kvhn * 4 + g) * HD + 8 * h; }
        const bool fresh = (i == 0) || (j == 0);
        if (fresh) {
            __syncthreads();
            u32x4 kv[2], vv[2], kv2[2], vv2[2];
            attn_load_block(Kb, Vb, Km, Vm, b, kvh, j - 1, tid, kv, vv); attn_load_block(Kb, Vb, Km, Vm, b, kvh, j, tid, kv2, vv2);
            attn_store_block(kimg, vimg, (j + 2) % 3, tid, kv, vv);      attn_store_block(kimg, vimg, j % 3, tid, kv2, vv2);
        }
        __syncthreads();
        const bool pre = (i + 1 < per) && (uid + 1 < NUNITS) && (j + 1 < 64);
        u32x4 nk[2], nv[2];
        if (pre) attn_load_block(Kb, Vb, Km, Vm, b, kvh, j + 1, tid, nk, nv);
        const float sk = a.in[13][hq] * LOG2E;
        bf16* Og = (bf16*)(ws + WS_O) + (size_t)Rb * D + hq * HD;
        const int pbase = ((j + 2) % 3) * 128, cbase = (j % 3) * 128;
        if (j != 0) {
            if (half == 0) { attn_qgroup<0, false>(kimg, vimg, pbase, cbase, qf[0], qf[0], qn, Og, sk, lane); attn_qgroup<1, false>(kimg, vimg, pbase, cbase, qf[1], qf[0], qn, Og, sk, lane); }
            else           { attn_qgroup<2, false>(kimg, vimg, pbase, cbase, qf[0], qf[0], qn, Og, sk, lane); attn_qgroup<3, false>(kimg, vimg, pbase, cbase, qf[1], qf[0], qn, Og, sk, lane); }
        } else {
            if (half == 0) { attn_qgroup<0, true>(kimg, vimg, pbase, cbase, qf[0], qf[0], qn, Og, sk, lane); attn_qgroup<1, true>(kimg, vimg, pbase, cbase, qf[1], qf[0], qn, Og, sk, lane); }
            else           { attn_qgroup<2, true>(kimg, vimg, pbase, cbase, qf[0], qf[0], qn, Og, sk, lane); attn_qgroup<3, true>(kimg, vimg, pbase, cbase, qf[1], qf[0], qn, Og, sk, lane); }
        }
        if (pre) attn_store_block(kimg, vimg, (j + 1) % 3, tid, nk, nv);
    }
    __syncthreads();
}

#if ROUTE_MFMA
__device__ __forceinline__ void route_phase(const Args& a, LAS unsigned char* lds, unsigned* ctl, int G, int tid, int wave, int lane) {
    unsigned char* ws = a.ws;
    constexpr int WROW = 2 * D + 16;
    LAS unsigned char* wimg = lds;
    LAS int* cntL = (LAS int*)(lds + 36864); LAS int* baseL = (LAS int*)(lds + 36864 + 64);
    LAS float* lsc = (LAS float*)(lds + 40960 + wave * 512);
    const float* Wr = a.in[16]; const float* gm = a.in[15];
    for (int idx = tid; idx < NE * D; idx += NWAVES * 64) { const int e = idx & 7, k = idx >> 3; const float w = Wr[idx] * gm[k];
        const unsigned hi = f2bf(w); const float rem = w - __uint_as_float(hi << 16); const unsigned lo = f2bf(rem);
        *(LAS unsigned short*)(wimg + e * WROW + k * 2) = (unsigned short)hi; *(LAS unsigned short*)(wimg + (8 + e) * WROW + k * 2) = (unsigned short)lo; }
    const bf16* hsrc = (const bf16*)(ws + WS_HB);
    unsigned char* xq = ws + WS_XQ;
    int* list = (int*)(ws + WS_LIST); u32x2* tokep = (u32x2*)(ws + WS_TOKEP); f32x2* tokg = (f32x2*)(ws + WS_TOKG);
    const int r16 = lane & 15, kq = lane >> 4;
    for (int blk = blockIdx.x; blk < M / 128; blk += G) {
        __syncthreads();
        if (tid < 8) cntL[tid] = 0;
        __syncthreads();
        const int rbase = blk * 128 + wave * 16;
        const GAS char* xp = (const GAS char*)hsrc + ((size_t)(rbase + r16) * D + 8 * kq) * 2;
        f32x4 acc = (f32x4){0.f, 0.f, 0.f, 0.f}; float ss = 0.f;
        {
            u32x4 xa[8], xb[8];
#pragma unroll
            for (int j = 0; j < 8; ++j) xa[j] = *(const GAS u32x4*)(xp + j * 64);
#pragma unroll
            for (int c = 0; c < 4; ++c) {
                if (c + 1 < 4) {
#pragma unroll
                    for (int j = 0; j < 8; ++j) { if ((c & 1) == 0) xb[j] = *(const GAS u32x4*)(xp + ((c + 1) * 8 + j) * 64); else xa[j] = *(const GAS u32x4*)(xp + ((c + 1) * 8 + j) * 64); }
                }
#pragma unroll
                for (int j = 0; j < 8; ++j) {
                    const int s = c * 8 + j; const u32x4 w = (c & 1) == 0 ? xa[j] : xb[j];
                    const bf16x8 wf = *(const LAS bf16x8*)(wimg + r16 * WROW + (32 * s + 8 * kq) * 2);
                    acc = __builtin_amdgcn_mfma_f32_16x16x32_bf16(__builtin_bit_cast(bf16x8, w), wf, acc, 0, 0, 0);
                    const float x0 = bflo(w.x), x1 = bfhi(w.x), x2 = bflo(w.y), x3 = bfhi(w.y), x4 = bflo(w.z), x5 = bfhi(w.z), x6 = bflo(w.w), x7 = bfhi(w.w);
                    ss += ((x0 * x0 + x1 * x1) + (x2 * x2 + x3 * x3)) + ((x4 * x4 + x5 * x5) + (x6 * x6 + x7 * x7));
                }
                __builtin_amdgcn_sched_barrier(0);
            }
        }
        ss += __shfl_xor(ss, 16); ss += __shfl_xor(ss, 32);
        const float rstd = 1.0f / sqrtf(ss * (1.0f / (float)D) + RMS_EPS);
        { const float sc = rstd * XQ_SCALE; GAS unsigned char* xr = (GAS unsigned char*)xq + (size_t)(rbase + r16) * D + 8 * kq;
          u32x4 xa[8], xb[8];
#pragma unroll
          for (int j = 0; j < 8; ++j) xa[j] = *(const GAS u32x4*)(xp + j * 64);
#pragma unroll
          for (int c = 0; c < 4; ++c) {
              if (c + 1 < 4) {
#pragma unroll
                  for (int j = 0; j < 8; ++j) { if ((c & 1) == 0) xb[j] = *(const GAS u32x4*)(xp + ((c + 1) * 8 + j) * 64); else xa[j] = *(const GAS u32x4*)(xp + ((c + 1) * 8 + j) * 64); }
              }
#pragma unroll
              for (int j = 0; j < 8; ++j) { const int s = c * 8 + j; const u32x4 w = (c & 1) == 0 ? xa[j] : xb[j];
                  *(GAS u32x2*)(xr + 32 * s) = (u32x2){pk4_fp8(bflo(w.x) * sc, bfhi(w.x) * sc, bflo(w.y) * sc, bfhi(w.y) * sc), pk4_fp8(bflo(w.z) * sc, bfhi(w.z) * sc, bflo(w.w) * sc, bfhi(w.w) * sc)}; }
              __builtin_amdgcn_sched_barrier(0);
          } }
#pragma unroll
        for (int i = 0; i < 4; ++i) acc[i] += __shfl_xor(acc[i], 8);
        if (r16 < 8) {
#pragma unroll
            for (int i = 0; i < 4; ++i) lsc[(4 * kq + i) * 8 + r16] = acc[i];
        }
        LDS_WAIT(); asm volatile("" ::: "memory");
        int my_e1 = -1, my_e2 = -1; float my_g1 = 0.f, my_g2 = 0.f;
        {
            const f32x4 l0 = *(const LAS f32x4*)(lsc + (lane & 15) * 8), l1 = *(const LAS f32x4*)(lsc + (lane & 15) * 8 + 4);
            float lg[8] = {l0.x * rstd, l0.y * rstd, l0.z * rstd, l0.w * rstd, l1.x * rstd, l1.y * rstd, l1.z * rstd, l1.w * rstd};
            int e1 = 0; float v1 = lg[0];
#pragma unroll
            for (int e = 1; e < 8; ++e) if (lg[e] > v1) { v1 = lg[e]; e1 = e; }
            int e2 = -1; float v2 = -INFINITY;
#pragma unroll
            for (int e = 0; e < 8; ++e) if (e != e1 && lg[e] > v2) { v2 = lg[e]; e2 = e; }
            const float g1 = 1.0f / (1.0f + expf(v2 - v1));
            if (lane < 16) { my_e1 = e1; my_e2 = e2; my_g1 = g1; my_g2 = 1.0f - g1; }
        }
        unsigned long long mk[8]; int wb = 0;
#pragma unroll
        for (int e = 0; e < 8; ++e) { mk[e] = __ballot(my_e1 == e || my_e2 == e); if (lane == e) wb = __popcll(mk[e]); }
        if (lane < 8) wb = atomicAdd((int*)(cntL + lane), wb);
        __syncthreads();
        if (tid < 8) baseL[tid] = (int)__hip_atomic_fetch_add(ctl + CW_CNT + 64 * tid, (unsigned)cntL[tid], RLX_AGENT);
        __syncthreads();
        {
            int pos1 = 0, pos2 = 0;
#pragma unroll
            for (int e = 0; e < 8; ++e) {
                const int wbe = __shfl(wb, e); const int p = baseL[e] + wbe + __popcll(mk[e] & ((1ull << lane) - 1ull));
                if (my_e1 == e) pos1 = p; if (my_e2 == e) pos2 = p;
            }
            if (lane < 16) {
                const int tok = rbase + lane;
                list[(size_t)my_e1 * M + pos1] = tok; list[(size_t)my_e2 * M + pos2] = tok;
                tokep[tok] = (u32x2){((unsigned)my_e1 << 28) | (unsigned)pos1, ((unsigned)my_e2 << 28) | (unsigned)pos2};
                tokg[tok] = (f32x2){my_g1, my_g2};
            }
        }
    }
    __syncthreads();
}
#else
__device__ __forceinline__ void route_phase(const Args& a, LAS unsigned char* lds, unsigned* ctl, int G, int tid, int wave, int lane) {
    unsigned char* ws = a.ws;
    LAS float* wr_l = (LAS float*)lds;
    LAS int* cntL = (LAS int*)(lds + 32768); LAS int* baseL = (LAS int*)(lds + 32768 + 64);
    const float* Wr = a.in[16]; const float* gm = a.in[15];
    for (int idx = tid; idx < NE * D; idx += NWAVES * 64) { const int e = idx >> 10, k = idx & (D - 1); wr_l[idx] = Wr[k * NE + e] * gm[k]; }
    const bf16* hsrc = (const bf16*)(ws + WS_HB);
    unsigned char* xq = ws + WS_XQ;
    int* list = (int*)(ws + WS_LIST); u32x2* tokep = (u32x2*)(ws + WS_TOKEP); f32x2* tokg = (f32x2*)(ws + WS_TOKG);
    for (int blk = blockIdx.x; blk < M / 128; blk += G) {
        __syncthreads();
        if (tid < 8) cntL[tid] = 0;
        __syncthreads();
        int my_e1 = -1, my_e2 = -1; float my_g1 = 0.f, my_g2 = 0.f;
        const int rbase = blk * 128 + wave * 16;
        constexpr int RB = 2;
        u32x2 nx[RB][4];
#pragma unroll
        for (int q = 0; q < RB; ++q)
#pragma unroll
            for (int j = 0; j < 4; ++j) nx[q][j] = *(const GAS u32x2*)(hsrc + (size_t)(rbase + q) * D + 4 * lane + 256 * j);
        for (int jj0 = 0; jj0 < 16; jj0 += RB) {
            f32x4 hv[RB][4]; float s[RB], d[RB][8];
#pragma unroll
            for (int q = 0; q < RB; ++q) { s[q] = 0.f;
#pragma unroll
                for (int j = 0; j < 4; ++j) { const u32x2 w = nx[q][j]; hv[q][j] = (f32x4){bflo(w.x), bfhi(w.x), bflo(w.y), bfhi(w.y)};
                    s[q] += (hv[q][j].x * hv[q][j].x + hv[q][j].y * hv[q][j].y) + (hv[q][j].z * hv[q][j].z + hv[q][j].w * hv[q][j].w); } }
            { const int jn = jj0 + RB < 16 ? jj0 + RB : jj0;
#pragma unroll
              for (int q = 0; q < RB; ++q)
#pragma unroll
                  for (int j = 0; j < 4; ++j) nx[q][j] = *(const GAS u32x2*)(hsrc + (size_t)(rbase + jn + q) * D + 4 * lane + 256 * j); }
#pragma unroll
            for (int e = 0; e < 8; ++e) {
#pragma unroll
                for (int q = 0; q < RB; ++q) d[q][e] = 0.f;
#pragma unroll
                for (int j = 0; j < 4; ++j) { const f32x4 w = *(const LAS f32x4*)(wr_l + e * D + 4 * lane + 256 * j);
#pragma unroll
                    for (int q = 0; q < RB; ++q) d[q][e] += (hv[q][j].x * w.x + hv[q][j].y * w.y) + (hv[q][j].z * w.z + hv[q][j].w * w.w); } }
#pragma unroll
            for (int o = 1; o < 64; o <<= 1) {
#pragma unroll
                for (int q = 0; q < RB; ++q) { s[q] += __shfl_xor(s[q], o);
#pragma unroll
                    for (int e = 0; e < 8; ++e) d[q][e] += __shfl_xor(d[q][e], o); } }
#pragma unroll
            for (int q = 0; q < RB; ++q) {
                const int jj = jj0 + q;
                const float rstd = 1.0f / sqrtf(s[q] * (1.0f / (float)D) + RMS_EPS);
                { const float sc = rstd * XQ_SCALE; unsigned char* xr = xq + (size_t)(rbase + jj) * D + 4 * lane;
#pragma unroll
                  for (int j = 0; j < 4; ++j) *(unsigned*)(xr + 256 * j) = pk4_fp8(hv[q][j].x * sc, hv[q][j].y * sc, hv[q][j].z * sc, hv[q][j].w * sc); }
                float lg[8];
#pragma unroll
                for (int e = 0; e < 8; ++e) lg[e] = d[q][e] * rstd;
                int e1 = 0; float v1 = lg[0];
#pragma unroll
                for (int e = 1; e < 8; ++e) if (lg[e] > v1) { v1 = lg[e]; e1 = e; }
                int e2 = -1; float v2 = -INFINITY;
#pragma unroll
                for (int e = 0; e < 8; ++e) if (e != e1 && lg[e] > v2) { v2 = lg[e]; e2 = e; }
                const float g1 = 1.0f / (1.0f + expf(v2 - v1));
                if (lane == jj) { my_e1 = e1; my_e2 = e2; my_g1 = g1; my_g2 = 1.0f - g1; }
            }
        }
        unsigned long long mk[8]; int wb = 0;
#pragma unroll
        for (int e = 0; e < 8; ++e) { mk[e] = __ballot(my_e1 == e || my_e2 == e); if (lane == e) wb = __popcll(mk[e]); }
        if (lane < 8) wb = atomicAdd((int*)(cntL + lane), wb);
        __syncthreads();
        if (tid < 8) baseL[tid] = (int)__hip_atomic_fetch_add(ctl + CW_CNT + 64 * tid, (unsigned)cntL[tid], RLX_AGENT);
        __syncthreads();
        {
            int pos1 = 0, pos2 = 0;
#pragma unroll
            for (int e = 0; e < 8; ++e) {
                const int wbe = __shfl(wb, e); const int p = baseL[e] + wbe + __popcll(mk[e] & ((1ull << lane) - 1ull));
                if (my_e1 == e) pos1 = p; if (my_e2 == e) pos2 = p;
            }
            if (lane < 16) {
                const int tok = rbase + lane;
                list[(size_t)my_e1 * M + pos1] = tok; list[(size_t)my_e2 * M + pos2] = tok;
                tokep[tok] = (u32x2){((unsigned)my_e1 << 28) | (unsigned)pos1, ((unsigned)my_e2 << 28) | (unsigned)pos2};
                tokg[tok] = (f32x2){my_g1, my_g2};
            }
        }
    }
    __syncthreads();
}

#endif
__device__ __forceinline__ void unpack8_fp8(const u32x2 w, float (&f)[8]) {
    const f32x2 a = __builtin_amdgcn_cvt_pk_f32_fp8((int)w.x, false), b = __builtin_amdgcn_cvt_pk_f32_fp8((int)w.x, true), c = __builtin_amdgcn_cvt_pk_f32_fp8((int)w.y, false), d = __builtin_amdgcn_cvt_pk_f32_fp8((int)w.y, true);
    f[0] = a.x; f[1] = a.y; f[2] = b.x; f[3] = b.y; f[4] = c.x; f[5] = c.y; f[6] = d.x; f[7] = d.y;
}
__device__ __forceinline__ void final_y_tail(const bf16* YP, size_t s, int k, float (&y)[8]) {
    const int T = (int)(s >> 8);
    const bf16* p = YP + ((size_t)((T - DOWN_MAIN_TILES) * 4 + (k >> 8)) * DOWN_KS) * 65536 + (size_t)(s & 255) * 256 + (k & 255);
#pragma unroll
    for (int e = 0; e < 8; ++e) y[e] = 0.f;
#pragma unroll
    for (int ks = 0; ks < DOWN_KS; ++ks) { float t[8]; unpack8(*(const u32x4*)(p + (size_t)ks * 65536), t);
#pragma unroll
        for (int e = 0; e < 8; ++e) y[e] += t[e]; }
}
__device__ __forceinline__ void final_phase(const Args& a, unsigned* ctl, int vcu, int G, int wave, int lane) {
    unsigned char* ws = a.ws;
    MoeInfo mi; moe_info_load(ctl, mi);
    const bf16* hb = (const bf16*)(ws + WS_HB); const unsigned char* Y = ws + WS_Y; const bf16* YP = (const bf16*)(ws + WS_YP);
    const u32x2* tokep = (const u32x2*)(ws + WS_TOKEP); const f32x2* tokg = (const f32x2*)(ws + WS_TOKG); const float* gf = a.in[20];
    const int gw = vcu * NWAVES + wave, NGW = G * NWAVES;
    float gfv[16];
#pragma unroll
    for (int j = 0; j < 2; ++j)
#pragma unroll
        for (int e = 0; e < 8; ++e) gfv[j * 8 + e] = gf[8 * lane + 512 * j + e];
    constexpr int RB = 4;
    u32x2 epn[RB]; f32x2 gn[RB];
#pragma unroll
    for (int q = 0; q < RB; ++q) { const int r = gw + q * NGW < M ? gw + q * NGW : gw; epn[q] = ((const GAS u32x2*)tokep)[r]; gn[q] = ((const GAS f32x2*)tokg)[r]; }
    for (int r0 = gw; r0 < M; r0 += RB * NGW) {
        u32x2 ep[RB]; f32x2 g[RB]; size_t s1[RB], s2[RB]; u32x4 wh[RB][2]; u32x2 w1[RB][2], w2[RB][2];
#pragma unroll
        for (int q = 0; q < RB; ++q) { ep[q] = epn[q]; g[q] = gn[q] * (1.0f / (HQ_SCALE * WD_SCALE)); }
#pragma unroll
        for (int q = 0; q < RB; ++q) {
            const int r = r0 + q * NGW < M ? r0 + q * NGW : r0;
            int ts1 = 0, ts2 = 0; const int e1 = (int)(ep[q].x >> 28), e2 = (int)(ep[q].y >> 28);
#pragma unroll
            for (int e = 0; e < 8; ++e) { if (e1 == e) ts1 = mi.ts[e]; if (e2 == e) ts2 = mi.ts[e]; }
            s1[q] = (size_t)ts1 * 256 + (ep[q].x & 0x0fffffffu); s2[q] = (size_t)ts2 * 256 + (ep[q].y & 0x0fffffffu);
#pragma unroll
            for (int j = 0; j < 2; ++j) { const int k = 8 * lane + 512 * j;
                wh[q][j] = *(const u32x4*)(hb + (size_t)r * D + k); w1[q][j] = *(const u32x2*)(Y + s1[q] * D + k); w2[q][j] = *(const u32x2*)(Y + s2[q] * D + k); }
        }
        { const int rn0 = r0 + RB * NGW;
#pragma unroll
          for (int q = 0; q < RB; ++q) { const int r = rn0 + q * NGW < M ? rn0 + q * NGW : gw; epn[q] = ((const GAS u32x2*)tokep)[r]; gn[q] = ((const GAS f32x2*)tokg)[r]; } }
#pragma unroll
        for (int q = 0; q < RB; ++q) {
            const int r = r0 + q * NGW; if (r >= M) break;
            const bool t1 = (s1[q] >> 8) >= (size_t)DOWN_MAIN_TILES, t2 = (s2[q] >> 8) >= (size_t)DOWN_MAIN_TILES;
            float v[16]; float s = 0.f;
#pragma unroll
            for (int j = 0; j < 2; ++j) {
                const int k = 8 * lane + 512 * j; float hf[8], y1[8], y2[8];
                unpack8(wh[q][j], hf); unpack8_fp8(w1[q][j], y1); unpack8_fp8(w2[q][j], y2);
                if (t1) final_y_tail(YP, s1[q], k, y1);
                if (t2) final_y_tail(YP, s2[q], k, y2);
#pragma unroll
                for (int e = 0; e < 8; ++e) { const float t = hf[e] + g[q].x * y1[e] + g[q].y * y2[e]; v[j * 8 + e] = t; s += t * t; }
            }
            s = wave_sum(s); const float rstd = 1.0f / sqrtf(s * (1.0f / (float)D) + RMS_EPS);
#pragma unroll
            for (int j = 0; j < 2; ++j) {
                float* o = a.out + (size_t)r * D + 8 * lane + 512 * j;
                *(f32x4*)o = (f32x4){v[j * 8 + 0] * rstd * gfv[j * 8 + 0], v[j * 8 + 1] * rstd * gfv[j * 8 + 1], v[j * 8 + 2] * rstd * gfv[j * 8 + 2], v[j * 8 + 3] * rstd * gfv[j * 8 + 3]};
                *(f32x4*)(o + 4) = (f32x4){v[j * 8 + 4] * rstd * gfv[j * 8 + 4], v[j * 8 + 5] * rstd * gfv[j * 8 + 5], v[j * 8 + 6] * rstd * gfv[j * 8 + 6], v[j * 8 + 7] * rstd * gfv[j * 8 + 7]};
            }
        }
    }
}

constexpr int N_PHASES = 13;
#ifndef REP_P0
#define REP_P0 1
#endif
#ifndef REP_P4
#define REP_P4 1
#endif
#ifndef REP_MOE
#define REP_MOE 1
#endif
#ifndef REP_EW
#define REP_EW 1
#endif
#ifndef REP_CONV
#define REP_CONV 1
#endif
#ifndef REP_QKV
#define REP_QKV 1
#endif
#ifndef REP_ATT
#define REP_ATT 1
#endif
__global__ void __launch_bounds__(NWAVES * 64, 2) fwd_kernel(Args args) {
    extern __shared__ __attribute__((aligned(16))) unsigned char lds_raw[];
    LAS unsigned char* lds = (LAS unsigned char*)lds_raw;
    volatile LAS unsigned* MISC = (volatile LAS unsigned*)(lds + MISC_OFF);
    const int wave = __builtin_amdgcn_readfirstlane((int)threadIdx.x >> 6);
#define lane hw_lane()
#define tid (wave * 64 + hw_lane())
    const int G = gridDim.x; const int bx = blockIdx.x; const int vcu = (G % 8 == 0) ? (bx % 8) * (G / 8) + bx / 8 : bx;
    unsigned char* ws = args.ws;
    unsigned* ctl = (unsigned*)(ws + WS_CTL);
    for (int u = (int)threadIdx.x; u < (LDS_BYTES - LDSCTL_OFF) / 4; u += NWAVES * 64) ((LAS unsigned*)(lds + LDSCTL_OFF))[u] = 0u;
    __syncthreads();
#if !MULTI_LAUNCH
    XcdBarrier bar = xcd_barrier_post(ctl + CW_BAR, MISC + 8, wave);
#define GRID_BAR() xcd_barrier(bar, wave)
#else
#define GRID_BAR() do { } while (0)
#endif
    const int lo = args.ph_lo, hi = args.ph_hi;
#define IN(k) (lo <= (k) && (k) < hi)
#ifndef PROBE_T_PH
#define PROBE_T_PH -1
#endif
#ifndef PROBE_T_AMP
#define PROBE_T_AMP 20
#endif
#ifndef PROBE_T_MODE
#define PROBE_T_MODE 0
#endif
#ifndef PROBE_T_WG
#define PROBE_T_WG 0
#endif
#define TSW ((volatile LAS unsigned*)(lds + LDS_BYTES - 16))
#define TS_NOW() ((unsigned)__builtin_amdgcn_s_memrealtime())
#define TS_BEGIN(k) do { if (PROBE_T_PH == (k) && bx == PROBE_T_WG && wave == 0) { TSW[0] = TS_NOW(); TSW[2] = 1u; } } while (0)
#define TS_END(k, mode) do { if (PROBE_T_PH == (k) && PROBE_T_MODE == (mode) && bx == PROBE_T_WG && wave == 0) TSW[1] = TS_NOW() - TSW[0]; } while (0)
#define SEAM(k) do { TS_END(k, 0); if (PROBE_T_PH == (k) && bx == PROBE_T_WG && wave == 0) TSW[2] = 0u; if (IN(k) && IN((k) + 1)) GRID_BAR(); TS_END(k, 1); TS_BEGIN((k) + 1); } while (0)
    unsigned char* misc = ws + WS_MISC;
    const float* ssq = (const float*)(ws + WS_SSQ);

    TS_BEGIN(0);
    if (IN(0)) { for (int rep = 0; rep < REP_P0; ++rep) { p0_prologue(args, lds, vcu, G, wave, lane); SEAM(0); } }

    if (IN(1)) {
        typedef pg8::DenseSched<M / 256, NCONV / 256> DS; DS S{(const char*)(ws + WS_HB), (const char*)(ws + WS_WIN), 2 * D, G, bx};
        LAS float* rtab = (LAS float*)(lds + pg8::RSTD_TAB_OFF);
        auto pre = [&]() {
            if (bx < 96) {
                const float* ms0 = (const float*)(misc + MS_SSQ0); float* bm = (float*)(misc + MS_BM); float* vm = (float*)(misc + MS_VM);
                int n0, n1, vch = -1; if (bx < 32) { n0 = 32 * bx; n1 = n0 + 16; } else { const int j2 = bx - 32; n0 = D + 256 * (j2 >> 3) + 16 * (j2 & 7); n1 = n0 + 128; vch = 128 * (j2 >> 3) + 16 * (j2 & 7); }
                meta_dual(lds, (const bf16*)(misc + MS_MB), D, (const bf16*)(ws + WS_WIN), n0, n1, lane, wave, [&](const f32x4& a0, const f32x4& a1, int r16, int kq) {
    #pragma unroll
                    for (int g = 0; g < 4; ++g) { const int i = 4 * kq + g; const float r = 1.0f / sqrtf(ms0[i] * (1.0f / (float)D) + RMS_EPS);
                        if (vch < 0) { bm[i * D + n0 + r16] = a0[g] * r; bm[i * D + n1 + r16] = a1[g] * r; } else vm[i * D + vch + r16] = (a0[g] * r) * (a1[g] * r); } });
            }
            __syncthreads(); pg8::rstd_table_fill(S, ssq, rtab, tid); __syncthreads();
        };
        pg8::EpiConvIn E{(bf16*)(ws + WS_BC), (bf16*)(ws + WS_VC), rtab};
        ExpertCvtBg bg{args.in[17], args.in[18], args.in[19], args.in[15], ws, EXP_ITEMS - bg_cover(G), 0, BG_P1, bx * NWAVES + wave, G * NWAVES, {}, {}, {}, nullptr, 0u, 0, 0.f, false};
#if BG_CVT
        pg8::gemm_phase<pg8::EpiConvIn, DS, true>(lds, S, E, wave, pre, bg);
#else
        (void)bg; pg8::gemm_phase<pg8::EpiConvIn, DS, true>(lds, S, E, wave, pre);
#endif
        SEAM(1);
    }
    if (IN(2)) { for (int rep = 0; rep < REP_CONV; ++rep) { conv_phase(args, G, tid); SEAM(2); } }

    if (IN(3)) {
        typedef pg8::DenseSched<M / 256, D / 256> DS; DS S{(const char*)(ws + WS_YC), (const char*)(ws + WS_WOUT), 2 * D, G, bx};
        auto pre = [&]() {
            if (bx < 32) {
                const float* meta = args.in[1]; float* hm = (float*)(misc + MS_HM); bf16* hmb = (bf16*)(misc + MS_HMB); float* p1 = (float*)(misc + MS_SSQ1);
                const int n0 = 32 * bx, n1 = n0 + 16;
                meta_dual(lds, (const bf16*)(misc + MS_YCM), D, (const bf16*)(ws + WS_WOUT), n0, n1, lane, wave, [&](const f32x4& a0, const f32x4& a1, int r16, int kq) {
    #pragma unroll
                    for (int g = 0; g < 4; ++g) { const int i = 4 * kq + g; const float v0 = meta[i * D + n0 + r16] + a0[g], v1 = meta[i * D + n1 + r16] + a1[g];
                        hm[i * D + n0 + r16] = v0; hm[i * D + n1 + r16] = v1; hmb[i * D + n0 + r16] = (bf16)f2bf(v0); hmb[i * D + n1 + r16] = (bf16)f2bf(v1);
                        float q = v0 * v0 + v1 * v1; q += __shfl_xor(q, 1); q += __shfl_xor(q, 2); q += __shfl_xor(q, 4); q += __shfl_xor(q, 8);
                        if (r16 == 0) p1[bx * 16 + i] = q; } });
            }
        };
        pg8::EpiResidT<FFN8 != 0> E{(bf16*)(ws + WS_HB), (float*)(ws + WS_SSQ), 1.0f, ws + WS_XQ};
        pg8::gemm_phase<pg8::EpiResidT<FFN8 != 0>, DS, true>(lds, S, E, wave, pre);
        SEAM(3);
    }
    if (IN(4)) for (int rep = 0; rep < REP_P4; ++rep) {
#if FFN8
        typedef pg8::DenseSched<M / 256, NGU / 256, true> DS; DS S{(const char*)(ws + WS_XQ), (const char*)(ws + WS_WGU8), D, G, bx};
#else
        typedef pg8::DenseSched<M / 256, NGU / 256> DS; DS S{(const char*)(ws + WS_HB), (const char*)(ws + WS_WGU), 2 * D, G, bx};
#endif
        LAS float* rtab = (LAS float*)(lds + pg8::RSTD_TAB_OFF);
        auto pre = [&]() {
            if (bx < 224) {
                const f32x4 rs = meta_rstd_parts((const float*)(misc + MS_SSQ1), lane); bf16* hdm = (bf16*)(misc + MS_HDM);
                const int n0 = 256 * (bx >> 3) + 16 * (bx & 7), n1 = n0 + 128, hch = 128 * (bx >> 3) + 16 * (bx & 7);
                meta_dual(lds, (const bf16*)(misc + MS_HMB), D, (const bf16*)(ws + WS_WGU), n0, n1, lane, wave, [&](const f32x4& a0, const f32x4& a1, int r16, int kq) {
    #pragma unroll
                    for (int g = 0; g < 4; ++g) { const int i = 4 * kq + g; hdm[i * DFF + hch + r16] = (bf16)f2bf(pg8::silu_mul(a0[g] * rs[g], a1[g] * rs[g])); } });
            }
            __syncthreads(); pg8::rstd_table_fill(S, ssq, rtab, tid); __syncthreads();
        };
#if FFN8
        typedef pg8::EpiSwiGLU8T<FFN8 == 1> EPI4; EPI4 E{ws + WS_HD, rtab};
#else
        typedef pg8::EpiSwiGLU EPI4; EPI4 E{(bf16*)(ws + WS_HD), rtab};
#endif
        ExpertCvtBg bg{args.in[17], args.in[18], args.in[19], args.in[15], ws, EXP_ITEMS - bg_cover(G), BG_P1, BG_P4, bx * NWAVES + wave, G * NWAVES, {}, {}, {}, nullptr, 0u, 0, 0.f, false};
#if BG_CVT
        pg8::gemm_phase<EPI4, DS, true>(lds, S, E, wave, pre, bg);
#else
        (void)bg; pg8::gemm_phase<EPI4, DS, true>(lds, S, E, wave, pre);
#endif
        SEAM(4);
    }
    if (IN(5)) {
#if FFN8 == 1
        typedef pg8::DenseSched<M / 256, D / 256, true> DS; DS S{(const char*)(ws + WS_HD), (const char*)(ws + WS_WD8), DFF, G, bx};
#else
        typedef pg8::DenseSched<M / 256, D / 256> DS; DS S{(const char*)(ws + WS_HD), (const char*)(ws + WS_WD), 2 * DFF, G, bx};
#endif
        auto pre = [&]() {
            if (bx < 32) {
                float* hm = (float*)(misc + MS_HM); bf16* hmb = (bf16*)(misc + MS_HMB); float* p2 = (float*)(misc + MS_SSQ2);
                const int n0 = 32 * bx, n1 = n0 + 16;
                meta_dual(lds, (const bf16*)(misc + MS_HDM), DFF, (const bf16*)(ws + WS_WD), n0, n1, lane, wave, [&](const f32x4& a0, const f32x4& a1, int r16, int kq) {
    #pragma unroll
                    for (int g = 0; g < 4; ++g) { const int i = 4 * kq + g; const float v0 = hm[i * D + n0 + r16] + a0[g], v1 = hm[i * D + n1 + r16] + a1[g];
                        hm[i * D + n0 + r16] = v0; hm[i * D + n1 + r16] = v1; hmb[i * D + n0 + r16] = (bf16)f2bf(v0); hmb[i * D + n1 + r16] = (bf16)f2bf(v1);
                        float q = v0 * v0 + v1 * v1; q += __shfl_xor(q, 1); q += __shfl_xor(q, 2); q += __shfl_xor(q, 4); q += __shfl_xor(q, 8);
                        if (r16 == 0) p2[bx * 16 + i] = q; } });
            }
        };
        typedef pg8::EpiResidT<false, FFN8 == 1> EPI5; EPI5 E{(bf16*)(ws + WS_HB), (float*)(ws + WS_SSQ), FFN8 == 1 ? 1.0f / (HDQ_SCALE * WD8_SCALE) : 1.0f, nullptr};
        pg8::gemm_phase<EPI5, DS, true>(lds, S, E, wave, pre);
        SEAM(5);
    }
    if (IN(6)) {
        typedef pg8::DenseSched<M / 256, NQKV / 256> DS; DS S{(const char*)(ws + WS_HB), (const char*)(ws + WS_WQKV), 2 * D, G, bx};
        LAS float* rtab = (LAS float*)(lds + pg8::RSTD_TAB_OFF);
        auto pre = [&]() {
            if (bx < 16) {
                const f32x4 rs = meta_rstd_parts((const float*)(misc + MS_SSQ2), lane); const float* bias = args.in[12]; const f32x2* rope = (const f32x2*)(ws + WS_ROPE);
                bf16* km = (bf16*)(misc + MS_KM); bf16* vmt = (bf16*)(misc + MS_VMETA);
                int n0, n1; if (bx < 8) { n0 = D + 32 * (bx >> 1) + 16 * (bx & 1); n1 = n0 + 128; } else { n0 = D + KVD + 32 * (bx - 8); n1 = n0 + 16; }
                meta_dual(lds, (const bf16*)(misc + MS_HMB), D, (const bf16*)(ws + WS_WQKV), n0, n1, lane, wave, [&](const f32x4& a0, const f32x4& a1, int r16, int kq) {
    #pragma unroll
                    for (int g = 0; g < 4; ++g) { const int i = 4 * kq + g;
                        if (bx < 8) { const int wc = bx >> 1, dlo = 16 * (bx & 1) + r16; const float lo_ = a0[g] * rs[g] + bias[D + 64 * wc + dlo], hi_ = a1[g] * rs[g] + bias[D + 64 * wc + dlo + 32];
                            const f32x2 cs = rope[i * 32 + dlo]; km[i * KVD + 64 * wc + dlo] = (bf16)f2bf(lo_ * cs.x - hi_ * cs.y); km[i * KVD + 64 * wc + dlo + 32] = (bf16)f2bf(hi_ * cs.x + lo_ * cs.y); }
                        else { const int c0 = n0 - (D + KVD) + r16; vmt[i * KVD + c0] = (bf16)f2bf(a0[g] * rs[g] + bias[n0 + r16]); vmt[i * KVD + c0 + 16] = (bf16)f2bf(a1[g] * rs[g] + bias[n1 + r16]); } } });
            }
            __syncthreads(); pg8::rstd_table_fill(S, ssq, rtab, tid); __syncthreads();
        };
        pg8::EpiQKV E{(bf16*)(ws + WS_Q), (bf16*)(ws + WS_KB), (bf16*)(ws + WS_VB), rtab, args.in[12], (const f32x2*)(ws + WS_ROPE)};
        for (int rep = 0; rep < REP_QKV; ++rep) { pg8::gemm_phase<pg8::EpiQKV, DS, true>(lds, S, E, wave, pre);
        SEAM(6); }
    }
    if (IN(7)) { for (int rep = 0; rep < REP_ATT; ++rep) { attn_phase(args, lds, vcu, G, tid, wave, lane); SEAM(7); } }

    if (IN(8)) {
        typedef pg8::DenseSched<M / 256, D / 256> DS; DS S{(const char*)(ws + WS_O), (const char*)(ws + WS_WO), 2 * D, G, bx};
        pg8::EpiResid E{(bf16*)(ws + WS_HB), (float*)(ws + WS_SSQ), 1.0f, nullptr};
        pg8::gemm_phase<pg8::EpiResid, DS, true>(lds, S, E, wave);
        SEAM(8);
    }
    if (IN(9)) { route_phase(args, lds, ctl, G, tid, wave, lane); SEAM(9); }

    for (int rep = 0; rep < REP_MOE; ++rep) {
        if (IN(10)) {
            LAS int* ml = (LAS int*)(lds + MISC_OFF + 64); moe_info_to_lds(ctl, ml, wave);
            const int ntile = __builtin_amdgcn_readfirstlane(ml[8]);
            pg8::MoeUpSched S{(const char*)(ws + WS_XQ), (const char*)(ws + WS_EWGU), (const int*)(ws + WS_LIST), ml, D, ntile, G, bx, 0};
            pg8::EpiMoeUp E{(unsigned char*)args.out, ws, 0};
            pg8::gemm_phase<pg8::EpiMoeUp, pg8::MoeUpSched, true>(lds, S, E, wave);
            SEAM(10);
        }
        if (IN(11)) {
            LAS int* ml = (LAS int*)(lds + MISC_OFF + 64); moe_info_to_lds(ctl, ml, wave);
            const int ntile = __builtin_amdgcn_readfirstlane(ml[8]);
            const int nmain = ntile < DOWN_MAIN_TILES ? ntile : DOWN_MAIN_TILES;
            pg8::MoeDownSched S{(unsigned char*)args.out, ws, (const char*)(ws + WS_EWD), ml, DFF, nmain, G, bx, 0};
            pg8::EpiMoeDown E{ws + WS_Y};
            pg8::gemm_phase<pg8::EpiMoeDown, pg8::MoeDownSched, true>(lds, S, E, wave);
            pg8::MoeDownTailSched S2{(unsigned char*)args.out, ws, (const char*)(ws + WS_EWD), ml, DFF, (ntile - nmain) * 4 * DOWN_KS, G, bx};
            pg8::EpiMoeDownPart E2{(bf16*)(ws + WS_YP)};
            pg8::gemm_phase<pg8::EpiMoeDownPart, pg8::MoeDownTailSched, true>(lds, S2, E2, wave);
            SEAM(11);
        }
    }
    if (IN(12)) { for (int rep = 0; rep < REP_EW; ++rep) { if (rep) GRID_BAR(); final_phase(args, ctl, vcu, G, wave, lane); } }
    if (PROBE_T_PH >= 0 && bx == PROBE_T_WG) {
        if (PROBE_T_PH == 12 && wave == 0) TSW[1] = TS_NOW() - TSW[0];
        if (wave == 0) { const unsigned d = TSW[1] * (unsigned)PROBE_T_AMP; const unsigned t0 = TS_NOW(); while (TS_NOW() - t0 < d) __builtin_amdgcn_s_sleep(8); }
        __syncthreads();
    }
#undef IN
#undef SEAM
#undef lane
#undef tid
}

extern "C" void kernel_launch(void* const* d_in, const int* in_sizes, int n_in, void* d_out, int out_size, void* d_ws, size_t ws_size, hipStream_t stream) {
    static int grid = 0;
    if (grid == 0) {
        if (n_in != 21 || in_sizes[0] != M * D || out_size != M * D || ws_size < WS_END2) { fprintf(stderr, "kernel_launch: unexpected shapes (n_in %d, in0 %d, out %d, ws %zu); nothing launched\n", n_in, n_in > 0 ? in_sizes[0] : -1, out_size, ws_size); grid = -1; return; }
        int dev = 0, cus = 0, per_cu = 0;
        if (hipGetDevice(&dev) != hipSuccess || hipDeviceGetAttribute(&cus, hipDeviceAttributeMultiprocessorCount, dev) != hipSuccess) { grid = -1; return; }
        if (hipFuncSetAttribute((const void*)fwd_kernel, hipFuncAttributeMaxDynamicSharedMemorySize, LDS_BYTES) != hipSuccess) { fprintf(stderr, "kernel_launch: hipFuncSetAttribute failed\n"); grid = -1; return; }
        if (hipOccupancyMaxActiveBlocksPerMultiprocessor(&per_cu, (const void*)fwd_kernel, NWAVES * 64, LDS_BYTES) != hipSuccess || per_cu < 1) fprintf(stderr, "kernel_launch: occupancy query reports %d\n", per_cu);
        (void)hipGetLastError();
        grid = cus;
    }
    if (grid < 0) return;
    if (hipMemsetAsync((char*)d_ws + WS_CTL, 0, CTL_ZERO_BYTES, stream) != hipSuccess) return;
    Args a{};
    for (int i = 0; i < 21; ++i) a.in[i] = (const float*)d_in[i];
    a.out = (float*)d_out; a.ws = (unsigned char*)d_ws;
    for (int f = 0; f < 32; ++f) a.inv[f] = (float)std::pow(10000.0, -(double)f / 32.0);
#if MULTI_LAUNCH
    for (int p = 0; p < N_PHASES; ++p) { a.ph_lo = p; a.ph_hi = p + 1; hipLaunchKernelGGL(fwd_kernel, dim3(grid), dim3(NWAVES * 64), LDS_BYTES, stream, a); }
#else
    a.ph_lo = 0; a.ph_hi = N_PHASES;
    hipLaunchKernelGGL(fwd_kernel, dim3(grid), dim3(NWAVES * 64), LDS_BYTES, stream, a);
#endif
}
```
